# Optimizing an MI355X kernel written in HIP

```python
import jax, jax.numpy as jnp
from jax import lax
import numpy as np

D_MODEL = 1024
BATCH = 4
SEQ = 4096
DEPTH = 2

MEM_LEN = 256
D_MIX = 2 * D_MODEL
D_GROUP = D_MIX // 4
A_HEADS = 4
A_HD = D_GROUP // A_HEADS
B_HEADS = 8
B_KV_HEADS = 2
B_HD = D_GROUP // B_HEADS
WINDOW = 128
BLOCK = 128
ROPE_THETA = 500000.0
ROPE_DIM = B_HD // 4
C_HEADS = 4
C_QK = D_GROUP // (2 * C_HEADS)
C_V = D_GROUP // C_HEADS
CONV_W = 5
D_HEADS = 4
D_HD = D_GROUP // D_HEADS

CHUNK = 64
MAX_POS_OFFSET = 1024
EPS = 1e-6

IN_SIZES = (
    D_GROUP, D_GROUP, D_GROUP, D_GROUP, D_GROUP,
    B_HEADS * B_HD, B_KV_HEADS * B_HD, B_KV_HEADS * B_HD, D_GROUP,
    C_HEADS * C_QK, C_HEADS * C_QK, C_HEADS * C_V, D_GROUP, D_GROUP,
    2 * C_HEADS, 2 * C_HEADS,
    D_GROUP, D_GROUP,
)
D_IN = sum(IN_SIZES)
SPLIT_POINTS = tuple(int(s) for s in np.cumsum(IN_SIZES)[:-1])

kernel_name = "hybrid_hgrn2_swa_mlstm_memxattn_encoder"

F32 = jnp.float32


def _rmsnorm(x, g):
    xf = x.astype(F32)
    y = xf * lax.rsqrt(jnp.mean(xf * xf, axis=-1, keepdims=True) + EPS)
    return (y * g.astype(F32)).astype(x.dtype)


def _head_layernorm(h, g):
    mu = jnp.mean(h, axis=-1, keepdims=True)
    var = jnp.mean(jnp.square(h - mu), axis=-1, keepdims=True)
    return (h - mu) * lax.rsqrt(var + EPS) * g.astype(F32)


def _to_chunks(a):
    b, h, t = a.shape[:3]
    a = a.reshape((b, h, t // CHUNK, CHUNK) + a.shape[3:])
    return jnp.moveaxis(a, 2, 0)


def _from_chunks(a):
    a = jnp.moveaxis(a, 0, 2)
    return a.reshape(a.shape[:2] + (a.shape[2] * a.shape[3],) + a.shape[4:])


def _flip_t(a):
    return jnp.flip(a, axis=2)


def _hgrn2_scan(q, k, v, log_f):
    bsz, nh, _, dk = q.shape
    dv = v.shape[-1]
    mask = jnp.tril(jnp.ones((CHUNK, CHUNK), bool))[:, :, None]

    def step(S, inp):
        qb, kb, vb, gb = inp
        b = jnp.cumsum(gb, axis=2)
        diff = b[:, :, :, None, :] - b[:, :, None, :, :]
        decay = jnp.exp(jnp.where(mask, diff, -jnp.inf))
        attn = jnp.einsum('bhtd,bhsd,bhtsd->bhts', qb, kb, decay)
        o = (jnp.einsum('bhts,bhsv->bhtv', attn, vb)
             + jnp.einsum('bhtd,bhdv->bhtv', qb * jnp.exp(b), S))
        b_last = b[:, :, -1:, :]
        S = (jnp.exp(b_last[:, :, 0, :])[..., None] * S
             + jnp.einsum('bhsd,bhsv->bhdv', kb * jnp.exp(b_last - b), vb))
        return S, o

    S0 = jnp.zeros((bsz, nh, dk, dv), F32)
    _, o = lax.scan(step, S0, (_to_chunks(q), _to_chunks(k), _to_chunks(v), _to_chunks(log_f)))
    return _from_chunks(o)


def _hgrn2_branch(q, i, zf, zb, z, lb, norm_g):
    bsz, t, _ = q.shape
    heads = lambda a: a.astype(F32).reshape(bsz, t, A_HEADS, A_HD).transpose(0, 2, 1, 3)
    lbh = lb.astype(F32).reshape(A_HEADS, 1, A_HD)
    qh, vh = heads(q), heads(i)

    def gates(zg):
        zg = heads(zg)
        f = lbh + (1.0 - lbh) * jax.nn.sigmoid(zg)
        return (1.0 - lbh) * jax.nn.sigmoid(-zg), jnp.log(f)

    kf, gf = gates(zf)
    kb, gb = gates(zb)
    o_f = _hgrn2_scan(qh, kf, vh, gf)
    o_b = _flip_t(_hgrn2_scan(_flip_t(qh), _flip_t(kb), _flip_t(vh), _flip_t(gb)))
    o = (o_f + o_b).transpose(0, 2, 1, 3)
    o = _rmsnorm(o, norm_g.reshape(A_HEADS, A_HD))
    return o.reshape(bsz, t, D_GROUP).astype(z.dtype) * jax.nn.silu(z)


def _rope(x, cos, sin):
    half = ROPE_DIM // 2
    x1 = x[..., :half].astype(F32)
    x2 = x[..., half:ROPE_DIM].astype(F32)
    rot = jnp.concatenate([x1 * cos - x2 * sin, x2 * cos + x1 * sin], axis=-1).astype(x.dtype)
    return jnp.concatenate([rot, x[..., ROPE_DIM:]], axis=-1)


def _window_attention(q, k, v, z, sink, cos, sin):
    bsz, t, _ = q.shape
    nb = t // BLOCK
    grp = B_HEADS // B_KV_HEADS
    q = _rope(q.reshape(bsz, t, B_HEADS, B_HD), cos, sin).reshape(bsz, nb, BLOCK, B_KV_HEADS, grp, B_HD)
    k = _rope(k.reshape(bsz, t, B_KV_HEADS, B_HD), cos, sin)
    v = v.reshape(bsz, t, B_KV_HEADS, B_HD)

    def band(a):
        a = jnp.pad(a, ((0, 0), (BLOCK, BLOCK), (0, 0), (0, 0))).reshape(bsz, nb + 2, BLOCK, B_KV_HEADS, B_HD)
        return jnp.concatenate([a[:, :-2], a[:, 1:-1], a[:, 2:]], axis=2)

    kw, vw = band(k), band(v)
    qpos = jnp.arange(t).reshape(nb, BLOCK)
    kpos = jnp.arange(-BLOCK, t + BLOCK).reshape(nb + 2, BLOCK)
    kpos = jnp.concatenate([kpos[:-2], kpos[1:-1], kpos[2:]], axis=1)
    kp = kpos[:, None, :]
    valid = (jnp.abs(qpos[:, :, None] - kp) <= WINDOW) & (kp >= 0) & (kp < t)
    s = jnp.einsum('bnqkgd,bnskd->bnkgqs', q, kw).astype(F32) * (B_HD ** -0.5)
    s = jnp.where(valid[None, :, None, None], s, -jnp.inf)
    sk = jnp.broadcast_to(sink.astype(F32).reshape(1, 1, B_KV_HEADS, grp, 1, 1), s.shape[:-1] + (1,))
    p = jax.nn.softmax(jnp.concatenate([s, sk], axis=-1), axis=-1)[..., :-1]
    o = jnp.einsum('bnkgqs,bnskd->bnqkgd', p.astype(v.dtype), vw)
    return o.reshape(bsz, t, D_GROUP) * jax.nn.silu(z)


def _centered_dwconv(x, w):
    pad = CONV_W // 2
    return lax.conv_general_dilated(
        x, w[:, None, :].astype(x.dtype), window_strides=(1,), padding=((pad, pad),),
        dimension_numbers=('NWC', 'WIO', 'NWC'), feature_group_count=x.shape[-1])


def _mlstm_scan(q, k, v, log_i, log_f):
    bsz, nh, _, dk = q.shape
    dv = v.shape[-1]
    mask = jnp.tril(jnp.ones((CHUNK, CHUNK), bool))

    def step(carry, inp):
        C, n, m = carry
        qb, kb, vb, ib, fb = inp
        b = jnp.cumsum(fb, axis=-1)
        d_intra = jnp.where(mask, b[..., :, None] - b[..., None, :] + ib[..., None, :], -jnp.inf)
        d_inter = b + m[..., None]
        m_t = jnp.maximum(jnp.max(d_intra, axis=-1), d_inter)
        w = jnp.einsum('bhtd,bhsd->bhts', qb, kb) * jnp.exp(d_intra - m_t[..., None])
        g = jnp.exp(d_inter - m_t)
        num = jnp.einsum('bhts,bhsv->bhtv', w, vb) + g[..., None] * jnp.einsum('bhtd,bhdv->bhtv', qb, C)
        den = jnp.sum(w, axis=-1) + g * jnp.einsum('bhtd,bhd->bht', qb, n)
        h = num / jnp.maximum(jnp.abs(den), jnp.exp(-m_t))[..., None]
        b_last = b[..., -1]
        a = b_last[..., None] - b + ib
        m_new = jnp.maximum(b_last + m, jnp.max(a, axis=-1))
        ws = jnp.exp(a - m_new[..., None])
        decay = jnp.exp(b_last + m - m_new)
        C = decay[..., None, None] * C + jnp.einsum('bhs,bhsd,bhsv->bhdv', ws, kb, vb)
        n = decay[..., None] * n + jnp.einsum('bhs,bhsd->bhd', ws, kb)
        return (C, n, m_new), h

    init = (jnp.zeros((bsz, nh, dk, dv), F32), jnp.zeros((bsz, nh, dk), F32), jnp.zeros((bsz, nh), F32))
    _, h = lax.scan(step, init, tuple(_to_chunks(a) for a in (q, k, v, log_i, log_f)))
    return _from_chunks(h)


def _mlstm_branch(q, k, v, o, z, ig, fg, gate_b, conv_w, norm_g):
    bsz, t, _ = q.shape
    qk = jax.nn.silu(_centered_dwconv(jnp.concatenate([q, k], axis=-1), conv_w))
    q, k = jnp.split(qk, 2, axis=-1)
    heads = lambda a, d: a.astype(F32).reshape(bsz, t, C_HEADS, d).transpose(0, 2, 1, 3)
    qh = heads(q, C_QK) * (C_QK ** -0.5)
    kh = heads(k, C_QK)
    vh = heads(v, C_V)
    gb = gate_b.astype(F32)
    to_dir = lambda a: a.reshape(bsz, t, 2, C_HEADS).transpose(2, 0, 3, 1)
    log_i = to_dir(ig.astype(F32) + gb[:2 * C_HEADS])
    log_f = to_dir(jax.nn.log_sigmoid(fg.astype(F32) + gb[2 * C_HEADS:]))
    h_f = _mlstm_scan(qh, kh, vh, log_i[0], log_f[0])
    h_b = _flip_t(_mlstm_scan(_flip_t(qh), _flip_t(kh), _flip_t(vh), _flip_t(log_i[1]), _flip_t(log_f[1])))
    h = (h_f + h_b).transpose(0, 2, 1, 3) * jax.nn.sigmoid(o.astype(F32)).reshape(bsz, t, C_HEADS, C_V)
    h = _head_layernorm(h, norm_g.reshape(C_HEADS, C_V))
    return h.reshape(bsz, t, D_GROUP).astype(z.dtype) * jax.nn.silu(z)


def _memory_attention(q, z, mem_n, w_kv):
    bsz, t, _ = q.shape
    m = mem_n.shape[1]
    k, v = jnp.split(mem_n @ w_kv, 2, axis=-1)
    k = k.reshape(bsz, m, D_HEADS, D_HD)
    v = v.reshape(bsz, m, D_HEADS, D_HD)
    qh = q.reshape(bsz, t, D_HEADS, D_HD)
    s = jnp.einsum('bthd,bmhd->bhtm', qh, k).astype(F32) * (D_HD ** -0.5)
    p = jax.nn.softmax(s, axis=-1).astype(v.dtype)
    o = jnp.einsum('bhtm,bmhd->bthd', p, v).reshape(bsz, t, D_GROUP)
    return o * jax.nn.silu(z)


def setup_inputs(seed: int = 0) -> dict:
    key = jax.random.key(seed)
    ks = jax.random.split(key, 18)
    nrm = lambda k, shape: jax.random.normal(k, shape, F32)
    x = nrm(ks[0], (BATCH, SEQ, D_MODEL))
    mem = nrm(ks[1], (BATCH, MEM_LEN, D_MODEL))
    positions = (jax.random.randint(ks[2], (BATCH, 1), 0, MAX_POS_OFFSET)
                 + jnp.arange(SEQ)[None, :]).astype(jnp.int32)
    norm_g = 1.0 + 0.02 * nrm(ks[3], (DEPTH, D_MODEL))
    w_in = nrm(ks[4], (DEPTH, D_MODEL, D_IN)) * (D_MODEL ** -0.5)
    hgrn_lb_logits = 0.5 * nrm(ks[5], (DEPTH, D_GROUP))
    hgrn_norm_g = 1.0 + 0.02 * nrm(ks[6], (DEPTH, D_GROUP))
    attn_sink = 0.5 * nrm(ks[7], (DEPTH, B_HEADS))
    mlstm_conv_w = nrm(ks[8], (DEPTH, CONV_W, 2 * C_HEADS * C_QK)) * (CONV_W ** -0.5)
    f_bias = jnp.tile(jnp.linspace(3.0, 6.0, C_HEADS), 2)[None, :] + 0.1 * nrm(ks[9], (DEPTH, 2 * C_HEADS))
    i_bias = 0.1 * nrm(ks[10], (DEPTH, 2 * C_HEADS))
    mlstm_gate_b = jnp.concatenate([i_bias, f_bias], axis=-1)
    mlstm_norm_g = 1.0 + 0.02 * nrm(ks[11], (DEPTH, D_GROUP))
    mem_norm_g = 1.0 + 0.02 * nrm(ks[12], (DEPTH, D_MODEL))
    w_mem_kv = nrm(ks[13], (DEPTH, D_MODEL, 2 * D_GROUP)) * (D_MODEL ** -0.5)
    w_out = nrm(ks[14], (DEPTH, D_MIX, D_MODEL)) * (D_MIX ** -0.5)
    final_norm_g = 1.0 + 0.02 * nrm(ks[15], (D_MODEL,))
    return {
        "x": x, "mem": mem, "positions": positions, "norm_g": norm_g, "w_in": w_in,
        "hgrn_lb_logits": hgrn_lb_logits, "hgrn_norm_g": hgrn_norm_g, "attn_sink": attn_sink,
        "mlstm_conv_w": mlstm_conv_w, "mlstm_gate_b": mlstm_gate_b, "mlstm_norm_g": mlstm_norm_g,
        "mem_norm_g": mem_norm_g, "w_mem_kv": w_mem_kv, "w_out": w_out, "final_norm_g": final_norm_g,
    }


def reference(x, mem, positions, norm_g, w_in, hgrn_lb_logits, hgrn_norm_g, attn_sink,
              mlstm_conv_w, mlstm_gate_b, mlstm_norm_g, mem_norm_g, w_mem_kv, w_out, final_norm_g):
    lb_all = jnp.cumsum(jax.nn.softmax(hgrn_lb_logits.astype(F32), axis=0), axis=0)
    lb_all = lb_all - lb_all[:1]
    inv_freq = ROPE_THETA ** (-jnp.arange(0, ROPE_DIM, 2, dtype=F32) / ROPE_DIM)
    ang = positions.astype(F32)[..., None] * inv_freq
    cos = jnp.cos(ang)[:, :, None, :]
    sin = jnp.sin(ang)[:, :, None, :]
    for l in range(DEPTH):
        h = _rmsnorm(x, norm_g[l])
        u = h @ w_in[l]
        (a_q, a_i, a_ff, a_fb, a_z,
         b_q, b_k, b_v, b_z,
         c_q, c_k, c_v, c_o, c_z, c_ig, c_fg,
         d_q, d_z) = jnp.split(u, SPLIT_POINTS, axis=-1)
        y_a = _hgrn2_branch(a_q, a_i, a_ff, a_fb, a_z, lb_all[l], hgrn_norm_g[l])
        y_b = _window_attention(b_q, b_k, b_v, b_z, attn_sink[l], cos, sin)
        y_c = _mlstm_branch(c_q, c_k, c_v, c_o, c_z, c_ig, c_fg, mlstm_gate_b[l], mlstm_conv_w[l], mlstm_norm_g[l])
        y_d = _memory_attention(d_q, d_z, _rmsnorm(mem, mem_norm_g[l]), w_mem_kv[l])
        y = jnp.concatenate([y_a, y_b, y_c, y_d], axis=-1)
        x = x + y @ w_out[l]
    return _rmsnorm(x, final_norm_g)
```

```cpp
#include <hip/hip_runtime.h>
#include <math.h>

namespace nv {
constexpr int BATCH = 4, SEQ = 4096, DM = 1024, DIN = 6928, DMIX = 2048, MEML = 256;
constexpr float EPS = 1e-6f;
constexpr int A_Q = 0, A_I = 512, A_FF = 1024, A_FB = 1536, A_Z = 2048;
constexpr int B_Q = 2560, B_K = 3072, B_V = 3200, B_Z = 3328;
constexpr int C_Q = 3840, C_K = 4096, C_V = 4352, C_O = 4864, C_Z = 5376, C_IG = 5888, C_FG = 5896;
constexpr int D_Q = 5904, D_Z = 6416;

__device__ __forceinline__ float sigmoidf_(float x) { return 1.0f / (1.0f + expf(-x)); }
__device__ __forceinline__ float siluf_(float x) { return x / (1.0f + expf(-x)); }

__global__ void __launch_bounds__(256) k_rmsnorm(const float* __restrict__ x, const float* __restrict__ g, float* __restrict__ out, int d) {
    const int r = blockIdx.x; const float* xr = x + (size_t)r * d;
    float s = 0.f;
    for (int i = threadIdx.x; i < d; i += 256) { float v = xr[i]; s += v * v; }
    __shared__ float red[256];
    red[threadIdx.x] = s; __syncthreads();
    for (int o = 128; o > 0; o >>= 1) { if ((int)threadIdx.x < o) red[threadIdx.x] += red[threadIdx.x + o]; __syncthreads(); }
    const float rs = 1.0f / sqrtf(red[0] / (float)d + EPS);
    for (int i = threadIdx.x; i < d; i += 256) out[(size_t)r * d + i] = xr[i] * rs * g[i];
}

__global__ void __launch_bounds__(256) k_sgemm(const float* __restrict__ A, const float* __restrict__ B, float* __restrict__ C, const float* __restrict__ R,
                                               int M, int N, int K, int lda, int ldb, int ldc, int ldr) {
    __shared__ float As[16][65];
    __shared__ float Bs[16][65];
    const int bm = blockIdx.y * 64, bn = blockIdx.x * 64;
    const int tx = threadIdx.x & 15, ty = threadIdx.x >> 4;
    float acc[4][4];
#pragma unroll
    for (int i = 0; i < 4; ++i)
#pragma unroll
        for (int j = 0; j < 4; ++j) acc[i][j] = 0.f;
    for (int k0 = 0; k0 < K; k0 += 16) {
#pragma unroll
        for (int i = 0; i < 4; ++i) { const int e = threadIdx.x + i * 256; const int r = e >> 4, c = e & 15; As[c][r] = A[(size_t)(bm + r) * lda + k0 + c]; }
#pragma unroll
        for (int i = 0; i < 4; ++i) { const int e = threadIdx.x + i * 256; const int r = e >> 6, c = e & 63; Bs[r][c] = (bn + c < N) ? B[(size_t)(k0 + r) * ldb + bn + c] : 0.f; }
        __syncthreads();
#pragma unroll
        for (int k = 0; k < 16; ++k) {
            float a[4], b[4];
#pragma unroll
            for (int i = 0; i < 4; ++i) { a[i] = As[k][ty * 4 + i]; b[i] = Bs[k][tx * 4 + i]; }
#pragma unroll
            for (int i = 0; i < 4; ++i)
#pragma unroll
                for (int j = 0; j < 4; ++j) acc[i][j] = fmaf(a[i], b[j], acc[i][j]);
        }
        __syncthreads();
    }
#pragma unroll
    for (int i = 0; i < 4; ++i)
#pragma unroll
        for (int j = 0; j < 4; ++j) {
            const int r = bm + ty * 4 + i, c = bn + tx * 4 + j;
            if (c < N) { float v = acc[i][j]; if (R) v += R[(size_t)r * ldr + c]; C[(size_t)r * ldc + c] = v; }
        }
}

__global__ void k_lb(const float* __restrict__ logits, float* __restrict__ lb) {
    const int c = blockIdx.x * blockDim.x + threadIdx.x; if (c >= 512) return;
    const float a = logits[c], b = logits[512 + c]; const float m = fmaxf(a, b);
    const float ea = expf(a - m), eb = expf(b - m);
    lb[c] = 0.f; lb[512 + c] = eb / (ea + eb);
}

__global__ void k_rope_tab(const int* __restrict__ pos, float* __restrict__ cs, float* __restrict__ sn) {
    const int i = blockIdx.x * blockDim.x + threadIdx.x; if (i >= SEQ * 8) return;
    const int t = i >> 3, j = i & 7;
    const double inv = pow(500000.0, -(double)(2 * j) / 16.0);
    const double ang = (double)pos[t] * inv;
    cs[i] = (float)cos(ang); sn[i] = (float)sin(ang);
}

__global__ void __launch_bounds__(256) k_hgrn(const float* __restrict__ u, const float* __restrict__ lb, float* __restrict__ odir) {
    const int h = blockIdx.x & 3, dir = (blockIdx.x >> 2) & 1, dq = blockIdx.x >> 3;
    const int tid = threadIdx.x, dvl = tid & 31, dkg = tid >> 5;
    __shared__ float sq[128], sf[128], sk[128], sv[32], red[8][32];
    float S[16];
#pragma unroll
    for (int i = 0; i < 16; ++i) S[i] = 0.f;
    for (int step = 0; step < SEQ; ++step) {
        const int t = dir ? (SEQ - 1 - step) : step;
        const float* ur = u + (size_t)t * DIN;
        if (tid < 128) {
            const float z = ur[(dir ? A_FB : A_FF) + h * 128 + tid];
            const float l = lb[h * 128 + tid];
            sf[tid] = l + (1.f - l) * sigmoidf_(z);
            sk[tid] = (1.f - l) * sigmoidf_(-z);
            sq[tid] = ur[A_Q + h * 128 + tid];
        } else if (tid < 160) {
            sv[tid - 128] = ur[A_I + h * 128 + dq * 32 + (tid - 128)];
        }
        __syncthreads();
        const float v = sv[dvl]; float part = 0.f;
#pragma unroll
        for (int i = 0; i < 16; ++i) { const int dk = dkg * 16 + i; S[i] = sf[dk] * S[i] + sk[dk] * v; part = fmaf(S[i], sq[dk], part); }
        red[dkg][dvl] = part;
        __syncthreads();
        if (tid < 32) { float o = 0.f;
#pragma unroll
            for (int g = 0; g < 8; ++g) o += red[g][tid];
            odir[((size_t)dir * SEQ + t) * 512 + h * 128 + dq * 32 + tid] = o; }
    }
}
__global__ void __launch_bounds__(256) k_hgrn_comb(const float* __restrict__ odir, const float* __restrict__ u, const float* __restrict__ ng, float* __restrict__ y) {
    const int t = blockIdx.x, h = threadIdx.x >> 6, lane = threadIdx.x & 63;
    const float* a = odir + (size_t)t * 512 + h * 128; const float* b = odir + ((size_t)SEQ + t) * 512 + h * 128;
    const float o0 = a[lane] + b[lane], o1 = a[lane + 64] + b[lane + 64];
    float s = o0 * o0 + o1 * o1;
    for (int o = 32; o > 0; o >>= 1) s += __shfl_xor(s, o);
    const float rs = 1.0f / sqrtf(s / 128.f + EPS);
    const float* ur = u + (size_t)t * DIN;
    y[(size_t)t * DMIX + h * 128 + lane] = o0 * rs * ng[h * 128 + lane] * siluf_(ur[A_Z + h * 128 + lane]);
    y[(size_t)t * DMIX + h * 128 + lane + 64] = o1 * rs * ng[h * 128 + lane + 64] * siluf_(ur[A_Z + h * 128 + lane + 64]);
}

__global__ void k_conv(const float* __restrict__ u, const float* __restrict__ cw, float* __restrict__ qk) {
    const int i = blockIdx.x * blockDim.x + threadIdx.x; if (i >= SEQ * 512) return;
    const int t = i >> 9, c = i & 511;
    float s = 0.f;
#pragma unroll
    for (int j = 0; j < 5; ++j) { const int tt = t + j - 2; if (tt >= 0 && tt < SEQ) s = fmaf(u[(size_t)tt * DIN + C_Q + c], cw[j * 512 + c], s); }
    s = siluf_(s);
    qk[i] = (c < 256) ? s * 0.125f : s;
}
__global__ void __launch_bounds__(256) k_mlstm(const float* __restrict__ u, const float* __restrict__ qk, const float* __restrict__ gb, float* __restrict__ hdir) {
    const int h = blockIdx.x & 3, dir = (blockIdx.x >> 2) & 1, dq = blockIdx.x >> 3;
    const int tid = threadIdx.x, dvl = tid & 31, dkg = tid >> 5;
    __shared__ float sq[64], sk[64], sv[32], sn[64], red[8][32], sden, sgate[2];
    float C[8];
#pragma unroll
    for (int i = 0; i < 8; ++i) C[i] = 0.f;
    if (tid < 64) sn[tid] = 0.f;
    const float bi = gb[dir * 4 + h], bf = gb[8 + dir * 4 + h];
    __syncthreads();
    for (int step = 0; step < SEQ; ++step) {
        const int t = dir ? (SEQ - 1 - step) : step;
        const float* ur = u + (size_t)t * DIN;
        if (tid < 64) { sq[tid] = qk[(size_t)t * 512 + h * 64 + tid]; }
        else if (tid < 128) { sk[tid - 64] = qk[(size_t)t * 512 + 256 + h * 64 + (tid - 64)]; }
        else if (tid < 160) { sv[tid - 128] = ur[C_V + h * 128 + dq * 32 + (tid - 128)]; }
        else if (tid == 160) { sgate[0] = expf(ur[C_IG + dir * 4 + h] + bi); sgate[1] = sigmoidf_(ur[C_FG + dir * 4 + h] + bf); }
        __syncthreads();
        const float gi = sgate[0], gf = sgate[1];
        if (tid < 64) {
            const float nn = gf * sn[tid] + gi * sk[tid]; sn[tid] = nn;
            float d = nn * sq[tid];
            for (int o = 32; o > 0; o >>= 1) d += __shfl_xor(d, o);
            if (tid == 0) sden = d;
        }
        const float v = sv[dvl]; float part = 0.f;
#pragma unroll
        for (int i = 0; i < 8; ++i) { const int dk = dkg * 8 + i; C[i] = gf * C[i] + gi * sk[dk] * v; part = fmaf(C[i], sq[dk], part); }
        red[dkg][dvl] = part;
        __syncthreads();
        if (tid < 32) { float o = 0.f;
#pragma unroll
            for (int g = 0; g < 8; ++g) o += red[g][tid];
            hdir[((size_t)dir * SEQ + t) * 512 + h * 128 + dq * 32 + tid] = o / fmaxf(fabsf(sden), 1.0f); }
        __syncthreads();
    }
}
__global__ void __launch_bounds__(256) k_mlstm_comb(const float* __restrict__ hdir, const float* __restrict__ u, const float* __restrict__ ng, float* __restrict__ y) {
    const int t = blockIdx.x, h = threadIdx.x >> 6, lane = threadIdx.x & 63;
    const float* a = hdir + (size_t)t * 512 + h * 128; const float* b = hdir + ((size_t)SEQ + t) * 512 + h * 128;
    const float* ur = u + (size_t)t * DIN;
    const float v0 = (a[lane] + b[lane]) * sigmoidf_(ur[C_O + h * 128 + lane]);
    const float v1 = (a[lane + 64] + b[lane + 64]) * sigmoidf_(ur[C_O + h * 128 + lane + 64]);
    float s = v0 + v1;
    for (int o = 32; o > 0; o >>= 1) s += __shfl_xor(s, o);
    const float mu = s / 128.f;
    const float d0 = v0 - mu, d1 = v1 - mu;
    float q = d0 * d0 + d1 * d1;
    for (int o = 32; o > 0; o >>= 1) q += __shfl_xor(q, o);
    const float rs = 1.0f / sqrtf(q / 128.f + EPS);
    y[(size_t)t * DMIX + 1024 + h * 128 + lane] = d0 * rs * ng[h * 128 + lane] * siluf_(ur[C_Z + h * 128 + lane]);
    y[(size_t)t * DMIX + 1024 + h * 128 + lane + 64] = d1 * rs * ng[h * 128 + lane + 64] * siluf_(ur[C_Z + h * 128 + lane + 64]);
}

__global__ void k_rope(const float* __restrict__ u, const float* __restrict__ cs, const float* __restrict__ sn, float* __restrict__ qr, float* __restrict__ kr) {
    const int i = blockIdx.x * blockDim.x + threadIdx.x; if (i >= SEQ * 640) return;
    const int t = i / 640, c = i % 640;
    const bool isq = c < 512; const int cc = isq ? c : c - 512; const int d = cc & 63;
    const float* src = u + (size_t)t * DIN + (isq ? B_Q : B_K) + (cc - d);
    float v;
    if (d < 8) v = src[d] * cs[t * 8 + d] - src[d + 8] * sn[t * 8 + d];
    else if (d < 16) v = src[d] * cs[t * 8 + d - 8] + src[d - 8] * sn[t * 8 + d - 8];
    else v = src[d];
    if (isq) qr[(size_t)t * 512 + cc] = v * 0.125f; else kr[(size_t)t * 128 + cc] = v;
}
__global__ void __launch_bounds__(256) k_winattn(const float* __restrict__ u, const float* __restrict__ qr, const float* __restrict__ kr, const float* __restrict__ sink, float* __restrict__ y) {
    const int t0 = blockIdx.x * 16, hq = blockIdx.y, kvh = hq >> 2;
    __shared__ float sQ[16][65], sS[16][273];
    const int tid = threadIdx.x;
    for (int e = tid; e < 16 * 64; e += 256) { const int r = e >> 6, c = e & 63; sQ[r][c] = qr[(size_t)(t0 + r) * 512 + hq * 64 + c]; }
    __syncthreads();
    const int k0 = t0 - 128;
    for (int e = tid; e < 16 * 272; e += 256) {
        const int r = e / 272, j = e % 272; const int kp = k0 + j, qp = t0 + r;
        float s = -INFINITY;
        if (kp >= 0 && kp < SEQ && kp - qp <= 128 && qp - kp <= 128) {
            const float* kk = kr + (size_t)kp * 128 + kvh * 64; s = 0.f;
            for (int d = 0; d < 64; ++d) s = fmaf(sQ[r][d], kk[d], s);
        }
        sS[r][j] = s;
    }
    __syncthreads();
    {
        const int r = tid >> 4, l = tid & 15; const float sk = sink[hq];
        float m = sk;
        for (int j = l; j < 272; j += 16) m = fmaxf(m, sS[r][j]);
        for (int o = 8; o > 0; o >>= 1) m = fmaxf(m, __shfl_xor(m, o));
        float sum = 0.f;
        for (int j = l; j < 272; j += 16) { const float p = expf(sS[r][j] - m); sS[r][j] = p; sum += p; }
        for (int o = 8; o > 0; o >>= 1) sum += __shfl_xor(sum, o);
        sum += expf(sk - m);
        const float inv = 1.0f / sum;
        for (int j = l; j < 272; j += 16) sS[r][j] *= inv;
    }
    __syncthreads();
    for (int e = tid; e < 16 * 64; e += 256) {
        const int r = e >> 6, d = e & 63; float o = 0.f;
        for (int j = 0; j < 272; ++j) { const int kp = k0 + j; if (kp >= 0 && kp < SEQ) o = fmaf(sS[r][j], u[(size_t)kp * DIN + B_V + kvh * 64 + d], o); }
        const int t = t0 + r;
        y[(size_t)t * DMIX + 512 + hq * 64 + d] = o * siluf_(u[(size_t)t * DIN + B_Z + hq * 64 + d]);
    }
}

__global__ void __launch_bounds__(256) k_memattn(const float* __restrict__ u, const float* __restrict__ kvm, float* __restrict__ y) {
    const int t0 = blockIdx.x * 16, h = blockIdx.y;
    __shared__ float sQ[16][129], sS[16][257];
    const int tid = threadIdx.x;
    for (int e = tid; e < 16 * 128; e += 256) { const int r = e >> 7, c = e & 127; sQ[r][c] = u[(size_t)(t0 + r) * DIN + D_Q + h * 128 + c]; }
    __syncthreads();
    const float scale = 0.08838834764831845f;
    for (int e = tid; e < 16 * 256; e += 256) {
        const int r = e >> 8, j = e & 255; const float* kk = kvm + (size_t)j * 1024 + h * 128; float s = 0.f;
        for (int d = 0; d < 128; ++d) s = fmaf(sQ[r][d], kk[d], s);
        sS[r][j] = s * scale;
    }
    __syncthreads();
    {
        const int r = tid >> 4, l = tid & 15;
        float m = -INFINITY;
        for (int j = l; j < 256; j += 16) m = fmaxf(m, sS[r][j]);
        for (int o = 8; o > 0; o >>= 1) m = fmaxf(m, __shfl_xor(m, o));
        float sum = 0.f;
        for (int j = l; j < 256; j += 16) { const float p = expf(sS[r][j] - m); sS[r][j] = p; sum += p; }
        for (int o = 8; o > 0; o >>= 1) sum += __shfl_xor(sum, o);
        const float inv = 1.0f / sum;
        for (int j = l; j < 256; j += 16) sS[r][j] *= inv;
    }
    __syncthreads();
    for (int e = tid; e < 16 * 128; e += 256) {
        const int r = e >> 7, d = e & 127; float o = 0.f;
        for (int j = 0; j < 256; ++j) o = fmaf(sS[r][j], kvm[(size_t)j * 1024 + 512 + h * 128 + d], o);
        const int t = t0 + r;
        y[(size_t)t * DMIX + 1536 + h * 128 + d] = o * siluf_(u[(size_t)t * DIN + D_Z + h * 128 + d]);
    }
}
}

extern "C" void kernel_launch(void* const* d_in, const int* in_sizes, int n_in,
                              void* d_out, int out_size, void* d_ws, size_t ws_size,
                              hipStream_t stream) {
    using namespace nv;
    const float* x = (const float*)d_in[0];
    const float* mem = (const float*)d_in[1];
    const int* positions = (const int*)d_in[2];
    const float* norm_g = (const float*)d_in[3];
    const float* w_in = (const float*)d_in[4];
    const float* lb_logits = (const float*)d_in[5];
    const float* hgrn_norm_g = (const float*)d_in[6];
    const float* attn_sink = (const float*)d_in[7];
    const float* conv_w = (const float*)d_in[8];
    const float* gate_b = (const float*)d_in[9];
    const float* mlstm_norm_g = (const float*)d_in[10];
    const float* mem_norm_g = (const float*)d_in[11];
    const float* w_mem_kv = (const float*)d_in[12];
    const float* w_out = (const float*)d_in[13];
    const float* final_g = (const float*)d_in[14];
    float* out = (float*)d_out;

    float* ws = (float*)d_ws;
    size_t off = 0;
    auto take = [&](size_t n) { float* p = ws + off; off += (n + 63) & ~(size_t)63; return p; };
    float* xn = take((size_t)SEQ * DM);
    float* u = take((size_t)SEQ * DIN);
    float* qk = take((size_t)SEQ * 512);
    float* qr = take((size_t)SEQ * 512);
    float* kr = take((size_t)SEQ * 128);
    float* odir = take((size_t)2 * SEQ * 512);
    float* y = take((size_t)SEQ * DMIX);
    float* xc = take((size_t)SEQ * DM);
    float* xc2 = take((size_t)SEQ * DM);
    float* memn = take((size_t)MEML * DM);
    float* kvm = take((size_t)MEML * DM);
    float* lb = take(1024);
    float* cs = take((size_t)SEQ * 8);
    float* sn = take((size_t)SEQ * 8);

    k_lb<<<2, 256, 0, stream>>>(lb_logits, lb);
    for (int b = 0; b < BATCH; ++b) {
        const float* xb = x + (size_t)b * SEQ * DM;
        k_rope_tab<<<(SEQ * 8 + 255) / 256, 256, 0, stream>>>(positions + (size_t)b * SEQ, cs, sn);
        const float* xin = xb;
        for (int l = 0; l < 2; ++l) {
            float* xo = (l == 0) ? xc : xc2;
            k_rmsnorm<<<SEQ, 256, 0, stream>>>(xin, norm_g + l * DM, xn, DM);
            k_sgemm<<<dim3((DIN + 63) / 64, SEQ / 64), 256, 0, stream>>>(xn, w_in + (size_t)l * DM * DIN, u, nullptr, SEQ, DIN, DM, DM, DIN, DIN, 0);
            k_hgrn<<<32, 256, 0, stream>>>(u, lb + l * 512, odir);
            k_hgrn_comb<<<SEQ, 256, 0, stream>>>(odir, u, hgrn_norm_g + l * 512, y);
            k_rope<<<(SEQ * 640 + 255) / 256, 256, 0, stream>>>(u, cs, sn, qr, kr);
            k_winattn<<<dim3(SEQ / 16, 8), 256, 0, stream>>>(u, qr, kr, attn_sink + l * 8, y);
            k_conv<<<(SEQ * 512 + 255) / 256, 256, 0, stream>>>(u, conv_w + (size_t)l * 5 * 512, qk);
            k_mlstm<<<32, 256, 0, stream>>>(u, qk, gate_b + l * 16, odir);
            k_mlstm_comb<<<SEQ, 256, 0, stream>>>(odir, u, mlstm_norm_g + l * 512, y);
            k_rmsnorm<<<MEML, 256, 0, stream>>>(mem + (size_t)b * MEML * DM, mem_norm_g + l * DM, memn, DM);
            k_sgemm<<<dim3(1024 / 64, MEML / 64), 256, 0, stream>>>(memn, w_mem_kv + (size_t)l * DM * 1024, kvm, nullptr, MEML, 1024, DM, DM, 1024, 1024, 0);
            k_memattn<<<dim3(SEQ / 16, 4), 256, 0, stream>>>(u, kvm, y);
            k_sgemm<<<dim3(DM / 64, SEQ / 64), 256, 0, stream>>>(y, w_out + (size_t)l * DMIX * DM, xo, xin, SEQ, DM, DMIX, DMIX, DM, DM, DM);
            xin = xo;
        }
        k_rmsnorm<<<SEQ, 256, 0, stream>>>(xin, final_g, out + (size_t)b * SEQ * DM, DM);
    }
}
```

```cpp
#include <hip/hip_runtime.h>
#include <math.h>
#define MK_MULTI 1
namespace pg8 {
#define PG8_LAS __attribute__((address_space(3)))
typedef unsigned short bf16_t;
typedef short bf16x8 __attribute__((ext_vector_type(8)));
typedef float f32x4 __attribute__((ext_vector_type(4)));
typedef unsigned u32x4 __attribute__((ext_vector_type(4)));
constexpr int BM = 256, BK = 64, HALF = 128, HTB = HALF * BK * 2  , STAGE_BYTES = 8 * HTB, NXCD = 8, WGM = 8;

__host__ __device__ __forceinline__ int lds_byte(int r, int c) { const int st = (r >> 4) * 2 + (c >> 5), rr = r & 15, cc = c & 31, ob = rr * 64 + cc * 2; return st * 1024 + (ob ^ (((ob >> 9) & 1) << 5)); }
__host__ __device__ __forceinline__ void stage_rc(int b, int& R, int& C) { const int st = b / 1024, sb = b % 1024, swz = sb ^ (((sb >> 9) & 1) << 5); R = (st >> 1) * 16 + swz / 64; C = (st & 1) * 32 + (swz % 64) / 2; }
__host__ __device__ __forceinline__ int perm32(int rho) { const int n = rho >> 4, i = rho & 15; return 8 * (i >> 2) + 4 * n + (i & 3); }

struct Unit { int pm, pn; };
struct Gemm { const bf16_t* A; const bf16_t* Bt; int M, N, K, lda; };

struct StaticOrder {
    int nM, nN, nwg, G, c;
    __host__ __device__ void init(int M, int N, int G_, int c_) { nM = M / BM; nN = N / BM; nwg = nM * nN; G = G_; c = c_; }
    __host__ __device__ bool next(int i, Unit& u) const {
        const long L = (long)i * G + c; if (L >= nwg) return false;
        int wgid = (int)L; { const int q = nwg / NXCD, r = nwg % NXCD, xcd = wgid % NXCD, off = wgid / NXCD; wgid = (xcd < r ? xcd * (q + 1) : r * (q + 1) + (xcd - r) * q) + off; }
        const int nig = WGM * nN, gid = wgid / nig, fm = gid * WGM, gsz = (nM - fm) < WGM ? (nM - fm) : WGM;
        u.pm = fm + ((wgid % nig) % gsz); u.pn = (wgid % nig) / gsz; return true;
    }
    __device__ __forceinline__ void a_ready(const Unit&) const {}
    __device__ __forceinline__ void done(const Unit&) const {}
};

__device__ __forceinline__ unsigned cvt_pk_bf16(float lo, float hi) { unsigned r; asm volatile("v_cvt_pk_bf16_f32 %0, %1, %2" : "=v"(r) : "v"(lo), "v"(hi)); return r; }

__device__ __forceinline__ float bf2f_(unsigned h16) { return __uint_as_float(h16 << 16); }
struct EpiIn {
    static constexpr bool PERM = true, AFTER_DRAIN = false;
    bf16_t* O; int ldc; const float* ss;
    __device__ __forceinline__ void operator()(const f32x4 (&acc)[2][2][4][2], const Unit& u, int wr, int wc, int fr, int fq) const {
        const int row0 = u.pm * BM + wr * 64 + fr; const int col0 = u.pn * BM + wc * 32 + 8 * fq;
#pragma unroll
        for (int ai = 0; ai < 2; ++ai)
#pragma unroll
            for (int m = 0; m < 4; ++m) { const int r = row0 + ai * HALF + m * 16; const float rs = 1.0f / sqrtf(ss[r] * (1.0f / 1024.f) + 1e-6f);
                bf16_t* rowp = O + (size_t)r * ldc + col0;
#pragma unroll
                for (int bj = 0; bj < 2; ++bj) { const f32x4 v0 = acc[ai][bj][m][0] * rs, v1 = acc[ai][bj][m][1] * rs;
                    u32x4 w; w.x = cvt_pk_bf16(v0[0], v0[1]); w.y = cvt_pk_bf16(v0[2], v0[3]); w.z = cvt_pk_bf16(v1[0], v1[1]); w.w = cvt_pk_bf16(v1[2], v1[3]);
                    *(u32x4*)(rowp + bj * HALF) = w; } }
    }
};
struct EpiKv {
    static constexpr bool PERM = true, AFTER_DRAIN = false;
    bf16_t* O;
    __device__ __forceinline__ void operator()(const f32x4 (&acc)[2][2][4][2], const Unit& u, int wr, int wc, int fr, int fq) const {
        const int row0 = u.pm * BM + wr * 64 + fr; const int col0 = (u.pn & 3) * BM + wc * 32 + 8 * fq;
#pragma unroll
        for (int ai = 0; ai < 2; ++ai)
#pragma unroll
            for (int m = 0; m < 4; ++m) { const int r = row0 + ai * HALF + m * 16; bf16_t* rowp = O + (size_t)r * 1024 + col0;
#pragma unroll
                for (int bj = 0; bj < 2; ++bj) { const f32x4 v0 = acc[ai][bj][m][0], v1 = acc[ai][bj][m][1];
                    u32x4 w; w.x = cvt_pk_bf16(v0[0], v0[1]); w.y = cvt_pk_bf16(v0[2], v0[3]); w.z = cvt_pk_bf16(v1[0], v1[1]); w.w = cvt_pk_bf16(v1[2], v1[3]);
                    *(u32x4*)(rowp + bj * HALF) = w; } }
    }
};
typedef unsigned u32x2e __attribute__((ext_vector_type(2)));
template <int LAYER> struct EpiOut {
    static constexpr bool PERM = false, AFTER_DRAIN = false;
    const float* x0; bf16_t* hi; bf16_t* lo; float* x2; int xs, xo; float* ssn;
    __device__ __forceinline__ void operator()(const f32x4 (&acc)[2][2][4][2], const Unit& u, int wr, int wc, int fr, int fq) const {
        const int row0 = u.pm * BM + wr * 64 + fr; const int col0 = u.pn * BM + wc * 32 + 4 * fq;
#pragma unroll
        for (int ai = 0; ai < 2; ++ai)
#pragma unroll
            for (int m = 0; m < 4; ++m) { const int r = row0 + ai * HALF + m * 16; float part = 0.f;
#pragma unroll
                for (int bj = 0; bj < 2; ++bj)
#pragma unroll
                    for (int n = 0; n < 2; ++n) { const int c = col0 + bj * HALF + n * 16; const size_t e = (size_t)r * 1024 + c;
                        f32x4 xv;
                        if (LAYER == 0) xv = *(const f32x4*)(x0 + e);
                        else { const u32x2e h = *(const u32x2e*)(hi + e), l = *(const u32x2e*)(lo + e);
                            xv = (f32x4){bf2f_(h.x & 0xffffu) + bf2f_(l.x & 0xffffu), bf2f_(h.x >> 16) + bf2f_(l.x >> 16), bf2f_(h.y & 0xffffu) + bf2f_(l.y & 0xffffu), bf2f_(h.y >> 16) + bf2f_(l.y >> 16)}; }
                        const f32x4 v = xv + acc[ai][bj][m][n];
                        part += (v[0] * v[0] + v[1] * v[1]) + (v[2] * v[2] + v[3] * v[3]);
                        if (LAYER == 0) {
                            u32x2e hw; hw.x = cvt_pk_bf16(v[0], v[1]); hw.y = cvt_pk_bf16(v[2], v[3]);
                            const f32x4 d = v - (f32x4){bf2f_(hw.x & 0xffffu), bf2f_(hw.x >> 16), bf2f_(hw.y & 0xffffu), bf2f_(hw.y >> 16)};
                            u32x2e lw; lw.x = cvt_pk_bf16(d[0], d[1]); lw.y = cvt_pk_bf16(d[2], d[3]);
                            *(u32x2e*)(hi + e) = hw; *(u32x2e*)(lo + e) = lw;
                        } else { *(f32x4*)(x2 + (size_t)r * xs + xo + c) = v; } }
                part += __shfl_xor(part, 16); part += __shfl_xor(part, 32);
                if (fq == 0) atomicAdd(ssn + r, part); }
    }
};
struct KvOrder {
    int c, c0;
    __device__ bool next(int i, Unit& u) const { const int t = c - c0; if (i != 0 || t < 0 || t >= 32) return false; const int l = t >> 4; u.pm = l * 4 + ((t >> 2) & 3); u.pn = l * 4 + (t & 3); return true; }
    __device__ __forceinline__ void a_ready(const Unit&) const {}
    __device__ __forceinline__ void done(const Unit&) const {}
};

template <class Epi, class Sched, bool ALIGN_EPI = false, bool SP2 = false>
__device__ __forceinline__ void gemm_phase(PG8_LAS unsigned char* lds, const Gemm g, const Sched& S, const Epi& E) {
    int tid = threadIdx.x; asm volatile("" : "+v"(tid)); const int wid = __builtin_amdgcn_readfirstlane(tid >> 6), lane = tid & 63, wr = wid >> 2, wc = wid & 3, fr = lane & 15, fq = lane >> 4;
    const int K = g.K, nt = K / BK;
    unsigned voffA[2], voffB[2];
#pragma unroll
    for (int i = 0; i < 2; ++i) { int R, C; stage_rc(tid * 16 + i * 8192, R, C); const int Rb = Epi::PERM ? ((R & ~31) + perm32(R & 31)) : R;
        voffA[i] = (unsigned)(R * g.lda + C) * 2u; voffB[i] = (unsigned)(Rb * K + C) * 2u; }
    const size_t kstep = (size_t)(BK * 2);
    const size_t hstep = (size_t)HALF * K * 2, hstepA = (size_t)HALF * g.lda * 2;
    const size_t tstep = 2 * hstep, tstepA = 2 * hstepA;
    const unsigned ldsw = (unsigned)wid * 1024u;
    const int aoff = lds_byte(wr * 64 + fr, fq * 8), boff = lds_byte(wc * 32 + fr, fq * 8);
#define PG8_SA(b, h) (((b) * 2 + (h)) * HTB)
#define PG8_SB(b, h) ((4 + (b) * 2 + (h)) * HTB)
#define PG8_STAGE(bufoff, gbase, voff) do { _Pragma("unroll") for (int _i = 0; _i < 2; ++_i) \
        __builtin_amdgcn_global_load_lds((const unsigned*)((const char*)(gbase) + (voff)[_i]), (PG8_LAS unsigned*)(lds + (bufoff) + ldsw + _i * 8192), 16, 0, 0); } while (0)
#define PG8_LDA(dst, b, h) do { _Pragma("unroll") for (int m = 0; m < 4; ++m) _Pragma("unroll") for (int k = 0; k < 2; ++k) dst[m][k] = *(const PG8_LAS bf16x8*)(lds + PG8_SA(b, h) + aoff + m * 2048 + k * 1024); } while (0)
#define PG8_LDB(dst, b, h) do { _Pragma("unroll") for (int n = 0; n < 2; ++n) _Pragma("unroll") for (int k = 0; k < 2; ++k) dst[n][k] = *(const PG8_LAS bf16x8*)(lds + PG8_SB(b, h) + boff + n * 2048 + k * 1024); } while (0)
#define PG8_MMA(ai, bj, At, Bt) do { __builtin_amdgcn_s_setprio(1); _Pragma("unroll") for (int m = 0; m < 4; ++m) _Pragma("unroll") for (int n = 0; n < 2; ++n) _Pragma("unroll") for (int k = 0; k < 2; ++k) \
        acc[ai][bj][m][n] = __builtin_amdgcn_mfma_f32_16x16x32_bf16(Bt[n][k], At[m][k], acc[ai][bj][m][n], 0, 0, 0); __builtin_amdgcn_s_setprio(0); } while (0)
#define PG8_WAIT_V(n) asm volatile("s_waitcnt vmcnt(" #n ")" ::: "memory")
#define PG8_WAIT_L(n) asm volatile("s_waitcnt lgkmcnt(" #n ")" ::: "memory")
#define PG8_BAR __builtin_amdgcn_s_barrier()
#define PG8_SCHED __builtin_amdgcn_sched_barrier(0)
    Unit cur, nxt; int ui = 0;
    if (!S.next(0, cur)) return;
    f32x4 acc[2][2][4][2];
#pragma unroll
    for (int a = 0; a < 2; ++a)
#pragma unroll
        for (int b = 0; b < 2; ++b)
#pragma unroll
            for (int m = 0; m < 4; ++m)
#pragma unroll
                for (int n = 0; n < 2; ++n) acc[a][b][m][n] = (f32x4){0.f, 0.f, 0.f, 0.f};
    bf16x8 At[4][2], B0[2][2], B1[2][2];
    const char* cA = (const char*)g.A + (size_t)cur.pm * tstepA; const char* cB = (const char*)g.Bt + (size_t)cur.pn * tstep;
    S.a_ready(cur);
    if constexpr (SP2) {
        PG8_STAGE(PG8_SB(0, 0), cB, voffB); PG8_STAGE(PG8_SB(0, 1), cB + hstep, voffB); PG8_STAGE(PG8_SA(0, 0), cA, voffA); PG8_STAGE(PG8_SA(0, 1), cA + hstepA, voffA);
        if (wr == 1) PG8_BAR;
        PG8_WAIT_V(2); PG8_BAR;
        PG8_STAGE(PG8_SB(1, 0), cB + kstep, voffB); PG8_STAGE(PG8_SA(1, 0), cA + kstep, voffA); PG8_STAGE(PG8_SB(1, 1), cB + hstep + kstep, voffB);
        PG8_WAIT_V(6); PG8_BAR;
    } else {
        PG8_STAGE(PG8_SB(0, 0), cB, voffB); PG8_STAGE(PG8_SA(0, 0), cA, voffA); PG8_STAGE(PG8_SB(0, 1), cB + hstep, voffB); PG8_STAGE(PG8_SA(0, 1), cA + hstepA, voffA);
        if (wr == 1) PG8_BAR;
        PG8_WAIT_V(4); PG8_BAR;
        PG8_STAGE(PG8_SB(1, 0), cB + kstep, voffB); PG8_STAGE(PG8_SA(1, 0), cA + kstep, voffA); PG8_STAGE(PG8_SB(1, 1), cB + hstep + kstep, voffB);
        PG8_WAIT_V(6); PG8_BAR;
    }
    for (;;) {
        const bool has_next = S.next(ui + 1, nxt);
        const char* nA = has_next ? (const char*)g.A + (size_t)nxt.pm * tstepA : cA; const char* nB = has_next ? (const char*)g.Bt + (size_t)nxt.pn * tstep : cB;
        for (int t = 0; t < nt; t += 2) {
            const bool last = (t == nt - 2);
            const char* a1 = cA + (size_t)(t + 1) * kstep;
            const char* a2 = last ? nA : cA + (size_t)(t + 2) * kstep; const char* b2 = last ? nB : cB + (size_t)(t + 2) * kstep;
            const char* a3 = a2 + kstep; const char* b3 = b2 + kstep;
            if (last && has_next) S.a_ready(nxt);
            if constexpr (SP2) {
            PG8_LDB(B0, 0, 0); PG8_LDB(B1, 0, 1); PG8_SCHED; PG8_LDA(At, 0, 0); PG8_STAGE(PG8_SA(1, 1), a1 + hstepA, voffA);
            PG8_WAIT_V(8); PG8_WAIT_L(0); PG8_BAR; PG8_MMA(0, 0, At, B0); PG8_MMA(0, 1, At, B1); PG8_BAR; PG8_SCHED;
            PG8_LDA(At, 0, 1); PG8_STAGE(PG8_SB(0, 0), b2, voffB); PG8_STAGE(PG8_SB(0, 1), b2 + hstep, voffB); PG8_STAGE(PG8_SA(0, 0), a2, voffA);
            PG8_WAIT_V(8); PG8_WAIT_L(0); PG8_BAR; PG8_MMA(1, 0, At, B0); PG8_MMA(1, 1, At, B1); PG8_BAR; PG8_SCHED;
            PG8_LDB(B0, 1, 0); PG8_LDB(B1, 1, 1); PG8_SCHED; PG8_LDA(At, 1, 0); PG8_STAGE(PG8_SA(0, 1), a2 + hstepA, voffA);
            PG8_WAIT_V(8); PG8_WAIT_L(0); PG8_BAR; PG8_MMA(0, 0, At, B0); PG8_MMA(0, 1, At, B1); PG8_BAR; PG8_SCHED;
            PG8_LDA(At, 1, 1); PG8_STAGE(PG8_SB(1, 0), b3, voffB); PG8_STAGE(PG8_SB(1, 1), b3 + hstep, voffB); PG8_STAGE(PG8_SA(1, 0), a3, voffA);
            PG8_WAIT_V(8); PG8_WAIT_L(0); PG8_BAR; PG8_MMA(1, 0, At, B0); PG8_MMA(1, 1, At, B1); PG8_BAR; PG8_SCHED;
            } else {
            PG8_LDB(B0, 0, 0); PG8_SCHED; PG8_LDA(At, 0, 0); PG8_STAGE(PG8_SA(1, 1), a1 + hstepA, voffA);
            PG8_WAIT_L(8); PG8_BAR; PG8_WAIT_L(0); PG8_MMA(0, 0, At, B0); PG8_BAR; PG8_SCHED;
            PG8_LDB(B1, 0, 1); PG8_STAGE(PG8_SB(0, 0), b2, voffB);
            PG8_BAR; PG8_WAIT_L(0); PG8_MMA(0, 1, At, B1); PG8_BAR;
            PG8_LDA(At, 0, 1); PG8_STAGE(PG8_SA(0, 0), a2, voffA);
            PG8_BAR; PG8_WAIT_L(0); PG8_MMA(1, 0, At, B0); PG8_BAR; PG8_SCHED;
            PG8_STAGE(PG8_SB(0, 1), b2 + hstep, voffB);
            PG8_WAIT_V(6); PG8_BAR; PG8_MMA(1, 1, At, B1); PG8_BAR;
            PG8_LDB(B0, 1, 0); PG8_SCHED; PG8_LDA(At, 1, 0); PG8_STAGE(PG8_SA(0, 1), a2 + hstepA, voffA);
            PG8_WAIT_L(8); PG8_BAR; PG8_WAIT_L(0); PG8_MMA(0, 0, At, B0); PG8_BAR; PG8_SCHED;
            PG8_LDB(B1, 1, 1); PG8_STAGE(PG8_SB(1, 0), b3, voffB);
            PG8_BAR; PG8_WAIT_L(0); PG8_MMA(0, 1, At, B1); PG8_BAR;
            PG8_LDA(At, 1, 1); PG8_STAGE(PG8_SA(1, 0), a3, voffA);
            PG8_BAR; PG8_WAIT_L(0); PG8_MMA(1, 0, At, B0); PG8_BAR; PG8_SCHED;
            PG8_STAGE(PG8_SB(1, 1), b3 + hstep, voffB);
            PG8_WAIT_V(6); PG8_BAR; PG8_MMA(1, 1, At, B1); PG8_BAR;
            }
        }
        if constexpr (ALIGN_EPI) { if (wr == 0) PG8_BAR; }
        if constexpr (!Epi::AFTER_DRAIN) { E(acc, cur, wr, wc, fr, fq); S.done(cur); }
        if (!has_next) break;
#pragma unroll
        for (int a = 0; a < 2; ++a)
#pragma unroll
            for (int b = 0; b < 2; ++b)
#pragma unroll
                for (int m = 0; m < 4; ++m)
#pragma unroll
                    for (int n = 0; n < 2; ++n) acc[a][b][m][n] = (f32x4){0.f, 0.f, 0.f, 0.f};
        cur = nxt; cA = nA; cB = nB; ++ui;
        if constexpr (ALIGN_EPI) { if (wr == 1) PG8_BAR; }
    }
    PG8_WAIT_V(0);
    if constexpr (!ALIGN_EPI) { if (wr == 0) PG8_BAR; }
    PG8_BAR;
    if constexpr (Epi::AFTER_DRAIN) { E.fused(acc, cur, wr, wc, fr, fq, lds, wid, lane); S.done(cur); }
#undef PG8_SA
#undef PG8_SB
#undef PG8_STAGE
#undef PG8_LDA
#undef PG8_LDB
#undef PG8_MMA
#undef PG8_WAIT_V
#undef PG8_WAIT_L
#undef PG8_BAR
#undef PG8_SCHED
}
}
namespace mk {
#define LAS __attribute__((address_space(3)))
typedef unsigned short bf16_t;
typedef short bf16x8 __attribute__((ext_vector_type(8)));
typedef float f32x4 __attribute__((ext_vector_type(4)));
typedef unsigned u32x4 __attribute__((ext_vector_type(4)));
typedef unsigned u32x2 __attribute__((ext_vector_type(2)));

constexpr int SEQ = 4096, NU = 6912;
constexpr float EPS = 1e-6f;
constexpr int UA_Q = 0, UB_Q = 512, UC_V = 1024, UD_Q = 1536, UA_I = 2048, UA_FF = 2560, UA_FB = 3072, UA_Z = 3584;
constexpr int UB_K = 4096, UB_V = 4224, UB_Z = 4352, UC_Q = 4864, UC_K = 5120, UC_O = 5376, UC_Z = 5888, UD_Z = 6400;
constexpr int NSC = 16;
constexpr int SA_ELEMS = 128 * 128;
constexpr int SC_ROWS = 144, SC_ELEMS = SC_ROWS * 64;

struct MP {
    bf16_t* u;
    const float* gates;
    const bf16_t* kv;
    const float* cs; const float* sn;
    const float* lb;
    const float* hgrn_g; const float* sink; const float* conv_w; const float* gate_b; const float* mlstm_g;
    bf16_t* SA; float* DA;
    bf16_t* SC; float* CS;
    int nb;
};

__device__ __forceinline__ int otid() { int t = threadIdx.x; asm volatile("" : "+v"(t)); return t; }
__device__ __forceinline__ float bf2f(unsigned short h) { return __uint_as_float((unsigned)h << 16); }
__device__ __forceinline__ unsigned short f2bf(float f) { unsigned u = __float_as_uint(f); return (unsigned short)((u + 0x7fffu + ((u >> 16) & 1u)) >> 16); }
__device__ __forceinline__ unsigned pk2(float lo, float hi) { return (unsigned)f2bf(lo) | ((unsigned)f2bf(hi) << 16); }
__device__ __forceinline__ float sigm(float x) { return 1.0f / (1.0f + __expf(-x)); }
__device__ __forceinline__ float silu(float x) { return x / (1.0f + __expf(-x)); }

template <int K>
__device__ __forceinline__ void mma_nt(f32x4& acc, const LAS bf16_t* A, int lda, int m0, const LAS bf16_t* Bt, int ldb, int n0, int lane) {
    const LAS bf16_t* ap = A + (m0 + (lane & 15)) * lda + 8 * (lane >> 4);
    const LAS bf16_t* bp = Bt + (n0 + (lane & 15)) * ldb + 8 * (lane >> 4);
#pragma unroll
    for (int k0 = 0; k0 < K; k0 += 32) {
        const bf16x8 a = *(const LAS bf16x8*)(ap + k0);
        const bf16x8 b = *(const LAS bf16x8*)(bp + k0);
        acc = __builtin_amdgcn_mfma_f32_16x16x32_bf16(a, b, acc, 0, 0, 0);
    }
}
__device__ __forceinline__ float grp16_max(float v) { v = fmaxf(v, __shfl_xor(v, 1)); v = fmaxf(v, __shfl_xor(v, 2)); v = fmaxf(v, __shfl_xor(v, 4)); v = fmaxf(v, __shfl_xor(v, 8)); return v; }
__device__ __forceinline__ float grp16_sum(float v) { v += __shfl_xor(v, 1); v += __shfl_xor(v, 2); v += __shfl_xor(v, 4); v += __shfl_xor(v, 8); return v; }

__device__ __forceinline__ void d_item(const MP& p, LAS unsigned char* lds, int item) {
    const int tid = otid(), lane = tid & 63, w = __builtin_amdgcn_readfirstlane(tid >> 6);
    const int qt = item & 63, h = (item >> 6) & 3, b = item >> 8;
    const size_t row0 = (size_t)b * SEQ + qt * 64;
    LAS bf16_t* Qs = (LAS bf16_t*)lds;
    LAS bf16_t* KV = Qs + 64 * 136;
    LAS bf16_t* Ps = KV + 256 * 136;
    LAS float* red = (LAS float*)(Ps + 64 * 264);
    for (int c = tid; c < 64 * 16; c += 512) { const int r = c >> 4, ch = c & 15;
        const u32x4 v = *(const u32x4*)(p.u + (row0 + r) * NU + UD_Q + h * 128 + ch * 8); *(LAS u32x4*)(Qs + r * 136 + ch * 8) = v; }
    for (int c = tid; c < 256 * 16; c += 512) { const int r = c >> 4, ch = c & 15;
        const u32x4 v = *(const u32x4*)(p.kv + ((size_t)b * 256 + r) * 1024 + h * 128 + ch * 8); *(LAS u32x4*)(KV + r * 136 + ch * 8) = v; }
    __syncthreads();
    const int mb = w >> 1, nh = w & 1, q4 = lane >> 4, c16 = lane & 15;
    f32x4 s[8];
#pragma unroll
    for (int j = 0; j < 8; ++j) { s[j] = (f32x4){0.f, 0.f, 0.f, 0.f}; mma_nt<128>(s[j], Qs, 136, mb * 16, KV, 136, nh * 128 + j * 16, lane); }
    const float scale = 0.08838834764831845f;
    float mx[4];
#pragma unroll
    for (int i = 0; i < 4; ++i) { float m = -INFINITY;
#pragma unroll
        for (int j = 0; j < 8; ++j) { s[j][i] *= scale; m = fmaxf(m, s[j][i]); }
        mx[i] = grp16_max(m); }
    if (c16 == 0) {
#pragma unroll
        for (int i = 0; i < 4; ++i) red[nh * 64 + mb * 16 + 4 * q4 + i] = mx[i]; }
    __syncthreads();
#pragma unroll
    for (int i = 0; i < 4; ++i) { const int r = mb * 16 + 4 * q4 + i; const float m = fmaxf(red[r], red[64 + r]); float sum = 0.f;
#pragma unroll
        for (int j = 0; j < 8; ++j) { const float e = __expf(s[j][i] - m); sum += e; Ps[r * 264 + nh * 128 + j * 16 + c16] = f2bf(e); }
        sum = grp16_sum(sum);
        if (c16 == 0) red[128 + nh * 64 + r] = sum; }
    __syncthreads();
    for (int c = tid; c < 256 * 16; c += 512) { const int j = c & 255, ch = c >> 8;
        const u32x4 v = *(const u32x4*)(p.kv + ((size_t)b * 256 + j) * 1024 + 512 + h * 128 + ch * 8);
        LAS bf16_t* d = KV + (ch * 8) * 264 + j;
        d[0 * 264] = (bf16_t)(v.x & 0xffffu); d[1 * 264] = (bf16_t)(v.x >> 16); d[2 * 264] = (bf16_t)(v.y & 0xffffu); d[3 * 264] = (bf16_t)(v.y >> 16);
        d[4 * 264] = (bf16_t)(v.z & 0xffffu); d[5 * 264] = (bf16_t)(v.z >> 16); d[6 * 264] = (bf16_t)(v.w & 0xffffu); d[7 * 264] = (bf16_t)(v.w >> 16); }
    __syncthreads();
    f32x4 o[4];
#pragma unroll
    for (int n = 0; n < 4; ++n) { o[n] = (f32x4){0.f, 0.f, 0.f, 0.f}; mma_nt<256>(o[n], Ps, 264, mb * 16, KV, 264, (nh * 4 + n) * 16, lane); }
#pragma unroll
    for (int i = 0; i < 4; ++i) { const int r = mb * 16 + 4 * q4 + i; const float inv = 1.0f / (red[128 + r] + red[192 + r]);
        bf16_t* urow = p.u + (row0 + r) * NU;
#pragma unroll
        for (int n = 0; n < 4; ++n) { const int col = h * 128 + (nh * 4 + n) * 16 + c16;
            const float z = bf2f(urow[UD_Z + col]); urow[UD_Q + col] = f2bf(o[n][i] * inv * silu(z)); } }
    __syncthreads();
}

__device__ __forceinline__ void b_item(const MP& p, LAS unsigned char* lds, int item) {
    const int tid = otid(), lane = tid & 63, w = __builtin_amdgcn_readfirstlane(tid >> 6);
    const int qt = item & 63, kvh = (item >> 6) & 1, b = item >> 7;
    const int t0 = qt * 64; const size_t brow = (size_t)b * SEQ;
    LAS bf16_t* Ks = (LAS bf16_t*)lds;
    LAS bf16_t* Vt = Ks + 320 * 72;
    LAS bf16_t* Qs = Vt + 64 * 328;
    LAS bf16_t* Ps = Qs + 64 * 72;
    LAS float* red = (LAS float*)(Ps + 64 * 328);
    const int k0 = t0 - 128;
    for (int c = tid; c < 320 * 4; c += 512) { const int j = c >> 2, part = c & 3; const int kp = k0 + j;
        u32x4 a = (u32x4){0u, 0u, 0u, 0u}, bb = a;
        if (kp >= 0 && kp < SEQ) {
            const bf16_t* src = p.u + (brow + kp) * NU + UB_K + kvh * 64 + part * 16;
            a = *(const u32x4*)src; bb = *(const u32x4*)(src + 8);
            if (part == 0) {
                const float* cs = p.cs + (brow + kp) * 8; const float* sn = p.sn + (brow + kp) * 8;
                float x1[8], x2[8];
                x1[0] = bf2f(a.x & 0xffffu); x1[1] = bf2f(a.x >> 16); x1[2] = bf2f(a.y & 0xffffu); x1[3] = bf2f(a.y >> 16); x1[4] = bf2f(a.z & 0xffffu); x1[5] = bf2f(a.z >> 16); x1[6] = bf2f(a.w & 0xffffu); x1[7] = bf2f(a.w >> 16);
                x2[0] = bf2f(bb.x & 0xffffu); x2[1] = bf2f(bb.x >> 16); x2[2] = bf2f(bb.y & 0xffffu); x2[3] = bf2f(bb.y >> 16); x2[4] = bf2f(bb.z & 0xffffu); x2[5] = bf2f(bb.z >> 16); x2[6] = bf2f(bb.w & 0xffffu); x2[7] = bf2f(bb.w >> 16);
                float r1[8], r2[8];
#pragma unroll
                for (int e = 0; e < 8; ++e) { const float cc = cs[e], ss = sn[e]; r1[e] = x1[e] * cc - x2[e] * ss; r2[e] = x2[e] * cc + x1[e] * ss; }
                a = (u32x4){pk2(r1[0], r1[1]), pk2(r1[2], r1[3]), pk2(r1[4], r1[5]), pk2(r1[6], r1[7])};
                bb = (u32x4){pk2(r2[0], r2[1]), pk2(r2[2], r2[3]), pk2(r2[4], r2[5]), pk2(r2[6], r2[7])};
            }
        }
        *(LAS u32x4*)(Ks + j * 72 + part * 16) = a; *(LAS u32x4*)(Ks + j * 72 + part * 16 + 8) = bb; }
    for (int c = tid; c < 320 * 8; c += 512) { const int j = c % 320, ch = c / 320; const int kp = k0 + j;
        u32x4 v = (u32x4){0u, 0u, 0u, 0u};
        if (kp >= 0 && kp < SEQ) v = *(const u32x4*)(p.u + (brow + kp) * NU + UB_V + kvh * 64 + ch * 8);
        LAS bf16_t* d = Vt + (ch * 8) * 328 + j;
        d[0 * 328] = (bf16_t)(v.x & 0xffffu); d[1 * 328] = (bf16_t)(v.x >> 16); d[2 * 328] = (bf16_t)(v.y & 0xffffu); d[3 * 328] = (bf16_t)(v.y >> 16);
        d[4 * 328] = (bf16_t)(v.z & 0xffffu); d[5 * 328] = (bf16_t)(v.z >> 16); d[6 * 328] = (bf16_t)(v.w & 0xffffu); d[7 * 328] = (bf16_t)(v.w >> 16); }
    const int mb = w >> 1, nh = w & 1, q4 = lane >> 4, c16 = lane & 15;
    for (int g = 0; g < 4; ++g) {
        const int hq = kvh * 4 + g;
        for (int c = tid; c < 64 * 4; c += 512) { const int r = c >> 2, part = c & 3;
            const bf16_t* src = p.u + (brow + t0 + r) * NU + UB_Q + hq * 64 + part * 16;
            u32x4 a = *(const u32x4*)src, bb = *(const u32x4*)(src + 8);
            if (part == 0) {
                const float* cs = p.cs + (brow + t0 + r) * 8; const float* sn = p.sn + (brow + t0 + r) * 8;
                float x1[8], x2[8];
                x1[0] = bf2f(a.x & 0xffffu); x1[1] = bf2f(a.x >> 16); x1[2] = bf2f(a.y & 0xffffu); x1[3] = bf2f(a.y >> 16); x1[4] = bf2f(a.z & 0xffffu); x1[5] = bf2f(a.z >> 16); x1[6] = bf2f(a.w & 0xffffu); x1[7] = bf2f(a.w >> 16);
                x2[0] = bf2f(bb.x & 0xffffu); x2[1] = bf2f(bb.x >> 16); x2[2] = bf2f(bb.y & 0xffffu); x2[3] = bf2f(bb.y >> 16); x2[4] = bf2f(bb.z & 0xffffu); x2[5] = bf2f(bb.z >> 16); x2[6] = bf2f(bb.w & 0xffffu); x2[7] = bf2f(bb.w >> 16);
                float r1[8], r2[8];
#pragma unroll
                for (int e = 0; e < 8; ++e) { const float cc = cs[e], ss = sn[e]; r1[e] = x1[e] * cc - x2[e] * ss; r2[e] = x2[e] * cc + x1[e] * ss; }
                a = (u32x4){pk2(r1[0], r1[1]), pk2(r1[2], r1[3]), pk2(r1[4], r1[5]), pk2(r1[6], r1[7])};
                bb = (u32x4){pk2(r2[0], r2[1]), pk2(r2[2], r2[3]), pk2(r2[4], r2[5]), pk2(r2[6], r2[7])};
            }
            *(LAS u32x4*)(Qs + r * 72 + part * 16) = a; *(LAS u32x4*)(Qs + r * 72 + part * 16 + 8) = bb; }
        __syncthreads();
        f32x4 s[10];
#pragma unroll
        for (int j = 0; j < 10; ++j) { s[j] = (f32x4){0.f, 0.f, 0.f, 0.f}; mma_nt<64>(s[j], Qs, 72, mb * 16, Ks, 72, nh * 160 + j * 16, lane); }
        const float sk = p.sink[hq];
        float mx[4];
#pragma unroll
        for (int i = 0; i < 4; ++i) { const int qp = t0 + mb * 16 + 4 * q4 + i; float m = -INFINITY;
#pragma unroll
            for (int j = 0; j < 10; ++j) { const int kp = k0 + nh * 160 + j * 16 + c16; const int df = kp - qp;
                const bool ok = (kp >= 0) && (kp < SEQ) && (df <= 128) && (df >= -128);
                const float v = ok ? s[j][i] * 0.125f : -INFINITY; s[j][i] = v; m = fmaxf(m, v); }
            mx[i] = grp16_max(m); }
        if (c16 == 0) {
#pragma unroll
            for (int i = 0; i < 4; ++i) red[nh * 64 + mb * 16 + 4 * q4 + i] = mx[i]; }
        __syncthreads();
#pragma unroll
        for (int i = 0; i < 4; ++i) { const int r = mb * 16 + 4 * q4 + i; const float m = fmaxf(fmaxf(red[r], red[64 + r]), sk); float sum = 0.f;
#pragma unroll
            for (int j = 0; j < 10; ++j) { const float e = __expf(s[j][i] - m); sum += e; Ps[r * 328 + nh * 160 + j * 16 + c16] = f2bf(e); }
            sum = grp16_sum(sum);
            if (c16 == 0) { red[128 + nh * 64 + r] = sum; if (nh == 0) red[256 + r] = __expf(sk - m); } }
        __syncthreads();
        f32x4 o[2];
#pragma unroll
        for (int n = 0; n < 2; ++n) { o[n] = (f32x4){0.f, 0.f, 0.f, 0.f}; mma_nt<320>(o[n], Ps, 328, mb * 16, Vt, 328, (nh * 2 + n) * 16, lane); }
#pragma unroll
        for (int i = 0; i < 4; ++i) { const int r = mb * 16 + 4 * q4 + i; const float inv = 1.0f / (red[128 + r] + red[192 + r] + red[256 + r]);
            bf16_t* urow = p.u + (brow + t0 + r) * NU;
#pragma unroll
            for (int n = 0; n < 2; ++n) { const int col = hq * 64 + (nh * 2 + n) * 16 + c16;
                const float z = bf2f(urow[UB_Z + col]); urow[UB_Q + col] = f2bf(o[n][i] * inv * silu(z)); } }
        __syncthreads();
    }
}

struct ALds {
    LAS bf16_t *Qt, *Kt, *Qh, *KhT, *Vt, *Pm, *St; LAS float *seg, *Dl, *stats;
};
__device__ __forceinline__ ALds a_lds(LAS unsigned char* lds) {
    ALds L; L.Qt = (LAS bf16_t*)lds; L.Kt = L.Qt + 64 * 136; L.Qh = L.Kt + 64 * 136; L.KhT = L.Qh + 64 * 136; L.Vt = L.KhT + 128 * 72; L.Pm = L.Vt + 128 * 72;
    L.St = L.Pm + 64 * 72; L.seg = (LAS float*)(L.St + 128 * 136); L.Dl = L.seg + 512; L.stats = L.Dl + 128; return L;
}
template <int MODE>
__device__ __forceinline__ float a_gates(const MP& p, const ALds& L, size_t tbase, int h, int dir, float carry) {
    const int tid = otid(), d = tid & 127, sg = tid >> 7;
    const float lbv = p.lb[h * 128 + d];
    unsigned off = (unsigned)((tbase + sg * 16) * NU + h * 128 + d);
    float g[16], kk[16]; unsigned qp[8], vp[8];
#pragma unroll
    for (int k = 0; k < 16; ++k) {
        asm volatile("" : "+v"(off));
        const float z = bf2f(p.u[off + (dir ? UA_FB : UA_FF)]);
        const unsigned vv = p.u[off + UA_I];
        if (k & 1) vp[k >> 1] |= vv << 16; else vp[k >> 1] = vv;
        if (MODE == 1) { const unsigned qq = p.u[off + UA_Q]; if (k & 1) qp[k >> 1] |= qq << 16; else qp[k >> 1] = qq; }
        const float f = lbv + (1.f - lbv) * sigm(z);
        g[k] = __logf(f); kk[k] = 1.f - f;
        off += NU; }
    if (dir == 0) {
#pragma unroll
        for (int k = 1; k < 16; ++k) g[k] += g[k - 1];
        L.seg[sg * 128 + d] = g[15];
    } else {
#pragma unroll
        for (int k = 14; k >= 0; --k) g[k] += g[k + 1];
        L.seg[sg * 128 + d] = g[0];
    }
    __syncthreads();
    const float s0 = L.seg[d], s1 = L.seg[128 + d], s2 = L.seg[256 + d], s3 = L.seg[384 + d];
    const float tot = (s0 + s1) + (s2 + s3);
    float pre;
    if (dir == 0) pre = (sg > 0 ? s0 : 0.f) + (sg > 1 ? s1 : 0.f) + (sg > 2 ? s2 : 0.f);
    else pre = (sg < 3 ? s3 : 0.f) + (sg < 2 ? s2 : 0.f) + (sg < 1 ? s1 : 0.f);
    const float ref = dir == 0 ? (s0 + s1) : (s2 + s3);
    unsigned khp[8];
#pragma unroll
    for (int k = 0; k < 16; ++k) { const float bk = pre + g[k];
        const int pp = sg * 16 + k;
        const unsigned khb = f2bf(kk[k] * __expf((tot - bk) + carry));
        if (k & 1) khp[k >> 1] |= khb << 16; else khp[k >> 1] = khb;
        if (MODE == 1) {
            const float qv = bf2f((unsigned short)((k & 1) ? (qp[k >> 1] >> 16) : (qp[k >> 1] & 0xffffu)));
            L.Qt[pp * 136 + d] = f2bf(qv * __expf(bk - ref));
            L.Kt[pp * 136 + d] = f2bf(kk[k] * __expf(ref - bk));
            L.Qh[pp * 136 + d] = f2bf(qv * __expf(bk));
        } }
    *(LAS u32x4*)(L.KhT + d * 72 + sg * 16) = (u32x4){khp[0], khp[1], khp[2], khp[3]};
    *(LAS u32x4*)(L.KhT + d * 72 + sg * 16 + 8) = (u32x4){khp[4], khp[5], khp[6], khp[7]};
    if (MODE == 1 && sg == 0) L.Dl[d] = __expf(tot);
    *(LAS u32x4*)(L.Vt + d * 72 + sg * 16) = (u32x4){vp[0], vp[1], vp[2], vp[3]};
    *(LAS u32x4*)(L.Vt + d * 72 + sg * 16 + 8) = (u32x4){vp[4], vp[5], vp[6], vp[7]};
    return tot;
}

__device__ __forceinline__ void a_pass1(const MP& p, LAS unsigned char* lds, int item) {
    const int tid = otid(), lane = tid & 63, w = __builtin_amdgcn_readfirstlane(tid >> 6);
    const int dir = item & 1, sc = (item >> 1) & 15, h = (item >> 5) & 3, b = item >> 7;
    const ALds L = a_lds(lds);
    const int q4 = lane >> 4, c16 = lane & 15;
    f32x4 S[8];
#pragma unroll
    for (int j = 0; j < 8; ++j) S[j] = (f32x4){0.f, 0.f, 0.f, 0.f};
    float carry = 0.f;
    for (int ci = 0; ci < 4; ++ci) {
        const int cc = dir ? ci : 3 - ci;
        const size_t tbase = (size_t)b * SEQ + sc * 256 + cc * 64;
        const float tot = a_gates<0>(p, L, tbase, h, dir, carry);
        carry += tot;
        __syncthreads();
#pragma unroll
        for (int j = 0; j < 8; ++j) mma_nt<64>(S[j], L.KhT, 72, j * 16, L.Vt, 72, w * 16, lane);
        __syncthreads();
    }
    const size_t sidx = ((size_t)(dir * p.nb * 4 + b * 4 + h) * NSC + sc);
    bf16_t* dst = p.SA + sidx * SA_ELEMS;
#pragma unroll
    for (int j = 0; j < 8; ++j) {
        *(u32x2*)(dst + (size_t)(w * 16 + c16) * 128 + j * 16 + 4 * q4) = (u32x2){pk2(S[j][0], S[j][1]), pk2(S[j][2], S[j][3])}; }
    if (tid < 128) p.DA[sidx * 128 + tid] = __expf(carry);
}

__device__ __forceinline__ void a_scan_unit(const MP& p, int unit) {
    const int e4 = unit & 4095, seq = unit >> 12;
    const int dir = seq / (p.nb * 4);
    const int dk = (e4 * 4) & 127;
    float S0 = 0.f, S1 = 0.f, S2 = 0.f, S3 = 0.f;
    for (int i = 0; i < NSC; ++i) {
        const int sc = dir ? NSC - 1 - i : i;
        bf16_t* ptr = p.SA + ((size_t)seq * NSC + sc) * SA_ELEMS + e4 * 4;
        const u32x2 v = *(const u32x2*)ptr;
        const f32x4 D = *(const f32x4*)(p.DA + ((size_t)seq * NSC + sc) * 128 + dk);
        *(u32x2*)ptr = (u32x2){pk2(S0, S1), pk2(S2, S3)};
        S0 = D[0] * S0 + bf2f(v.x & 0xffffu); S1 = D[1] * S1 + bf2f(v.x >> 16); S2 = D[2] * S2 + bf2f(v.y & 0xffffu); S3 = D[3] * S3 + bf2f(v.y >> 16);
    }
}

__device__ __forceinline__ void a_pass3(const MP& p, LAS unsigned char* lds, int item) {
    const int tid = otid(), lane = tid & 63, w = __builtin_amdgcn_readfirstlane(tid >> 6);
    const int sc = item & 15, h = (item >> 4) & 3, b = item >> 6;
    const ALds L = a_lds(lds);
    const int q4 = lane >> 4, c16 = lane & 15, mb2 = w >> 1, nh = w & 1;
    f32x4 O[4][4];
#pragma unroll
    for (int a = 0; a < 4; ++a)
#pragma unroll
        for (int m = 0; m < 4; ++m) O[a][m] = (f32x4){0.f, 0.f, 0.f, 0.f};
#pragma unroll 1
    for (int dir = 0; dir < 2; ++dir) {
        const size_t sidx = ((size_t)(dir * p.nb * 4 + b * 4 + h) * NSC + sc);
        const bf16_t* sg = p.SA + sidx * SA_ELEMS;
        for (int c = tid; c < 128 * 16; c += 512) { const int r = c >> 4, ch = c & 15; *(LAS u32x4*)(L.St + r * 136 + ch * 8) = *(const u32x4*)(sg + r * 128 + ch * 8); }
        f32x4 S[8];
#pragma unroll
        for (int j = 0; j < 8; ++j) { const u32x2 v = *(const u32x2*)(sg + (size_t)(w * 16 + c16) * 128 + j * 16 + 4 * q4);
            S[j] = (f32x4){bf2f(v.x & 0xffffu), bf2f(v.x >> 16), bf2f(v.y & 0xffffu), bf2f(v.y >> 16)}; }
#pragma unroll 1
        for (int ci = 0; ci < 4; ++ci) {
            const int cc = dir ? 3 - ci : ci;
            const size_t tbase = (size_t)b * SEQ + sc * 256 + cc * 64;
            (void)a_gates<1>(p, L, tbase, h, dir, 0.f);
            __syncthreads();
#pragma unroll
            for (int n = 0; n < 2; ++n) { f32x4 a = (f32x4){0.f, 0.f, 0.f, 0.f}; const int nb16 = nh * 2 + n;
                mma_nt<128>(a, L.Qt, 136, mb2 * 16, L.Kt, 136, nb16 * 16, lane);
#pragma unroll
                for (int i = 0; i < 4; ++i) { const int pt = mb2 * 16 + 4 * q4 + i, ps = nb16 * 16 + c16;
                    const bool keep = dir ? (ps >= pt) : (ps <= pt);
                    L.Pm[pt * 72 + ps] = f2bf(keep ? a[i] : 0.f); } }
            __syncthreads();
            f32x4 T[4];
#pragma unroll
            for (int m = 0; m < 4; ++m) { T[m] = (f32x4){0.f, 0.f, 0.f, 0.f};
                mma_nt<64>(T[m], L.Pm, 72, m * 16, L.Vt, 72, w * 16, lane);
                mma_nt<128>(T[m], L.Qh, 136, m * 16, L.St, 136, w * 16, lane);
                __builtin_amdgcn_sched_barrier(0); }
            if (cc == 0) {
#pragma unroll
                for (int m = 0; m < 4; ++m) O[0][m] += T[m];
            } else if (cc == 1) {
#pragma unroll
                for (int m = 0; m < 4; ++m) O[1][m] += T[m];
            } else if (cc == 2) {
#pragma unroll
                for (int m = 0; m < 4; ++m) O[2][m] += T[m];
            } else {
#pragma unroll
                for (int m = 0; m < 4; ++m) O[3][m] += T[m];
            }
#pragma unroll
            for (int j = 0; j < 8; ++j) { const f32x4 D = *(const LAS f32x4*)(L.Dl + j * 16 + 4 * q4);
                S[j] = S[j] * D;
                mma_nt<64>(S[j], L.KhT, 72, j * 16, L.Vt, 72, w * 16, lane);
                *(LAS u32x2*)(L.St + (w * 16 + c16) * 136 + j * 16 + 4 * q4) = (u32x2){pk2(S[j][0], S[j][1]), pk2(S[j][2], S[j][3])};
                __builtin_amdgcn_sched_barrier(0); }
            __syncthreads();
        }
    }
    int q4e = q4 * 4; asm volatile("" : "+v"(q4e));
#pragma unroll
    for (int a = 0; a < 4; ++a)
#pragma unroll
        for (int m = 0; m < 4; ++m)
#pragma unroll
            for (int i = 0; i < 4; ++i) { const float v = O[a][m][i]; const float s = grp16_sum(v * v);
                if (c16 == 0) L.stats[w * 256 + a * 64 + m * 16 + q4e + i] = s; }
    __syncthreads();
    const float gn = p.hgrn_g[h * 128 + w * 16 + c16];
    const unsigned ebase = (unsigned)(((size_t)b * SEQ + sc * 256) * NU + h * 128 + w * 16 + c16);
#pragma unroll
    for (int a = 0; a < 4; ++a)
#pragma unroll
        for (int m = 0; m < 4; ++m)
#pragma unroll
            for (int i = 0; i < 4; ++i) { const int tl = a * 64 + m * 16 + q4e + i;
                float ss = 0.f;
#pragma unroll
                for (int ww = 0; ww < 8; ++ww) ss += L.stats[ww * 256 + tl];
                const float rs = 1.0f / sqrtf(ss * (1.0f / 128.f) + EPS);
                unsigned eo = ebase + (unsigned)tl * NU; asm volatile("" : "+v"(eo));
                const float z = bf2f(p.u[eo + UA_Z]);
                p.u[eo + UA_Q] = f2bf(O[a][m][i] * rs * gn * silu(z));
                if (i == 3) asm volatile("" ::: "memory"); }
    __syncthreads();
}

struct CLds {
    LAS bf16_t *Qc, *Kc, *Qg, *KhT, *Vt, *Pw, *St, *raw; LAS float *sc;
};
__device__ __forceinline__ CLds c_lds(LAS unsigned char* lds) {
    CLds L; L.Qc = (LAS bf16_t*)lds; L.Kc = L.Qc + 64 * 72; L.Qg = L.Kc + 64 * 72; L.KhT = L.Qg + 64 * 72; L.Vt = L.KhT + 64 * 72; L.Pw = L.Vt + 144 * 72; L.St = L.Pw + 64 * 72;
    L.raw = L.St + 144 * 72; L.sc = (LAS float*)(L.raw + 68 * 136); return L;
}
__device__ __forceinline__ float log_sigmoid(float x) { return fminf(x, 0.f) - log1pf(__expf(-fabsf(x))); }

template <bool WANT_Q>
__device__ __forceinline__ void c_load_qkv(const MP& p, const CLds& L, int b, int tl0  , int h) {
    const int tid = otid();
    const size_t brow = (size_t)b * SEQ;
    for (int c = tid; c < 68 * 16; c += 512) { const int r = c >> 4, ch = c & 15; const int tl = tl0 - 2 + r;
        u32x4 v = (u32x4){0u, 0u, 0u, 0u};
        if (tl >= 0 && tl < SEQ) v = *(const u32x4*)(p.u + (brow + tl) * NU + (ch < 8 ? UC_Q + h * 64 + ch * 8 : UC_K + h * 64 + (ch - 8) * 8));
        *(LAS u32x4*)(L.raw + r * 136 + ch * 8) = v; }
    {
        const int d = tid & 127, sg = tid >> 7;
        unsigned off = (unsigned)((brow + tl0 + sg * 16) * NU + UC_V + h * 128 + d);
        unsigned vp[8];
#pragma unroll
        for (int k = 0; k < 16; ++k) { asm volatile("" : "+v"(off)); const unsigned vv = p.u[off]; if (k & 1) vp[k >> 1] |= vv << 16; else vp[k >> 1] = vv; off += NU; }
        *(LAS u32x4*)(L.Vt + d * 72 + sg * 16) = (u32x4){vp[0], vp[1], vp[2], vp[3]};
        *(LAS u32x4*)(L.Vt + d * 72 + sg * 16 + 8) = (u32x4){vp[4], vp[5], vp[6], vp[7]};
        if (tid < 16 * 8) { const int r = 128 + (tid >> 3), ch = tid & 7; const unsigned one = (r == 128) ? 0x3f803f80u : 0u; *(LAS u32x4*)(L.Vt + r * 72 + ch * 8) = (u32x4){one, one, one, one}; }
    }
    __syncthreads();
    for (int e = tid; e < 64 * 128; e += 512) { const int pp = e >> 7, ch = e & 127;
        if (!WANT_Q && ch < 64) continue;
        const int wc = (ch < 64) ? (h * 64 + ch) : (256 + h * 64 + (ch - 64));
        float s = 0.f;
#pragma unroll
        for (int j = 0; j < 5; ++j) s = fmaf(bf2f(L.raw[(pp + j) * 136 + ch]), p.conv_w[j * 512 + wc], s);
        s = silu(s);
        if (ch < 64) L.Qc[pp * 72 + ch] = f2bf(s * 0.125f); else L.Kc[pp * 72 + (ch - 64)] = f2bf(s); }
}

__device__ __forceinline__ void c_pass1(const MP& p, LAS unsigned char* lds, int item) {
    const int tid = otid(), lane = tid & 63, w = __builtin_amdgcn_readfirstlane(tid >> 6);
    const int dir = item & 1, sc = (item >> 1) & 15, h = (item >> 5) & 3, b = item >> 7;
    const CLds L = c_lds(lds);
    const int q4 = lane >> 4, c16 = lane & 15;
    const size_t brow = (size_t)b * SEQ; const int tls = sc * 256;
    if (w == 0) {
        const float bi = p.gate_b[dir * 4 + h], bf = p.gate_b[8 + dir * 4 + h];
        float lf[4], li[4];
#pragma unroll
        for (int k = 0; k < 4; ++k) { const float* gr = p.gates + (brow + tls + lane * 4 + k) * 16; li[k] = gr[dir * 4 + h] + bi; lf[k] = log_sigmoid(gr[8 + dir * 4 + h] + bf); }
        const float tot4 = (lf[0] + lf[1]) + (lf[2] + lf[3]);
        float incl = tot4;
        if (dir == 0) {
#pragma unroll
            for (int o = 1; o < 64; o <<= 1) { const float t = __shfl_down(incl, o); if (lane + o < 64) incl += t; }
        } else {
#pragma unroll
            for (int o = 1; o < 64; o <<= 1) { const float t = __shfl_up(incl, o); if (lane >= o) incl += t; }
        }
        const float after_lane = incl - tot4;
        float E[4];
        if (dir == 0) { E[3] = after_lane; E[2] = E[3] + lf[3]; E[1] = E[2] + lf[2]; E[0] = E[1] + lf[1]; }
        else { E[0] = after_lane; E[1] = E[0] + lf[0]; E[2] = E[1] + lf[1]; E[3] = E[2] + lf[2]; }
        float a[4], amax = -INFINITY;
#pragma unroll
        for (int k = 0; k < 4; ++k) { a[k] = E[k] + li[k]; amax = fmaxf(amax, a[k]); }
#pragma unroll
        for (int o = 32; o > 0; o >>= 1) amax = fmaxf(amax, __shfl_xor(amax, o));
        float Btot = tot4;
#pragma unroll
        for (int o = 32; o > 0; o >>= 1) Btot += __shfl_xor(Btot, o);
#pragma unroll
        for (int k = 0; k < 4; ++k) L.sc[192 + lane * 4 + k] = __expf(a[k] - amax);
        if (lane == 0) { L.sc[576 + 2] = amax; L.sc[576 + 3] = Btot; }
    }
    f32x4 S[5];
#pragma unroll
    for (int j = 0; j < 5; ++j) S[j] = (f32x4){0.f, 0.f, 0.f, 0.f};
    for (int cc = 0; cc < 4; ++cc) {
        c_load_qkv<false>(p, L, b, tls + cc * 64, h);
        __syncthreads();
        for (int e = tid; e < 64 * 64; e += 512) { const int pp = e & 63, dk = e >> 6;
            L.KhT[dk * 72 + pp] = f2bf(L.sc[192 + cc * 64 + pp] * bf2f(L.Kc[pp * 72 + dk])); }
        __syncthreads();
#pragma unroll
        for (int j = 0; j < 4; ++j) mma_nt<64>(S[j], L.KhT, 72, j * 16, L.Vt, 72, w * 16, lane);
        if (w < 4) mma_nt<64>(S[4], L.KhT, 72, w * 16, L.Vt, 72, 128, lane);
        __syncthreads();
    }
    const size_t sidx = ((size_t)(dir * p.nb * 4 + b * 4 + h) * NSC + sc);
    bf16_t* dst = p.SC + sidx * SC_ELEMS;
#pragma unroll
    for (int j = 0; j < 4; ++j) *(u32x2*)(dst + (size_t)(w * 16 + c16) * 64 + j * 16 + 4 * q4) = (u32x2){pk2(S[j][0], S[j][1]), pk2(S[j][2], S[j][3])};
    if (w < 4) *(u32x2*)(dst + (size_t)(128 + c16) * 64 + w * 16 + 4 * q4) = (u32x2){pk2(S[4][0], S[4][1]), pk2(S[4][2], S[4][3])};
    if (tid == 0) { p.CS[sidx * 4 + 0] = L.sc[576 + 2]; p.CS[sidx * 4 + 1] = L.sc[576 + 3]; }
    __syncthreads();
}

__device__ __forceinline__ void c_scan_unit(const MP& p, int unit) {
    const int e4 = unit % 2304, seq = unit / 2304;
    const int dir = seq / (p.nb * 4);
    float S0 = 0.f, S1 = 0.f, S2 = 0.f, S3 = 0.f, M = 0.f;
    for (int i = 0; i < NSC; ++i) {
        const int sc = dir ? NSC - 1 - i : i;
        const size_t sidx = (size_t)seq * NSC + sc;
        bf16_t* ptr = p.SC + sidx * SC_ELEMS + e4 * 4;
        const u32x2 v = *(const u32x2*)ptr;
        const float A = p.CS[sidx * 4 + 0], B = p.CS[sidx * 4 + 1];
        *(u32x2*)ptr = (u32x2){pk2(S0, S1), pk2(S2, S3)};
        if (e4 == 0) p.CS[sidx * 4 + 2] = M;
        const float Mn = fmaxf(B + M, A);
        const float dc = __expf(B + M - Mn), wn = __expf(A - Mn);
        S0 = dc * S0 + wn * bf2f(v.x & 0xffffu); S1 = dc * S1 + wn * bf2f(v.x >> 16); S2 = dc * S2 + wn * bf2f(v.y & 0xffffu); S3 = dc * S3 + wn * bf2f(v.y >> 16);
        M = Mn;
    }
}

__device__ __forceinline__ void c_pass3(const MP& p, LAS unsigned char* lds, int item) {
    const int tid = otid(), lane = tid & 63, w = __builtin_amdgcn_readfirstlane(tid >> 6);
    const int sc = item & 15, h = (item >> 4) & 3, b = item >> 6;
    const CLds L = c_lds(lds);
    const int q4 = lane >> 4, c16 = lane & 15, mb2 = w >> 1, nh = w & 1;
    const size_t brow = (size_t)b * SEQ; const int tls = sc * 256;
    f32x4 H[4][4];
#pragma unroll
    for (int a = 0; a < 4; ++a)
#pragma unroll
        for (int m = 0; m < 4; ++m) H[a][m] = (f32x4){0.f, 0.f, 0.f, 0.f};
#pragma unroll 1
    for (int dir = 0; dir < 2; ++dir) {
        const size_t sidx = ((size_t)(dir * p.nb * 4 + b * 4 + h) * NSC + sc);
        const bf16_t* sg = p.SC + sidx * SC_ELEMS;
        for (int c = tid; c < 144 * 8; c += 512) { const int r = c >> 3, ch = c & 7; *(LAS u32x4*)(L.St + r * 72 + ch * 8) = *(const u32x4*)(sg + r * 64 + ch * 8); }
        f32x4 S[5];
#pragma unroll
        for (int j = 0; j < 4; ++j) { const u32x2 v = *(const u32x2*)(sg + (size_t)(w * 16 + c16) * 64 + j * 16 + 4 * q4);
            S[j] = (f32x4){bf2f(v.x & 0xffffu), bf2f(v.x >> 16), bf2f(v.y & 0xffffu), bf2f(v.y >> 16)}; }
        S[4] = (f32x4){0.f, 0.f, 0.f, 0.f};
        if (w < 4) { const u32x2 v = *(const u32x2*)(sg + (size_t)(128 + c16) * 64 + w * 16 + 4 * q4);
            S[4] = (f32x4){bf2f(v.x & 0xffffu), bf2f(v.x >> 16), bf2f(v.y & 0xffffu), bf2f(v.y >> 16)}; }
        if (tid == 0) L.sc[576 + 1] = p.CS[sidx * 4 + 2];
#pragma unroll 1
        for (int ci = 0; ci < 4; ++ci) {
            const int cc = dir ? 3 - ci : ci;
            const int tl0 = tls + cc * 64;
            c_load_qkv<true>(p, L, b, tl0, h);
            if (w == 0) {
                const float M = L.sc[576 + 1];
                const float* gr = p.gates + (brow + tl0 + lane) * 16;
                const float li = gr[dir * 4 + h] + p.gate_b[dir * 4 + h];
                const float lf = log_sigmoid(gr[8 + dir * 4 + h] + p.gate_b[8 + dir * 4 + h]);
                float bc = lf;
                if (dir == 0) {
#pragma unroll
                    for (int o = 1; o < 64; o <<= 1) { const float t = __shfl_up(bc, o); if (lane >= o) bc += t; }
                } else {
#pragma unroll
                    for (int o = 1; o < 64; o <<= 1) { const float t = __shfl_down(bc, o); if (lane + o < 64) bc += t; }
                }
                const float cb = li - bc;
                float pm = cb;
                if (dir == 0) {
#pragma unroll
                    for (int o = 1; o < 64; o <<= 1) { const float t = __shfl_up(pm, o); if (lane >= o) pm = fmaxf(pm, t); }
                } else {
#pragma unroll
                    for (int o = 1; o < 64; o <<= 1) { const float t = __shfl_down(pm, o); if (lane + o < 64) pm = fmaxf(pm, t); }
                }
                const float mt = fmaxf(bc + pm, bc + M);
                const float blast = __shfl(bc, dir ? 0 : 63);
                const float a = blast - bc + li;
                float amax = a;
#pragma unroll
                for (int o = 32; o > 0; o >>= 1) amax = fmaxf(amax, __shfl_xor(amax, o));
                const float Mn = fmaxf(blast + M, amax);
                L.sc[lane] = bc - mt; L.sc[64 + lane] = cb; L.sc[128 + lane] = __expf(bc + M - mt); L.sc[192 + lane] = __expf(a - Mn); L.sc[448 + lane] = mt;
                if (lane == 0) { L.sc[576 + 0] = __expf(blast + M - Mn); L.sc[576 + 4] = Mn; }
            }
            __syncthreads();
            for (int e = tid; e < 64 * 64; e += 512) { const int pp = e >> 6, dk = e & 63; L.Qg[pp * 72 + dk] = f2bf(L.sc[128 + pp] * bf2f(L.Qc[pp * 72 + dk])); }
            for (int e = tid; e < 64 * 64; e += 512) { const int pp = e & 63, dk = e >> 6; L.KhT[dk * 72 + pp] = f2bf(L.sc[192 + pp] * bf2f(L.Kc[pp * 72 + dk])); }
#pragma unroll
            for (int n = 0; n < 2; ++n) { f32x4 a = (f32x4){0.f, 0.f, 0.f, 0.f}; const int nb16 = nh * 2 + n;
                mma_nt<64>(a, L.Qc, 72, mb2 * 16, L.Kc, 72, nb16 * 16, lane);
#pragma unroll
                for (int i = 0; i < 4; ++i) { const int pt = mb2 * 16 + 4 * q4 + i, ps = nb16 * 16 + c16;
                    const bool keep = dir ? (ps >= pt) : (ps <= pt);
                    const float wv = keep ? a[i] * __expf(L.sc[pt] + L.sc[64 + ps]) : 0.f;
                    L.Pw[pt * 72 + ps] = f2bf(wv); } }
            __syncthreads();
            f32x4 T[4], Tn = (f32x4){0.f, 0.f, 0.f, 0.f};
#pragma unroll
            for (int m = 0; m < 4; ++m) { T[m] = (f32x4){0.f, 0.f, 0.f, 0.f};
                mma_nt<64>(T[m], L.Pw, 72, m * 16, L.Vt, 72, w * 16, lane);
                mma_nt<64>(T[m], L.Qg, 72, m * 16, L.St, 72, w * 16, lane);
                __builtin_amdgcn_sched_barrier(0); }
            if (w < 4) { mma_nt<64>(Tn, L.Pw, 72, w * 16, L.Vt, 72, 128, lane); mma_nt<64>(Tn, L.Qg, 72, w * 16, L.St, 72, 128, lane);
                if (c16 == 0) {
#pragma unroll
                    for (int i = 0; i < 4; ++i) L.sc[512 + w * 16 + 4 * q4 + i] = Tn[i]; } }
            __syncthreads();
#pragma unroll
            for (int m = 0; m < 4; ++m)
#pragma unroll
                for (int i = 0; i < 4; ++i) { const int pp = m * 16 + 4 * q4 + i; const float inv = 1.0f / fmaxf(fabsf(L.sc[512 + pp]), __expf(-L.sc[448 + pp])); T[m][i] *= inv; }
            if (cc == 0) {
#pragma unroll
                for (int m = 0; m < 4; ++m) H[0][m] += T[m];
            } else if (cc == 1) {
#pragma unroll
                for (int m = 0; m < 4; ++m) H[1][m] += T[m];
            } else if (cc == 2) {
#pragma unroll
                for (int m = 0; m < 4; ++m) H[2][m] += T[m];
            } else {
#pragma unroll
                for (int m = 0; m < 4; ++m) H[3][m] += T[m];
            }
            const float dcy = L.sc[576 + 0];
#pragma unroll
            for (int j = 0; j < 4; ++j) { S[j] = S[j] * dcy; mma_nt<64>(S[j], L.KhT, 72, j * 16, L.Vt, 72, w * 16, lane);
                *(LAS u32x2*)(L.St + (w * 16 + c16) * 72 + j * 16 + 4 * q4) = (u32x2){pk2(S[j][0], S[j][1]), pk2(S[j][2], S[j][3])}; }
            if (w < 4) { S[4] = S[4] * dcy; mma_nt<64>(S[4], L.KhT, 72, w * 16, L.Vt, 72, 128, lane);
                *(LAS u32x2*)(L.St + (128 + c16) * 72 + w * 16 + 4 * q4) = (u32x2){pk2(S[4][0], S[4][1]), pk2(S[4][2], S[4][3])}; }
            if (tid == 0) L.sc[576 + 1] = L.sc[576 + 4];
            __syncthreads();
        }
    }
    LAS float* st1 = L.sc + 640; LAS float* st2 = st1 + 8 * 256;
    int q4e = q4 * 4; asm volatile("" : "+v"(q4e));
    const unsigned ebase = (unsigned)((brow + tls) * NU + h * 128 + w * 16 + c16);
#pragma unroll
    for (int a = 0; a < 4; ++a)
#pragma unroll
        for (int m = 0; m < 4; ++m)
#pragma unroll
            for (int i = 0; i < 4; ++i) { const int tl = a * 64 + m * 16 + q4e + i;
                unsigned eo = ebase + (unsigned)tl * NU; asm volatile("" : "+v"(eo));
                const float og = bf2f(p.u[eo + UC_O]);
                const float v = H[a][m][i] * sigm(og); H[a][m][i] = v;
                const float s = grp16_sum(v);
                if (c16 == 0) st1[w * 256 + tl] = s;
                if (i == 3) asm volatile("" ::: "memory"); }
    __syncthreads();
#pragma unroll
    for (int a = 0; a < 4; ++a)
#pragma unroll
        for (int m = 0; m < 4; ++m)
#pragma unroll
            for (int i = 0; i < 4; ++i) { const int tl = a * 64 + m * 16 + q4e + i;
                float ss = 0.f;
#pragma unroll
                for (int ww = 0; ww < 8; ++ww) ss += st1[ww * 256 + tl];
                const float dv = H[a][m][i] - ss * (1.0f / 128.f); H[a][m][i] = dv;
                const float s = grp16_sum(dv * dv);
                if (c16 == 0) st2[w * 256 + tl] = s; }
    __syncthreads();
    const float gn = p.mlstm_g[h * 128 + w * 16 + c16];
#pragma unroll
    for (int a = 0; a < 4; ++a)
#pragma unroll
        for (int m = 0; m < 4; ++m)
#pragma unroll
            for (int i = 0; i < 4; ++i) { const int tl = a * 64 + m * 16 + q4e + i;
                float ss = 0.f;
#pragma unroll
                for (int ww = 0; ww < 8; ++ww) ss += st2[ww * 256 + tl];
                const float rs = 1.0f / sqrtf(ss * (1.0f / 128.f) + EPS);
                unsigned eo = ebase + (unsigned)tl * NU; asm volatile("" : "+v"(eo));
                const float z = bf2f(p.u[eo + UC_Z]);
                p.u[eo + UC_V] = f2bf(H[a][m][i] * rs * gn * silu(z));
                if (i == 3) asm volatile("" ::: "memory"); }
    __syncthreads();
}
}
#include <hip/hip_cooperative_groups.h>
namespace cg = cooperative_groups;
namespace fr {
using namespace mk;
constexpr int M = 16384, DM = 1024, DIN = 6928, NB = 4;
constexpr size_t MiB = 1u << 20;
constexpr int LDS_BYTES = 147456;
#ifndef MK_MULTI
#define MK_MULTI 0
#endif
constexpr int NPHASE = 12;
constexpr size_t WS_CTL = 0, CTL_ZERO_BYTES = 256 * 1024;
constexpr size_t WS_SS = 64 * 1024;
constexpr size_t WS_LB = 256 * 1024;
constexpr size_t WS_DA = WS_LB + 4096;
constexpr size_t WS_CS = WS_DA + 2 * 16 * 16 * 128 * 4;
constexpr size_t WS_U = 1 * MiB;
constexpr size_t WS_R2 = 217 * MiB;
constexpr size_t WS_WTIN = WS_R2;
constexpr size_t WS_SA = WS_R2;
constexpr size_t WS_SC = WS_R2 + 16 * MiB;
constexpr size_t WS_WTOUT = WS_R2 + 25 * MiB;
constexpr size_t WS_KV = WS_R2 + 33 * MiB;
constexpr size_t WS_GATES = WS_R2 + 37 * MiB;
constexpr size_t WS_CSN = WS_R2 + 38 * MiB;
static_assert(WS_CSN + 1 * MiB == 256 * MiB, "ws map");
static_assert(WS_U + (size_t)M * NU * 2 == WS_R2, "u fills [1, 217) MiB");
constexpr size_t DO_XB = 0;
constexpr size_t DO_LO = 32 * MiB;
constexpr size_t DO_WTKV = 32 * MiB;
constexpr size_t DO_MEMN = 36 * MiB;

struct KP {
    const float* x; const float* mem; const int* pos; const float* norm_g; const float* w_in; const float* lb_logits; const float* hgrn_g; const float* sink;
    const float* conv_w; const float* gate_b; const float* mlstm_g; const float* mem_g; const float* w_kv; const float* w_out; const float* final_g;
    float* out; unsigned char* ws; int ph_lo, ph_hi;
};

__device__ const double INVF[8] = {1.0, 0.19392274474868576, 0.03760603093086393, 0.007292664737217109, 0.001414213562373095, 0.0002742481756762073, 5.318295896944988e-05, 1.031338537721246e-05};
__device__ __forceinline__ float wave_sum(float v) {
#pragma unroll
    for (int o = 1; o < 64; o <<= 1) v += __shfl_xor(v, o);
    return v;
}
__device__ __forceinline__ int new_col_to_old(int c) {
    if (c < 512) return 0 + c;
    if (c < 1024) return 2560 + (c - 512);
    if (c < 1536) return 4352 + (c - 1024);
    if (c < 2048) return 5904 + (c - 1536);
    if (c < 2560) return 512 + (c - 2048);
    if (c < 3072) return 1024 + (c - 2560);
    if (c < 3584) return 1536 + (c - 3072);
    if (c < 4096) return 2048 + (c - 3584);
    if (c < 4224) return 3072 + (c - 4096);
    if (c < 4352) return 3200 + (c - 4224);
    if (c < 4864) return 3328 + (c - 4352);
    if (c < 5120) return 3840 + (c - 4864);
    if (c < 5376) return 4096 + (c - 5120);
    if (c < 5888) return 4864 + (c - 5376);
    if (c < 6400) return 5376 + (c - 5888);
    return 6416 + (c - 6400);
}
__device__ __forceinline__ void transpose_item(const float* W, int K, int N, bf16_t* WT, int k0, int src_col0, int dst_row0, const float* kscale, LAS float* scr, int lane) {
#pragma unroll 8
    for (int i = 0; i < 32; ++i) { const int kk = 2 * i + (lane >> 5); float v = W[(size_t)(k0 + kk) * N + src_col0 + (lane & 31)]; if (kscale) v *= kscale[k0 + kk]; scr[kk * 33 + (lane & 31)] = v; }
    asm volatile("s_waitcnt lgkmcnt(0)" ::: "memory");
    const int c = lane & 7;
#pragma unroll
    for (int j = 0; j < 4; ++j) { const int n = (lane >> 3) + 8 * j; const LAS float* s = scr + (8 * c) * 33 + n;
        u32x4 o; o.x = pk2(s[0 * 33], s[1 * 33]); o.y = pk2(s[2 * 33], s[3 * 33]); o.z = pk2(s[4 * 33], s[5 * 33]); o.w = pk2(s[6 * 33], s[7 * 33]);
        *(u32x4*)(WT + (size_t)(dst_row0 + n) * K + k0 + 8 * c) = o; }
    asm volatile("s_waitcnt lgkmcnt(0)" ::: "memory");
}
__device__ __forceinline__ void convert_wtin(const KP& a, int l, LAS unsigned char* lds, int gw, int ngw, int wave, int lane) {
    LAS float* scr = (LAS float*)(lds + wave * 8448);
    bf16_t* WT = (bf16_t*)(a.ws + WS_WTIN);
    for (int it = gw; it < 16 * 216; it += ngw) { const int kb = it / 216, nbk = it % 216;
        transpose_item(a.w_in + (size_t)l * DM * DIN, DM, DIN, WT, kb * 64, new_col_to_old(nbk * 32), nbk * 32, a.norm_g + l * DM, scr, lane); }
}
__device__ __forceinline__ void gates_block(const KP& a, int l, LAS unsigned char* lds, const bf16_t* xb, const float* ss, int blk) {
    const int tid = otid(), lane = tid & 63, w = __builtin_amdgcn_readfirstlane(tid >> 6);
    float* gates = (float*)(a.ws + WS_GATES);
    LAS bf16_t* A2 = (LAS bf16_t*)lds; LAS bf16_t* B2 = A2 + 64 * 520;
    f32x4 acc = (f32x4){0.f, 0.f, 0.f, 0.f};
    for (int kh = 0; kh < 2; ++kh) {
        for (int c = tid; c < 64 * 64; c += 512) { const int r = c >> 6, ch = c & 63;
            *(LAS u32x4*)(A2 + r * 520 + ch * 8) = *(const u32x4*)(xb + (size_t)(blk * 64 + r) * DM + kh * 512 + ch * 8); }
        for (int c = tid; c < 16 * 512; c += 512) { const int j = c & 15, k = c >> 4; const int kg = kh * 512 + k;
            B2[j * 520 + k] = f2bf(a.w_in[((size_t)l * DM + kg) * DIN + 5888 + j] * a.norm_g[l * DM + kg]); }
        __syncthreads();
        if (w < 4) mma_nt<512>(acc, A2, 520, w * 16, B2, 520, 0, lane);
        __syncthreads();
    }
    if (w < 4) {
#pragma unroll
        for (int i = 0; i < 4; ++i) { const int r = blk * 64 + w * 16 + 4 * (lane >> 4) + i; const float rs = 1.0f / sqrtf(ss[r] * (1.0f / 1024.f) + 1e-6f);
            gates[(size_t)r * 16 + (lane & 15)] = acc[i] * rs; }
    }
}

__device__ __forceinline__ void prologue(const KP& a, LAS unsigned char* lds) {
    const int tid = otid(), lane = tid & 63, wave = __builtin_amdgcn_readfirstlane(tid >> 6);
    const int G = gridDim.x, gw = blockIdx.x * 8 + wave, ngw = G * 8;
    LAS float* scr = (LAS float*)(lds + wave * 8448);
    float* ss0 = (float*)(a.ws + WS_SS);
    bf16_t* xb = (bf16_t*)((unsigned char*)a.out + DO_XB);
    for (int blk = blockIdx.x; blk < M / 64; blk += G) {
        for (int rr = wave; rr < 64; rr += 8) { const int r = blk * 64 + rr;
            const f32x4* xr = (const f32x4*)(a.x + (size_t)r * DM) + lane;
            f32x4 v[4]; float s = 0.f;
#pragma unroll
            for (int j = 0; j < 4; ++j) { v[j] = xr[64 * j]; s += (v[j][0] * v[j][0] + v[j][1] * v[j][1]) + (v[j][2] * v[j][2] + v[j][3] * v[j][3]); }
            s = wave_sum(s);
            if (lane == 0) ss0[r] = s;
            u32x2* o8 = (u32x2*)(xb + (size_t)r * DM) + lane;
#pragma unroll
            for (int j = 0; j < 4; ++j) o8[64 * j] = (u32x2){pk2(v[j][0], v[j][1]), pk2(v[j][2], v[j][3])};
        }
    }
    convert_wtin(a, 0, lds, gw, ngw, wave, lane);
    for (int it = gw; it < 2 * 32 * 32; it += ngw) { const int l = it >> 10, r = it & 1023, kb = r >> 5, nbk = r & 31;
        transpose_item(a.w_out + (size_t)l * 2048 * DM, 2048, DM, (bf16_t*)(a.ws + WS_WTOUT) + (size_t)l * DM * 2048, kb * 64, nbk * 32, nbk * 32, nullptr, scr, lane); }
    for (int it = gw; it < 2 * 16 * 32; it += ngw) { const int l = it >> 9, r = it & 511, kb = r >> 5, nbk = r & 31;
        transpose_item(a.w_kv + (size_t)l * DM * 1024, DM, 1024, (bf16_t*)((unsigned char*)a.out + DO_WTKV) + (size_t)l * 1024 * DM, kb * 64, nbk * 32, nbk * 32, nullptr, scr, lane); }
    for (int it = gw; it < 2 * 1024; it += ngw) { const int l = it >> 10, r = it & 1023;
        const f32x4* xr = (const f32x4*)(a.mem + (size_t)r * DM) + lane; const f32x4* gr = (const f32x4*)(a.mem_g + l * DM) + lane;
        f32x4 v[4]; float s = 0.f;
#pragma unroll
        for (int j = 0; j < 4; ++j) { v[j] = xr[64 * j]; s += (v[j][0] * v[j][0] + v[j][1] * v[j][1]) + (v[j][2] * v[j][2] + v[j][3] * v[j][3]); }
        const float rs = 1.0f / sqrtf(wave_sum(s) * (1.0f / 1024.f) + 1e-6f);
        u32x2* o8 = (u32x2*)((bf16_t*)((unsigned char*)a.out + DO_MEMN) + ((size_t)l * 1024 + r) * DM) + lane;
#pragma unroll
        for (int j = 0; j < 4; ++j) { const f32x4 g = gr[64 * j]; o8[64 * j] = (u32x2){pk2(v[j][0] * rs * g[0], v[j][1] * rs * g[1]), pk2(v[j][2] * rs * g[2], v[j][3] * rs * g[3])}; }
    }
    {
        float* cs = (float*)(a.ws + WS_CSN); float* sn = cs + (size_t)M * 8;
        for (int i = blockIdx.x * 512 + tid; i < M * 8; i += G * 512) { const int t = i >> 3, j = i & 7;
            const double inv = INVF[j];
            const double ang = (double)a.pos[t] * inv;
            const double kq = rint(ang * 0.15915494309189535);
            const float r = (float)fma(-kq, 1.2246467991473532e-16 * 2.0, fma(-kq, 6.283185307179586, ang));
            cs[i] = cosf(r); sn[i] = sinf(r); }
        if (blockIdx.x == 0) { float* lb = (float*)(a.ws + WS_LB);
            const float l0 = a.lb_logits[tid], l1 = a.lb_logits[512 + tid]; const float m = fmaxf(l0, l1); const float e0 = __expf(l0 - m), e1 = __expf(l1 - m);
            lb[tid] = 0.f; lb[512 + tid] = e1 / (e0 + e1); }
    }
    __syncthreads();
}

__device__ __forceinline__ MP make_mp(const KP& a, int l) {
    MP p;
    p.u = (bf16_t*)(a.ws + WS_U); p.gates = (const float*)(a.ws + WS_GATES); p.kv = (const bf16_t*)(a.ws + WS_KV) + (size_t)l * 1024 * 1024;
    p.cs = (const float*)(a.ws + WS_CSN); p.sn = p.cs + (size_t)M * 8; p.lb = (const float*)(a.ws + WS_LB) + l * 512;
    p.hgrn_g = a.hgrn_g + l * 512; p.sink = a.sink + l * 8; p.conv_w = a.conv_w + (size_t)l * 5 * 512; p.gate_b = a.gate_b + l * 16; p.mlstm_g = a.mlstm_g + l * 512;
    p.SA = (bf16_t*)(a.ws + WS_SA); p.DA = (float*)(a.ws + WS_DA); p.SC = (bf16_t*)(a.ws + WS_SC); p.CS = (float*)(a.ws + WS_CS); p.nb = NB;
    return p;
}

__device__ __forceinline__ void phase_g1(const KP& a, int l, LAS unsigned char* lds) {
    const int G = gridDim.x;
    const bf16_t* xb = (const bf16_t*)((unsigned char*)a.out + DO_XB);
    const float* ss = (const float*)(a.ws + WS_SS) + (size_t)l * M;
    for (int blk = blockIdx.x; blk < M / 64; blk += G) gates_block(a, l, lds, xb, ss, blk);
    __syncthreads();
    {
        pg8::Gemm g{xb, (const bf16_t*)(a.ws + WS_WTIN), M, NU, DM, DM};
        pg8::StaticOrder S; S.init(M, NU, G, (int)blockIdx.x);
        pg8::EpiIn E{(bf16_t*)(a.ws + WS_U), NU, ss};
        pg8::gemm_phase<pg8::EpiIn, pg8::StaticOrder, true, true>((PG8_LAS unsigned char*)lds, g, S, E);
    }
    if (l == 0) {
        __syncthreads();
        pg8::Gemm g{(const bf16_t*)((unsigned char*)a.out + DO_MEMN), (const bf16_t*)((unsigned char*)a.out + DO_WTKV), 2048, 2048, DM, DM};
        pg8::KvOrder S{(int)blockIdx.x, G - 64 > 0 ? G - 64 : 0};
        pg8::EpiKv E{(bf16_t*)(a.ws + WS_KV)};
        pg8::gemm_phase<pg8::EpiKv, pg8::KvOrder, false, true>((PG8_LAS unsigned char*)lds, g, S, E);
    }
}
__device__ __forceinline__ void phase_g2(const KP& a, int l, LAS unsigned char* lds) {
    const int tid = otid(), lane = tid & 63, wave = __builtin_amdgcn_readfirstlane(tid >> 6);
    const int G = gridDim.x;
    if (l == 0) { convert_wtin(a, 1, lds, blockIdx.x * 8 + wave, G * 8, wave, lane); __syncthreads(); }
    pg8::Gemm g{(const bf16_t*)(a.ws + WS_U), (const bf16_t*)(a.ws + WS_WTOUT) + (size_t)l * DM * 2048, M, DM, 2048, NU};
    pg8::StaticOrder S; S.init(M, DM, G, (int)blockIdx.x);
    bf16_t* hi = (bf16_t*)((unsigned char*)a.out + DO_XB); bf16_t* lo = (bf16_t*)((unsigned char*)a.out + DO_LO);
    float* ssn = (float*)(a.ws + WS_SS) + (size_t)(l + 1) * M;
    if (l == 0) { pg8::EpiOut<0> E{a.x, hi, lo, nullptr, 0, 0, ssn}; pg8::gemm_phase<pg8::EpiOut<0>, pg8::StaticOrder, false, true>((PG8_LAS unsigned char*)lds, g, S, E); }
    else { pg8::EpiOut<1> E{nullptr, hi, lo, (float*)(a.ws + WS_U), NU / 2, 1024, ssn}; pg8::gemm_phase<pg8::EpiOut<1>, pg8::StaticOrder, false, true>((PG8_LAS unsigned char*)lds, g, S, E); }
}
__device__ __forceinline__ void phase_m1(const MP& p, LAS unsigned char* lds) {
    const int nb = p.nb, G = gridDim.x;
    const int nB = nb * 128, nA = nb * 128, nC = nb * 128, nD = nb * 256;
    for (int it = blockIdx.x; it < nB + nA + nC + nD; it += G) {
        if (it < nB) b_item(p, lds, it);
        else if (it < nB + nA) a_pass1(p, lds, it - nB);
        else if (it < nB + nA + nC) c_pass1(p, lds, it - nB - nA);
        else d_item(p, lds, it - nB - nA - nC);
    }
}
__device__ __forceinline__ void phase_m2(const MP& p) {
    const int nb = p.nb, G = gridDim.x;
    const int nAu = nb * 8 * 4096, nCu = nb * 8 * 2304;
    for (int uu = blockIdx.x * 512 + otid(); uu < nAu + nCu; uu += G * 512) { if (uu < nAu) a_scan_unit(p, uu); else c_scan_unit(p, uu - nAu); }
}
__device__ __forceinline__ void phase_m3(const MP& p, LAS unsigned char* lds) {
    const int nb = p.nb, G = gridDim.x;
    for (int it = blockIdx.x; it < nb * 128; it += G) { if (it < nb * 64) a_pass3(p, lds, it); else c_pass3(p, lds, it - nb * 64); }
}
__device__ __forceinline__ void phase_final(const KP& a) {
    const int tid = otid(), lane = tid & 63, wave = __builtin_amdgcn_readfirstlane(tid >> 6);
    const int gw = blockIdx.x * 8 + wave, ngw = gridDim.x * 8;
    const float* ss2 = (const float*)(a.ws + WS_SS) + (size_t)2 * M;
    const float* x2 = (const float*)(a.ws + WS_U);
    for (int r = gw; r < M; r += ngw) {
        const float rs = 1.0f / sqrtf(ss2[r] * (1.0f / 1024.f) + 1e-6f);
        const f32x4* xr = (const f32x4*)(x2 + (size_t)r * (NU / 2) + 1024) + lane; const f32x4* gr = (const f32x4*)a.final_g + lane;
        f32x4* orow = (f32x4*)(a.out + (size_t)r * DM) + lane;
#pragma unroll
        for (int j = 0; j < 4; ++j) { const f32x4 v = xr[64 * j], g = gr[64 * j]; orow[64 * j] = v * rs * g; }
    }
}

__global__ void __launch_bounds__(512, 2) mega_fwd(KP a) {
    extern __shared__ __attribute__((aligned(16))) unsigned char lds_raw[];
    LAS unsigned char* lds = (LAS unsigned char*)lds_raw;
#if !MK_MULTI
    cg::grid_group grid = cg::this_grid();
#define GRID_SYNC() grid.sync()
#else
#define GRID_SYNC() do {} while (0)
#endif
    for (int ph = a.ph_lo; ph < a.ph_hi; ++ph) {
        if (ph == 0) prologue(a, lds);
        else if (ph == 11) phase_final(a);
        else {
            const int l = (ph - 1) / 5, s = (ph - 1) % 5;
            if (s == 0) phase_g1(a, l, lds);
            else if (s == 4) phase_g2(a, l, lds);
            else { const MP p = make_mp(a, l); if (s == 1) phase_m1(p, lds); else if (s == 2) phase_m2(p); else phase_m3(p, lds); }
        }
        if (ph + 1 < a.ph_hi) GRID_SYNC();
    }
}
}

extern "C" void kernel_launch(void* const* d_in, const int* in_sizes, int n_in,
                              void* d_out, int out_size, void* d_ws, size_t ws_size,
                              hipStream_t stream) {
    using namespace fr;
    static int grid_blocks = 0;
    if (!grid_blocks) {
        int dev = 0, cus = 0, per_cu = 0;
        (void)hipGetDevice(&dev);
        (void)hipDeviceGetAttribute(&cus, hipDeviceAttributeMultiprocessorCount, dev);
        (void)hipFuncSetAttribute((const void*)mega_fwd, hipFuncAttributeMaxDynamicSharedMemorySize, LDS_BYTES);
        (void)hipOccupancyMaxActiveBlocksPerMultiprocessor(&per_cu, (const void*)mega_fwd, 512, LDS_BYTES);
        if (per_cu < 1) per_cu = 1;
        grid_blocks = cus * (per_cu > 1 ? 1 : per_cu);
    }
    KP a{};
    a.x = (const float*)d_in[0]; a.mem = (const float*)d_in[1]; a.pos = (const int*)d_in[2]; a.norm_g = (const float*)d_in[3]; a.w_in = (const float*)d_in[4];
    a.lb_logits = (const float*)d_in[5]; a.hgrn_g = (const float*)d_in[6]; a.sink = (const float*)d_in[7]; a.conv_w = (const float*)d_in[8]; a.gate_b = (const float*)d_in[9];
    a.mlstm_g = (const float*)d_in[10]; a.mem_g = (const float*)d_in[11]; a.w_kv = (const float*)d_in[12]; a.w_out = (const float*)d_in[13]; a.final_g = (const float*)d_in[14];
    a.out = (float*)d_out; a.ws = (unsigned char*)d_ws;
    (void)hipMemsetAsync((char*)d_ws + WS_CTL, 0, CTL_ZERO_BYTES, stream);
#if MK_MULTI
    for (int ph = 0; ph < NPHASE; ++ph) { a.ph_lo = ph; a.ph_hi = ph + 1; hipLaunchKernelGGL(mega_fwd, dim3(grid_blocks), dim3(512), LDS_BYTES, stream, a); }
#else
    a.ph_lo = 0; a.ph_hi = NPHASE;
    void* args[] = {&a};
    (void)hipLaunchCooperativeKernel((const void*)mega_fwd, dim3(grid_blocks), dim3(512), args, LDS_BYTES, stream);
#endif
}
```

```cpp
#include <hip/hip_runtime.h>
#include <math.h>
#define MK_MULTI 0
namespace pg8 {
#define PG8_LAS __attribute__((address_space(3)))
typedef unsigned short bf16_t;
typedef short bf16x8 __attribute__((ext_vector_type(8)));
typedef float f32x4 __attribute__((ext_vector_type(4)));
typedef unsigned u32x4 __attribute__((ext_vector_type(4)));
constexpr int BM = 256, BK = 64, HALF = 128, HTB = HALF * BK * 2  , STAGE_BYTES = 8 * HTB, NXCD = 8, WGM = 8;

__host__ __device__ __forceinline__ int lds_byte(int r, int c) { const int st = (r >> 4) * 2 + (c >> 5), rr = r & 15, cc = c & 31, ob = rr * 64 + cc * 2; return st * 1024 + (ob ^ (((ob >> 9) & 1) << 5)); }
__host__ __device__ __forceinline__ void stage_rc(int b, int& R, int& C) { const int st = b / 1024, sb = b % 1024, swz = sb ^ (((sb >> 9) & 1) << 5); R = (st >> 1) * 16 + swz / 64; C = (st & 1) * 32 + (swz % 64) / 2; }
__host__ __device__ __forceinline__ int perm32(int rho) { const int n = rho >> 4, i = rho & 15; return 8 * (i >> 2) + 4 * n + (i & 3); }

struct Unit { int pm, pn; };
struct Gemm { const bf16_t* A; const bf16_t* Bt; int M, N, K, lda; };

struct StaticOrder {
    int nM, nN, nwg, G, c;
    __host__ __device__ void init(int M, int N, int G_, int c_) { nM = M / BM; nN = N / BM; nwg = nM * nN; G = G_; c = c_; }
    __host__ __device__ bool next(int i, Unit& u) const {
        const long L = (long)i * G + c; if (L >= nwg) return false;
        int wgid = (int)L; { const int q = nwg / NXCD, r = nwg % NXCD, xcd = wgid % NXCD, off = wgid / NXCD; wgid = (xcd < r ? xcd * (q + 1) : r * (q + 1) + (xcd - r) * q) + off; }
        const int nig = WGM * nN, gid = wgid / nig, fm = gid * WGM, gsz = (nM - fm) < WGM ? (nM - fm) : WGM;
        u.pm = fm + ((wgid % nig) % gsz); u.pn = (wgid % nig) / gsz; return true;
    }
    __device__ __forceinline__ void a_ready(const Unit&) const {}
    __device__ __forceinline__ void done(const Unit&) const {}
};

__device__ __forceinline__ unsigned cvt_pk_bf16(float lo, float hi) { unsigned r; asm volatile("v_cvt_pk_bf16_f32 %0, %1, %2" : "=v"(r) : "v"(lo), "v"(hi)); return r; }

__device__ __forceinline__ float bf2f_(unsigned h16) { return __uint_as_float(h16 << 16); }
struct EpiIn {
    static constexpr bool PERM = true, AFTER_DRAIN = false;
    bf16_t* O; int ldc; const float* ss;
    __device__ __forceinline__ void operator()(const f32x4 (&acc)[2][2][4][2], const Unit& u, int wr, int wc, int fr, int fq) const {
        const int row0 = u.pm * BM + wr * 64 + fr; const int col0 = u.pn * BM + wc * 32 + 8 * fq;
#pragma unroll
        for (int ai = 0; ai < 2; ++ai)
#pragma unroll
            for (int m = 0; m < 4; ++m) { const int r = row0 + ai * HALF + m * 16; const float rs = 1.0f / sqrtf(ss[r] * (1.0f / 1024.f) + 1e-6f);
                bf16_t* rowp = O + (size_t)r * ldc + col0;
#pragma unroll
                for (int bj = 0; bj < 2; ++bj) { const f32x4 v0 = acc[ai][bj][m][0] * rs, v1 = acc[ai][bj][m][1] * rs;
                    u32x4 w; w.x = cvt_pk_bf16(v0[0], v0[1]); w.y = cvt_pk_bf16(v0[2], v0[3]); w.z = cvt_pk_bf16(v1[0], v1[1]); w.w = cvt_pk_bf16(v1[2], v1[3]);
                    *(u32x4*)(rowp + bj * HALF) = w; } }
    }
};
struct EpiKv {
    static constexpr bool PERM = true, AFTER_DRAIN = false;
    bf16_t* O;
    __device__ __forceinline__ void operator()(const f32x4 (&acc)[2][2][4][2], const Unit& u, int wr, int wc, int fr, int fq) const {
        const int row0 = u.pm * BM + wr * 64 + fr; const int col0 = (u.pn & 3) * BM + wc * 32 + 8 * fq;
#pragma unroll
        for (int ai = 0; ai < 2; ++ai)
#pragma unroll
            for (int m = 0; m < 4; ++m) { const int r = row0 + ai * HALF + m * 16; bf16_t* rowp = O + (size_t)r * 1024 + col0;
#pragma unroll
                for (int bj = 0; bj < 2; ++bj) { const f32x4 v0 = acc[ai][bj][m][0], v1 = acc[ai][bj][m][1];
                    u32x4 w; w.x = cvt_pk_bf16(v0[0], v0[1]); w.y = cvt_pk_bf16(v0[2], v0[3]); w.z = cvt_pk_bf16(v1[0], v1[1]); w.w = cvt_pk_bf16(v1[2], v1[3]);
                    *(u32x4*)(rowp + bj * HALF) = w; } }
    }
};
typedef unsigned u32x2e __attribute__((ext_vector_type(2)));
template <int LAYER> struct EpiOut {
    static constexpr bool PERM = false, AFTER_DRAIN = false;
    const float* x0; bf16_t* hi; bf16_t* lo; float* x2; int xs, xo; float* ssn;
    __device__ __forceinline__ void operator()(const f32x4 (&acc)[2][2][4][2], const Unit& u, int wr, int wc, int fr, int fq) const {
        const int row0 = u.pm * BM + wr * 64 + fr; const int col0 = u.pn * BM + wc * 32 + 4 * fq;
#pragma unroll
        for (int ai = 0; ai < 2; ++ai)
#pragma unroll
            for (int m = 0; m < 4; ++m) { const int r = row0 + ai * HALF + m * 16; float part = 0.f;
#pragma unroll
                for (int bj = 0; bj < 2; ++bj)
#pragma unroll
                    for (int n = 0; n < 2; ++n) { const int c = col0 + bj * HALF + n * 16; const size_t e = (size_t)r * 1024 + c;
                        f32x4 xv;
                        if (LAYER == 0) xv = *(const f32x4*)(x0 + e);
                        else { const u32x2e h = *(const u32x2e*)(hi + e), l = *(const u32x2e*)(lo + e);
                            xv = (f32x4){bf2f_(h.x & 0xffffu) + bf2f_(l.x & 0xffffu), bf2f_(h.x >> 16) + bf2f_(l.x >> 16), bf2f_(h.y & 0xffffu) + bf2f_(l.y & 0xffffu), bf2f_(h.y >> 16) + bf2f_(l.y >> 16)}; }
                        const f32x4 v = xv + acc[ai][bj][m][n];
                        part += (v[0] * v[0] + v[1] * v[1]) + (v[2] * v[2] + v[3] * v[3]);
                        if (LAYER == 0) {
                            u32x2e hw; hw.x = cvt_pk_bf16(v[0], v[1]); hw.y = cvt_pk_bf16(v[2], v[3]);
                            const f32x4 d = v - (f32x4){bf2f_(hw.x & 0xffffu), bf2f_(hw.x >> 16), bf2f_(hw.y & 0xffffu), bf2f_(hw.y >> 16)};
                            u32x2e lw; lw.x = cvt_pk_bf16(d[0], d[1]); lw.y = cvt_pk_bf16(d[2], d[3]);
                            *(u32x2e*)(hi + e) = hw; *(u32x2e*)(lo + e) = lw;
                        } else { *(f32x4*)(x2 + (size_t)r * xs + xo + c) = v; } }
                part += __shfl_xor(part, 16); part += __shfl_xor(part, 32);
                if (fq == 0) atomicAdd(ssn + r, part); }
    }
};
struct KvOrder {
    int c, c0;
    __device__ bool next(int i, Unit& u) const { const int t = c - c0; if (i != 0 || t < 0 || t >= 32) return false; const int l = t >> 4; u.pm = l * 4 + ((t >> 2) & 3); u.pn = l * 4 + (t & 3); return true; }
    __device__ __forceinline__ void a_ready(const Unit&) const {}
    __device__ __forceinline__ void done(const Unit&) const {}
};

template <class Epi, class Sched, bool ALIGN_EPI = false, bool SP2 = false>
__device__ __forceinline__ void gemm_phase(PG8_LAS unsigned char* lds, const Gemm g, const Sched& S, const Epi& E) {
    int tid = threadIdx.x; asm volatile("" : "+v"(tid)); const int wid = __builtin_amdgcn_readfirstlane(tid >> 6), lane = tid & 63, wr = wid >> 2, wc = wid & 3, fr = lane & 15, fq = lane >> 4;
    const int K = g.K, nt = K / BK;
    unsigned voffA[2], voffB[2];
#pragma unroll
    for (int i = 0; i < 2; ++i) { int R, C; stage_rc(tid * 16 + i * 8192, R, C); const int Rb = Epi::PERM ? ((R & ~31) + perm32(R & 31)) : R;
        voffA[i] = (unsigned)(R * g.lda + C) * 2u; voffB[i] = (unsigned)(Rb * K + C) * 2u; }
    const size_t kstep = (size_t)(BK * 2);
    const size_t hstep = (size_t)HALF * K * 2, hstepA = (size_t)HALF * g.lda * 2;
    const size_t tstep = 2 * hstep, tstepA = 2 * hstepA;
    const unsigned ldsw = (unsigned)wid * 1024u;
    const int aoff = lds_byte(wr * 64 + fr, fq * 8), boff = lds_byte(wc * 32 + fr, fq * 8);
#define PG8_SA(b, h) (((b) * 2 + (h)) * HTB)
#define PG8_SB(b, h) ((4 + (b) * 2 + (h)) * HTB)
#define PG8_STAGE(bufoff, gbase, voff) do { _Pragma("unroll") for (int _i = 0; _i < 2; ++_i) \
        __builtin_amdgcn_global_load_lds((const unsigned*)((const char*)(gbase) + (voff)[_i]), (PG8_LAS unsigned*)(lds + (bufoff) + ldsw + _i * 8192), 16, 0, 0); } while (0)
#define PG8_LDA(dst, b, h) do { _Pragma("unroll") for (int m = 0; m < 4; ++m) _Pragma("unroll") for (int k = 0; k < 2; ++k) dst[m][k] = *(const PG8_LAS bf16x8*)(lds + PG8_SA(b, h) + aoff + m * 2048 + k * 1024); } while (0)
#define PG8_LDB(dst, b, h) do { _Pragma("unroll") for (int n = 0; n < 2; ++n) _Pragma("unroll") for (int k = 0; k < 2; ++k) dst[n][k] = *(const PG8_LAS bf16x8*)(lds + PG8_SB(b, h) + boff + n * 2048 + k * 1024); } while (0)
#define PG8_MMA(ai, bj, At, Bt) do { __builtin_amdgcn_s_setprio(1); _Pragma("unroll") for (int m = 0; m < 4; ++m) _Pragma("unroll") for (int n = 0; n < 2; ++n) _Pragma("unroll") for (int k = 0; k < 2; ++k) \
        acc[ai][bj][m][n] = __builtin_amdgcn_mfma_f32_16x16x32_bf16(Bt[n][k], At[m][k], acc[ai][bj][m][n], 0, 0, 0); __builtin_amdgcn_s_setprio(0); } while (0)
#define PG8_WAIT_V(n) asm volatile("s_waitcnt vmcnt(" #n ")" ::: "memory")
#define PG8_WAIT_L(n) asm volatile("s_waitcnt lgkmcnt(" #n ")" ::: "memory")
#define PG8_BAR __builtin_amdgcn_s_barrier()
#define PG8_SCHED __builtin_amdgcn_sched_barrier(0)
    Unit cur, nxt; int ui = 0;
    if (!S.next(0, cur)) return;
    f32x4 acc[2][2][4][2];
#pragma unroll
    for (int a = 0; a < 2; ++a)
#pragma unroll
        for (int b = 0; b < 2; ++b)
#pragma unroll
            for (int m = 0; m < 4; ++m)
#pragma unroll
                for (int n = 0; n < 2; ++n) acc[a][b][m][n] = (f32x4){0.f, 0.f, 0.f, 0.f};
    bf16x8 At[4][2], B0[2][2], B1[2][2];
    const char* cA = (const char*)g.A + (size_t)cur.pm * tstepA; const char* cB = (const char*)g.Bt + (size_t)cur.pn * tstep;
    S.a_ready(cur);
    if constexpr (SP2) {
        PG8_STAGE(PG8_SB(0, 0), cB, voffB); PG8_STAGE(PG8_SB(0, 1), cB + hstep, voffB); PG8_STAGE(PG8_SA(0, 0), cA, voffA); PG8_STAGE(PG8_SA(0, 1), cA + hstepA, voffA);
        if (wr == 1) PG8_BAR;
        PG8_WAIT_V(2); PG8_BAR;
        PG8_STAGE(PG8_SB(1, 0), cB + kstep, voffB); PG8_STAGE(PG8_SA(1, 0), cA + kstep, voffA); PG8_STAGE(PG8_SB(1, 1), cB + hstep + kstep, voffB);
        PG8_WAIT_V(6); PG8_BAR;
    } else {
        PG8_STAGE(PG8_SB(0, 0), cB, voffB); PG8_STAGE(PG8_SA(0, 0), cA, voffA); PG8_STAGE(PG8_SB(0, 1), cB + hstep, voffB); PG8_STAGE(PG8_SA(0, 1), cA + hstepA, voffA);
        if (wr == 1) PG8_BAR;
        PG8_WAIT_V(4); PG8_BAR;
        PG8_STAGE(PG8_SB(1, 0), cB + kstep, voffB); PG8_STAGE(PG8_SA(1, 0), cA + kstep, voffA); PG8_STAGE(PG8_SB(1, 1), cB + hstep + kstep, voffB);
        PG8_WAIT_V(6); PG8_BAR;
    }
    for (;;) {
        const bool has_next = S.next(ui + 1, nxt);
        const char* nA = has_next ? (const char*)g.A + (size_t)nxt.pm * tstepA : cA; const char* nB = has_next ? (const char*)g.Bt + (size_t)nxt.pn * tstep : cB;
        for (int t = 0; t < nt; t += 2) {
            const bool last = (t == nt - 2);
            const char* a1 = cA + (size_t)(t + 1) * kstep;
            const char* a2 = last ? nA : cA + (size_t)(t + 2) * kstep; const char* b2 = last ? nB : cB + (size_t)(t + 2) * kstep;
            const char* a3 = a2 + kstep; const char* b3 = b2 + kstep;
            if (last && has_next) S.a_ready(nxt);
            if constexpr (SP2) {
            PG8_LDB(B0, 0, 0); PG8_LDB(B1, 0, 1); PG8_SCHED; PG8_LDA(At, 0, 0); PG8_STAGE(PG8_SA(1, 1), a1 + hstepA, voffA);
            PG8_WAIT_V(8); PG8_WAIT_L(0); PG8_BAR; PG8_MMA(0, 0, At, B0); PG8_MMA(0, 1, At, B1); PG8_BAR; PG8_SCHED;
            PG8_LDA(At, 0, 1); PG8_STAGE(PG8_SB(0, 0), b2, voffB); PG8_STAGE(PG8_SB(0, 1), b2 + hstep, voffB); PG8_STAGE(PG8_SA(0, 0), a2, voffA);
            PG8_WAIT_V(8); PG8_WAIT_L(0); PG8_BAR; PG8_MMA(1, 0, At, B0); PG8_MMA(1, 1, At, B1); PG8_BAR; PG8_SCHED;
            PG8_LDB(B0, 1, 0); PG8_LDB(B1, 1, 1); PG8_SCHED; PG8_LDA(At, 1, 0); PG8_STAGE(PG8_SA(0, 1), a2 + hstepA, voffA);
            PG8_WAIT_V(8); PG8_WAIT_L(0); PG8_BAR; PG8_MMA(0, 0, At, B0); PG8_MMA(0, 1, At, B1); PG8_BAR; PG8_SCHED;
            PG8_LDA(At, 1, 1); PG8_STAGE(PG8_SB(1, 0), b3, voffB); PG8_STAGE(PG8_SB(1, 1), b3 + hstep, voffB); PG8_STAGE(PG8_SA(1, 0), a3, voffA);
            PG8_WAIT_V(8); PG8_WAIT_L(0); PG8_BAR; PG8_MMA(1, 0, At, B0); PG8_MMA(1, 1, At, B1); PG8_BAR; PG8_SCHED;
            } else {
            PG8_LDB(B0, 0, 0); PG8_SCHED; PG8_LDA(At, 0, 0); PG8_STAGE(PG8_SA(1, 1), a1 + hstepA, voffA);
            PG8_WAIT_L(8); PG8_BAR; PG8_WAIT_L(0); PG8_MMA(0, 0, At, B0); PG8_BAR; PG8_SCHED;
            PG8_LDB(B1, 0, 1); PG8_STAGE(PG8_SB(0, 0), b2, voffB);
            PG8_BAR; PG8_WAIT_L(0); PG8_MMA(0, 1, At, B1); PG8_BAR;
            PG8_LDA(At, 0, 1); PG8_STAGE(PG8_SA(0, 0), a2, voffA);
            PG8_BAR; PG8_WAIT_L(0); PG8_MMA(1, 0, At, B0); PG8_BAR; PG8_SCHED;
            PG8_STAGE(PG8_SB(0, 1), b2 + hstep, voffB);
            PG8_WAIT_V(6); PG8_BAR; PG8_MMA(1, 1, At, B1); PG8_BAR;
            PG8_LDB(B0, 1, 0); PG8_SCHED; PG8_LDA(At, 1, 0); PG8_STAGE(PG8_SA(0, 1), a2 + hstepA, voffA);
            PG8_WAIT_L(8); PG8_BAR; PG8_WAIT_L(0); PG8_MMA(0, 0, At, B0); PG8_BAR; PG8_SCHED;
            PG8_LDB(B1, 1, 1); PG8_STAGE(PG8_SB(1, 0), b3, voffB);
            PG8_BAR; PG8_WAIT_L(0); PG8_MMA(0, 1, At, B1); PG8_BAR;
            PG8_LDA(At, 1, 1); PG8_STAGE(PG8_SA(1, 0), a3, voffA);
            PG8_BAR; PG8_WAIT_L(0); PG8_MMA(1, 0, At, B0); PG8_BAR; PG8_SCHED;
            PG8_STAGE(PG8_SB(1, 1), b3 + hstep, voffB);
            PG8_WAIT_V(6); PG8_BAR; PG8_MMA(1, 1, At, B1); PG8_BAR;
            }
        }
        if constexpr (ALIGN_EPI) { if (wr == 0) PG8_BAR; }
        if constexpr (!Epi::AFTER_DRAIN) { E(acc, cur, wr, wc, fr, fq); S.done(cur); }
        if (!has_next) break;
#pragma unroll
        for (int a = 0; a < 2; ++a)
#pragma unroll
            for (int b = 0; b < 2; ++b)
#pragma unroll
                for (int m = 0; m < 4; ++m)
#pragma unroll
                    for (int n = 0; n < 2; ++n) acc[a][b][m][n] = (f32x4){0.f, 0.f, 0.f, 0.f};
        cur = nxt; cA = nA; cB = nB; ++ui;
        if constexpr (ALIGN_EPI) { if (wr == 1) PG8_BAR; }
    }
    PG8_WAIT_V(0);
    if constexpr (!ALIGN_EPI) { if (wr == 0) PG8_BAR; }
    PG8_BAR;
    if constexpr (Epi::AFTER_DRAIN) { E.fused(acc, cur, wr, wc, fr, fq, lds, wid, lane); S.done(cur); }
#undef PG8_SA
#undef PG8_SB
#undef PG8_STAGE
#undef PG8_LDA
#undef PG8_LDB
#undef PG8_MMA
#undef PG8_WAIT_V
#undef PG8_WAIT_L
#undef PG8_BAR
#undef PG8_SCHED
}
}
namespace mk {
#define LAS __attribute__((address_space(3)))
typedef unsigned short bf16_t;
typedef short bf16x8 __attribute__((ext_vector_type(8)));
typedef float f32x4 __attribute__((ext_vector_type(4)));
typedef unsigned u32x4 __attribute__((ext_vector_type(4)));
typedef unsigned u32x2 __attribute__((ext_vector_type(2)));

constexpr int SEQ = 4096, NU = 6912;
constexpr float EPS = 1e-6f;
constexpr int UA_Q = 0, UB_Q = 512, UC_V = 1024, UD_Q = 1536, UA_I = 2048, UA_FF = 2560, UA_FB = 3072, UA_Z = 3584;
constexpr int UB_K = 4096, UB_V = 4224, UB_Z = 4352, UC_Q = 4864, UC_K = 5120, UC_O = 5376, UC_Z = 5888, UD_Z = 6400;
constexpr int NSC = 16;
constexpr int SA_ELEMS = 128 * 128;
constexpr int SC_ROWS = 144, SC_ELEMS = SC_ROWS * 64;

struct MP {
    bf16_t* u;
    const float* gates;
    const bf16_t* kv;
    const float* cs; const float* sn;
    const float* lb;
    const float* hgrn_g; const float* sink; const float* conv_w; const float* gate_b; const float* mlstm_g;
    bf16_t* SA; float* DA;
    bf16_t* SC; float* CS;
    int nb;
};

__device__ __forceinline__ int otid() { int t = threadIdx.x; asm volatile("" : "+v"(t)); return t; }
__device__ __forceinline__ float bf2f(unsigned short h) { return __uint_as_float((unsigned)h << 16); }
__device__ __forceinline__ unsigned short f2bf(float f) { unsigned u = __float_as_uint(f); return (unsigned short)((u + 0x7fffu + ((u >> 16) & 1u)) >> 16); }
__device__ __forceinline__ unsigned pk2(float lo, float hi) { return (unsigned)f2bf(lo) | ((unsigned)f2bf(hi) << 16); }
__device__ __forceinline__ float sigm(float x) { return 1.0f / (1.0f + __expf(-x)); }
__device__ __forceinline__ float silu(float x) { return x / (1.0f + __expf(-x)); }

template <int K>
__device__ __forceinline__ void mma_nt(f32x4& acc, const LAS bf16_t* A, int lda, int m0, const LAS bf16_t* Bt, int ldb, int n0, int lane) {
    const LAS bf16_t* ap = A + (m0 + (lane & 15)) * lda + 8 * (lane >> 4);
    const LAS bf16_t* bp = Bt + (n0 + (lane & 15)) * ldb + 8 * (lane >> 4);
#pragma unroll
    for (int k0 = 0; k0 < K; k0 += 32) {
        const bf16x8 a = *(const LAS bf16x8*)(ap + k0);
        const bf16x8 b = *(const LAS bf16x8*)(bp + k0);
        acc = __builtin_amdgcn_mfma_f32_16x16x32_bf16(a, b, acc, 0, 0, 0);
    }
}
__device__ __forceinline__ float grp16_max(float v) { v = fmaxf(v, __shfl_xor(v, 1)); v = fmaxf(v, __shfl_xor(v, 2)); v = fmaxf(v, __shfl_xor(v, 4)); v = fmaxf(v, __shfl_xor(v, 8)); return v; }
__device__ __forceinline__ float grp16_sum(float v) { v += __shfl_xor(v, 1); v += __shfl_xor(v, 2); v += __shfl_xor(v, 4); v += __shfl_xor(v, 8); return v; }

__device__ __forceinline__ void d_item(const MP& p, LAS unsigned char* lds, int item) {
    const int tid = otid(), lane = tid & 63, w = __builtin_amdgcn_readfirstlane(tid >> 6);
    const int qt = item & 63, h = (item >> 6) & 3, b = item >> 8;
    const size_t row0 = (size_t)b * SEQ + qt * 64;
    LAS bf16_t* Qs = (LAS bf16_t*)lds;
    LAS bf16_t* KV = Qs + 64 * 136;
    LAS bf16_t* Ps = KV + 256 * 136;
    LAS float* red = (LAS float*)(Ps + 64 * 264);
    for (int c = tid; c < 64 * 16; c += 512) { const int r = c >> 4, ch = c & 15;
        const u32x4 v = *(const u32x4*)(p.u + (row0 + r) * NU + UD_Q + h * 128 + ch * 8); *(LAS u32x4*)(Qs + r * 136 + ch * 8) = v; }
    for (int c = tid; c < 256 * 16; c += 512) { const int r = c >> 4, ch = c & 15;
        const u32x4 v = *(const u32x4*)(p.kv + ((size_t)b * 256 + r) * 1024 + h * 128 + ch * 8); *(LAS u32x4*)(KV + r * 136 + ch * 8) = v; }
    __syncthreads();
    const int mb = w >> 1, nh = w & 1, q4 = lane >> 4, c16 = lane & 15;
    f32x4 s[8];
#pragma unroll
    for (int j = 0; j < 8; ++j) { s[j] = (f32x4){0.f, 0.f, 0.f, 0.f}; mma_nt<128>(s[j], Qs, 136, mb * 16, KV, 136, nh * 128 + j * 16, lane); }
    const float scale = 0.08838834764831845f;
    float mx[4];
#pragma unroll
    for (int i = 0; i < 4; ++i) { float m = -INFINITY;
#pragma unroll
        for (int j = 0; j < 8; ++j) { s[j][i] *= scale; m = fmaxf(m, s[j][i]); }
        mx[i] = grp16_max(m); }
    if (c16 == 0) {
#pragma unroll
        for (int i = 0; i < 4; ++i) red[nh * 64 + mb * 16 + 4 * q4 + i] = mx[i]; }
    __syncthreads();
#pragma unroll
    for (int i = 0; i < 4; ++i) { const int r = mb * 16 + 4 * q4 + i; const float m = fmaxf(red[r], red[64 + r]); float sum = 0.f;
#pragma unroll
        for (int j = 0; j < 8; ++j) { const float e = __expf(s[j][i] - m); sum += e; Ps[r * 264 + nh * 128 + j * 16 + c16] = f2bf(e); }
        sum = grp16_sum(sum);
        if (c16 == 0) red[128 + nh * 64 + r] = sum; }
    __syncthreads();
    for (int c = tid; c < 256 * 16; c += 512) { const int j = c & 255, ch = c >> 8;
        const u32x4 v = *(const u32x4*)(p.kv + ((size_t)b * 256 + j) * 1024 + 512 + h * 128 + ch * 8);
        LAS bf16_t* d = KV + (ch * 8) * 264 + j;
        d[0 * 264] = (bf16_t)(v.x & 0xffffu); d[1 * 264] = (bf16_t)(v.x >> 16); d[2 * 264] = (bf16_t)(v.y & 0xffffu); d[3 * 264] = (bf16_t)(v.y >> 16);
        d[4 * 264] = (bf16_t)(v.z & 0xffffu); d[5 * 264] = (bf16_t)(v.z >> 16); d[6 * 264] = (bf16_t)(v.w & 0xffffu); d[7 * 264] = (bf16_t)(v.w >> 16); }
    __syncthreads();
    f32x4 o[4];
#pragma unroll
    for (int n = 0; n < 4; ++n) { o[n] = (f32x4){0.f, 0.f, 0.f, 0.f}; mma_nt<256>(o[n], Ps, 264, mb * 16, KV, 264, (nh * 4 + n) * 16, lane); }
#pragma unroll
    for (int i = 0; i < 4; ++i) { const int r = mb * 16 + 4 * q4 + i; const float inv = 1.0f / (red[128 + r] + red[192 + r]);
        bf16_t* urow = p.u + (row0 + r) * NU;
#pragma unroll
        for (int n = 0; n < 4; ++n) { const int col = h * 128 + (nh * 4 + n) * 16 + c16;
            const float z = bf2f(urow[UD_Z + col]); urow[UD_Q + col] = f2bf(o[n][i] * inv * silu(z)); } }
    __syncthreads();
}

__device__ __forceinline__ void b_item(const MP& p, LAS unsigned char* lds, int item) {
    const int tid = otid(), lane = tid & 63, w = __builtin_amdgcn_readfirstlane(tid >> 6);
    const int qt = item & 63, kvh = (item >> 6) & 1, b = item >> 7;
    const int t0 = qt * 64; const size_t brow = (size_t)b * SEQ;
    LAS bf16_t* Ks = (LAS bf16_t*)lds;
    LAS bf16_t* Vt = Ks + 320 * 72;
    LAS bf16_t* Qs = Vt + 64 * 328;
    LAS bf16_t* Ps = Qs + 64 * 72;
    LAS float* red = (LAS float*)(Ps + 64 * 328);
    const int k0 = t0 - 128;
    for (int c = tid; c < 320 * 4; c += 512) { const int j = c >> 2, part = c & 3; const int kp = k0 + j;
        u32x4 a = (u32x4){0u, 0u, 0u, 0u}, bb = a;
        if (kp >= 0 && kp < SEQ) {
            const bf16_t* src = p.u + (brow + kp) * NU + UB_K + kvh * 64 + part * 16;
            a = *(const u32x4*)src; bb = *(const u32x4*)(src + 8);
            if (part == 0) {
                const float* cs = p.cs + (brow + kp) * 8; const float* sn = p.sn + (brow + kp) * 8;
                float x1[8], x2[8];
                x1[0] = bf2f(a.x & 0xffffu); x1[1] = bf2f(a.x >> 16); x1[2] = bf2f(a.y & 0xffffu); x1[3] = bf2f(a.y >> 16); x1[4] = bf2f(a.z & 0xffffu); x1[5] = bf2f(a.z >> 16); x1[6] = bf2f(a.w & 0xffffu); x1[7] = bf2f(a.w >> 16);
                x2[0] = bf2f(bb.x & 0xffffu); x2[1] = bf2f(bb.x >> 16); x2[2] = bf2f(bb.y & 0xffffu); x2[3] = bf2f(bb.y >> 16); x2[4] = bf2f(bb.z & 0xffffu); x2[5] = bf2f(bb.z >> 16); x2[6] = bf2f(bb.w & 0xffffu); x2[7] = bf2f(bb.w >> 16);
                float r1[8], r2[8];
#pragma unroll
                for (int e = 0; e < 8; ++e) { const float cc = cs[e], ss = sn[e]; r1[e] = x1[e] * cc - x2[e] * ss; r2[e] = x2[e] * cc + x1[e] * ss; }
                a = (u32x4){pk2(r1[0], r1[1]), pk2(r1[2], r1[3]), pk2(r1[4], r1[5]), pk2(r1[6], r1[7])};
                bb = (u32x4){pk2(r2[0], r2[1]), pk2(r2[2], r2[3]), pk2(r2[4], r2[5]), pk2(r2[6], r2[7])};
            }
        }
        *(LAS u32x4*)(Ks + j * 72 + part * 16) = a; *(LAS u32x4*)(Ks + j * 72 + part * 16 + 8) = bb; }
    for (int c = tid; c < 320 * 8; c += 512) { const int j = c % 320, ch = c / 320; const int kp = k0 + j;
        u32x4 v = (u32x4){0u, 0u, 0u, 0u};
        if (kp >= 0 && kp < SEQ) v = *(const u32x4*)(p.u + (brow + kp) * NU + UB_V + kvh * 64 + ch * 8);
        LAS bf16_t* d = Vt + (ch * 8) * 328 + j;
        d[0 * 328] = (bf16_t)(v.x & 0xffffu); d[1 * 328] = (bf16_t)(v.x >> 16); d[2 * 328] = (bf16_t)(v.y & 0xffffu); d[3 * 328] = (bf16_t)(v.y >> 16);
        d[4 * 328] = (bf16_t)(v.z & 0xffffu); d[5 * 328] = (bf16_t)(v.z >> 16); d[6 * 328] = (bf16_t)(v.w & 0xffffu); d[7 * 328] = (bf16_t)(v.w >> 16); }
    const int mb = w >> 1, nh = w & 1, q4 = lane >> 4, c16 = lane & 15;
    for (int g = 0; g < 4; ++g) {
        const int hq = kvh * 4 + g;
        for (int c = tid; c < 64 * 4; c += 512) { const int r = c >> 2, part = c & 3;
            const bf16_t* src = p.u + (brow + t0 + r) * NU + UB_Q + hq * 64 + part * 16;
            u32x4 a = *(const u32x4*)src, bb = *(const u32x4*)(src + 8);
            if (part == 0) {
                const float* cs = p.cs + (brow + t0 + r) * 8; const float* sn = p.sn + (brow + t0 + r) * 8;
                float x1[8], x2[8];
                x1[0] = bf2f(a.x & 0xffffu); x1[1] = bf2f(a.x >> 16); x1[2] = bf2f(a.y & 0xffffu); x1[3] = bf2f(a.y >> 16); x1[4] = bf2f(a.z & 0xffffu); x1[5] = bf2f(a.z >> 16); x1[6] = bf2f(a.w & 0xffffu); x1[7] = bf2f(a.w >> 16);
                x2[0] = bf2f(bb.x & 0xffffu); x2[1] = bf2f(bb.x >> 16); x2[2] = bf2f(bb.y & 0xffffu); x2[3] = bf2f(bb.y >> 16); x2[4] = bf2f(bb.z & 0xffffu); x2[5] = bf2f(bb.z >> 16); x2[6] = bf2f(bb.w & 0xffffu); x2[7] = bf2f(bb.w >> 16);
                float r1[8], r2[8];
#pragma unroll
                for (int e = 0; e < 8; ++e) { const float cc = cs[e], ss = sn[e]; r1[e] = x1[e] * cc - x2[e] * ss; r2[e] = x2[e] * cc + x1[e] * ss; }
                a = (u32x4){pk2(r1[0], r1[1]), pk2(r1[2], r1[3]), pk2(r1[4], r1[5]), pk2(r1[6], r1[7])};
                bb = (u32x4){pk2(r2[0], r2[1]), pk2(r2[2], r2[3]), pk2(r2[4], r2[5]), pk2(r2[6], r2[7])};
            }
            *(LAS u32x4*)(Qs + r * 72 + part * 16) = a; *(LAS u32x4*)(Qs + r * 72 + part * 16 + 8) = bb; }
        __syncthreads();
        f32x4 s[10];
#pragma unroll
        for (int j = 0; j < 10; ++j) { s[j] = (f32x4){0.f, 0.f, 0.f, 0.f}; mma_nt<64>(s[j], Qs, 72, mb * 16, Ks, 72, nh * 160 + j * 16, lane); }
        const float sk = p.sink[hq];
        float mx[4];
#pragma unroll
        for (int i = 0; i < 4; ++i) { const int qp = t0 + mb * 16 + 4 * q4 + i; float m = -INFINITY;
#pragma unroll
            for (int j = 0; j < 10; ++j) { const int kp = k0 + nh * 160 + j * 16 + c16; const int df = kp - qp;
                const bool ok = (kp >= 0) && (kp < SEQ) && (df <= 128) && (df >= -128);
                const float v = ok ? s[j][i] * 0.125f : -INFINITY; s[j][i] = v; m = fmaxf(m, v); }
            mx[i] = grp16_max(m); }
        if (c16 == 0) {
#pragma unroll
            for (int i = 0; i < 4; ++i) red[nh * 64 + mb * 16 + 4 * q4 + i] = mx[i]; }
        __syncthreads();
#pragma unroll
        for (int i = 0; i < 4; ++i) { const int r = mb * 16 + 4 * q4 + i; const float m = fmaxf(fmaxf(red[r], red[64 + r]), sk); float sum = 0.f;
#pragma unroll
            for (int j = 0; j < 10; ++j) { const float e = __expf(s[j][i] - m); sum += e; Ps[r * 328 + nh * 160 + j * 16 + c16] = f2bf(e); }
            sum = grp16_sum(sum);
            if (c16 == 0) { red[128 + nh * 64 + r] = sum; if (nh == 0) red[256 + r] = __expf(sk - m); } }
        __syncthreads();
        f32x4 o[2];
#pragma unroll
        for (int n = 0; n < 2; ++n) { o[n] = (f32x4){0.f, 0.f, 0.f, 0.f}; mma_nt<320>(o[n], Ps, 328, mb * 16, Vt, 328, (nh * 2 + n) * 16, lane); }
#pragma unroll
        for (int i = 0; i < 4; ++i) { const int r = mb * 16 + 4 * q4 + i; const float inv = 1.0f / (red[128 + r] + red[192 + r] + red[256 + r]);
            bf16_t* urow = p.u + (brow + t0 + r) * NU;
#pragma unroll
            for (int n = 0; n < 2; ++n) { const int col = hq * 64 + (nh * 2 + n) * 16 + c16;
                const float z = bf2f(urow[UB_Z + col]); urow[UB_Q + col] = f2bf(o[n][i] * inv * silu(z)); } }
        __syncthreads();
    }
}

struct ALds {
    LAS bf16_t *Qt, *Kt, *Qh, *KhT, *Vt, *Pm, *St; LAS float *seg, *Dl, *stats;
};
__device__ __forceinline__ ALds a_lds(LAS unsigned char* lds) {
    ALds L; L.Qt = (LAS bf16_t*)lds; L.Kt = L.Qt + 64 * 136; L.Qh = L.Kt + 64 * 136; L.KhT = L.Qh + 64 * 136; L.Vt = L.KhT + 128 * 72; L.Pm = L.Vt + 128 * 72;
    L.St = L.Pm + 64 * 72; L.seg = (LAS float*)(L.St + 128 * 136); L.Dl = L.seg + 512; L.stats = L.Dl + 128; return L;
}
template <int MODE>
__device__ __forceinline__ float a_gates(const MP& p, const ALds& L, size_t tbase, int h, int dir, float carry) {
    const int tid = otid(), d = tid & 127, sg = tid >> 7;
    const float lbv = p.lb[h * 128 + d];
    unsigned off = (unsigned)((tbase + sg * 16) * NU + h * 128 + d);
    float g[16], kk[16]; unsigned qp[8], vp[8];
#pragma unroll
    for (int k = 0; k < 16; ++k) {
        asm volatile("" : "+v"(off));
        const float z = bf2f(p.u[off + (dir ? UA_FB : UA_FF)]);
        const unsigned vv = p.u[off + UA_I];
        if (k & 1) vp[k >> 1] |= vv << 16; else vp[k >> 1] = vv;
        if (MODE == 1) { const unsigned qq = p.u[off + UA_Q]; if (k & 1) qp[k >> 1] |= qq << 16; else qp[k >> 1] = qq; }
        const float f = lbv + (1.f - lbv) * sigm(z);
        g[k] = __logf(f); kk[k] = 1.f - f;
        off += NU; }
    if (dir == 0) {
#pragma unroll
        for (int k = 1; k < 16; ++k) g[k] += g[k - 1];
        L.seg[sg * 128 + d] = g[15];
    } else {
#pragma unroll
        for (int k = 14; k >= 0; --k) g[k] += g[k + 1];
        L.seg[sg * 128 + d] = g[0];
    }
    __syncthreads();
    const float s0 = L.seg[d], s1 = L.seg[128 + d], s2 = L.seg[256 + d], s3 = L.seg[384 + d];
    const float tot = (s0 + s1) + (s2 + s3);
    float pre;
    if (dir == 0) pre = (sg > 0 ? s0 : 0.f) + (sg > 1 ? s1 : 0.f) + (sg > 2 ? s2 : 0.f);
    else pre = (sg < 3 ? s3 : 0.f) + (sg < 2 ? s2 : 0.f) + (sg < 1 ? s1 : 0.f);
    const float ref = dir == 0 ? (s0 + s1) : (s2 + s3);
    unsigned khp[8];
#pragma unroll
    for (int k = 0; k < 16; ++k) { const float bk = pre + g[k];
        const int pp = sg * 16 + k;
        const unsigned khb = f2bf(kk[k] * __expf((tot - bk) + carry));
        if (k & 1) khp[k >> 1] |= khb << 16; else khp[k >> 1] = khb;
        if (MODE == 1) {
            const float qv = bf2f((unsigned short)((k & 1) ? (qp[k >> 1] >> 16) : (qp[k >> 1] & 0xffffu)));
            L.Qt[pp * 136 + d] = f2bf(qv * __expf(bk - ref));
            L.Kt[pp * 136 + d] = f2bf(kk[k] * __expf(ref - bk));
            L.Qh[pp * 136 + d] = f2bf(qv * __expf(bk));
        } }
    *(LAS u32x4*)(L.KhT + d * 72 + sg * 16) = (u32x4){khp[0], khp[1], khp[2], khp[3]};
    *(LAS u32x4*)(L.KhT + d * 72 + sg * 16 + 8) = (u32x4){khp[4], khp[5], khp[6], khp[7]};
    if (MODE == 1 && sg == 0) L.Dl[d] = __expf(tot);
    *(LAS u32x4*)(L.Vt + d * 72 + sg * 16) = (u32x4){vp[0], vp[1], vp[2], vp[3]};
    *(LAS u32x4*)(L.Vt + d * 72 + sg * 16 + 8) = (u32x4){vp[4], vp[5], vp[6], vp[7]};
    return tot;
}

__device__ __forceinline__ void a_pass1(const MP& p, LAS unsigned char* lds, int item) {
    const int tid = otid(), lane = tid & 63, w = __builtin_amdgcn_readfirstlane(tid >> 6);
    const int dir = item & 1, sc = (item >> 1) & 15, h = (item >> 5) & 3, b = item >> 7;
    const ALds L = a_lds(lds);
    const int q4 = lane >> 4, c16 = lane & 15;
    f32x4 S[8];
#pragma unroll
    for (int j = 0; j < 8; ++j) S[j] = (f32x4){0.f, 0.f, 0.f, 0.f};
    float carry = 0.f;
    for (int ci = 0; ci < 4; ++ci) {
        const int cc = dir ? ci : 3 - ci;
        const size_t tbase = (size_t)b * SEQ + sc * 256 + cc * 64;
        const float tot = a_gates<0>(p, L, tbase, h, dir, carry);
        carry += tot;
        __syncthreads();
#pragma unroll
        for (int j = 0; j < 8; ++j) mma_nt<64>(S[j], L.KhT, 72, j * 16, L.Vt, 72, w * 16, lane);
        __syncthreads();
    }
    const size_t sidx = ((size_t)(dir * p.nb * 4 + b * 4 + h) * NSC + sc);
    bf16_t* dst = p.SA + sidx * SA_ELEMS;
#pragma unroll
    for (int j = 0; j < 8; ++j) {
        *(u32x2*)(dst + (size_t)(w * 16 + c16) * 128 + j * 16 + 4 * q4) = (u32x2){pk2(S[j][0], S[j][1]), pk2(S[j][2], S[j][3])}; }
    if (tid < 128) p.DA[sidx * 128 + tid] = __expf(carry);
}

__device__ __forceinline__ void a_scan_unit(const MP& p, int unit) {
    const int e4 = unit & 4095, seq = unit >> 12;
    const int dir = seq / (p.nb * 4);
    const int dk = (e4 * 4) & 127;
    float S0 = 0.f, S1 = 0.f, S2 = 0.f, S3 = 0.f;
    for (int i = 0; i < NSC; ++i) {
        const int sc = dir ? NSC - 1 - i : i;
        bf16_t* ptr = p.SA + ((size_t)seq * NSC + sc) * SA_ELEMS + e4 * 4;
        const u32x2 v = *(const u32x2*)ptr;
        const f32x4 D = *(const f32x4*)(p.DA + ((size_t)seq * NSC + sc) * 128 + dk);
        *(u32x2*)ptr = (u32x2){pk2(S0, S1), pk2(S2, S3)};
        S0 = D[0] * S0 + bf2f(v.x & 0xffffu); S1 = D[1] * S1 + bf2f(v.x >> 16); S2 = D[2] * S2 + bf2f(v.y & 0xffffu); S3 = D[3] * S3 + bf2f(v.y >> 16);
    }
}

__device__ __forceinline__ void a_pass3(const MP& p, LAS unsigned char* lds, int item) {
    const int tid = otid(), lane = tid & 63, w = __builtin_amdgcn_readfirstlane(tid >> 6);
    const int sc = item & 15, h = (item >> 4) & 3, b = item >> 6;
    const ALds L = a_lds(lds);
    const int q4 = lane >> 4, c16 = lane & 15, mb2 = w >> 1, nh = w & 1;
    f32x4 O[4][4];
#pragma unroll
    for (int a = 0; a < 4; ++a)
#pragma unroll
        for (int m = 0; m < 4; ++m) O[a][m] = (f32x4){0.f, 0.f, 0.f, 0.f};
#pragma unroll 1
    for (int dir = 0; dir < 2; ++dir) {
        const size_t sidx = ((size_t)(dir * p.nb * 4 + b * 4 + h) * NSC + sc);
        const bf16_t* sg = p.SA + sidx * SA_ELEMS;
        for (int c = tid; c < 128 * 16; c += 512) { const int r = c >> 4, ch = c & 15; *(LAS u32x4*)(L.St + r * 136 + ch * 8) = *(const u32x4*)(sg + r * 128 + ch * 8); }
        f32x4 S[8];
#pragma unroll
        for (int j = 0; j < 8; ++j) { const u32x2 v = *(const u32x2*)(sg + (size_t)(w * 16 + c16) * 128 + j * 16 + 4 * q4);
            S[j] = (f32x4){bf2f(v.x & 0xffffu), bf2f(v.x >> 16), bf2f(v.y & 0xffffu), bf2f(v.y >> 16)}; }
#pragma unroll 1
        for (int ci = 0; ci < 4; ++ci) {
            const int cc = dir ? 3 - ci : ci;
            const size_t tbase = (size_t)b * SEQ + sc * 256 + cc * 64;
            (void)a_gates<1>(p, L, tbase, h, dir, 0.f);
            __syncthreads();
#pragma unroll
            for (int n = 0; n < 2; ++n) { f32x4 a = (f32x4){0.f, 0.f, 0.f, 0.f}; const int nb16 = nh * 2 + n;
                mma_nt<128>(a, L.Qt, 136, mb2 * 16, L.Kt, 136, nb16 * 16, lane);
#pragma unroll
                for (int i = 0; i < 4; ++i) { const int pt = mb2 * 16 + 4 * q4 + i, ps = nb16 * 16 + c16;
                    const bool keep = dir ? (ps >= pt) : (ps <= pt);
                    L.Pm[pt * 72 + ps] = f2bf(keep ? a[i] : 0.f); } }
            __syncthreads();
            f32x4 T[4];
#pragma unroll
            for (int m = 0; m < 4; ++m) { T[m] = (f32x4){0.f, 0.f, 0.f, 0.f};
                mma_nt<64>(T[m], L.Pm, 72, m * 16, L.Vt, 72, w * 16, lane);
                mma_nt<128>(T[m], L.Qh, 136, m * 16, L.St, 136, w * 16, lane);
                __builtin_amdgcn_sched_barrier(0); }
            if (cc == 0) {
#pragma unroll
                for (int m = 0; m < 4; ++m) O[0][m] += T[m];
            } else if (cc == 1) {
#pragma unroll
                for (int m = 0; m < 4; ++m) O[1][m] += T[m];
            } else if (cc == 2) {
#pragma unroll
                for (int m = 0; m < 4; ++m) O[2][m] += T[m];
            } else {
#pragma unroll
                for (int m = 0; m < 4; ++m) O[3][m] += T[m];
            }
#pragma unroll
            for (int j = 0; j < 8; ++j) { const f32x4 D = *(const LAS f32x4*)(L.Dl + j * 16 + 4 * q4);
                S[j] = S[j] * D;
                mma_nt<64>(S[j], L.KhT, 72, j * 16, L.Vt, 72, w * 16, lane);
                *(LAS u32x2*)(L.St + (w * 16 + c16) * 136 + j * 16 + 4 * q4) = (u32x2){pk2(S[j][0], S[j][1]), pk2(S[j][2], S[j][3])};
                __builtin_amdgcn_sched_barrier(0); }
            __syncthreads();
        }
    }
    int q4e = q4 * 4; asm volatile("" : "+v"(q4e));
#pragma unroll
    for (int a = 0; a < 4; ++a)
#pragma unroll
        for (int m = 0; m < 4; ++m)
#pragma unroll
            for (int i = 0; i < 4; ++i) { const float v = O[a][m][i]; const float s = grp16_sum(v * v);
                if (c16 == 0) L.stats[w * 256 + a * 64 + m * 16 + q4e + i] = s; }
    __syncthreads();
    const float gn = p.hgrn_g[h * 128 + w * 16 + c16];
    const unsigned ebase = (unsigned)(((size_t)b * SEQ + sc * 256) * NU + h * 128 + w * 16 + c16);
#pragma unroll
    for (int a = 0; a < 4; ++a)
#pragma unroll
        for (int m = 0; m < 4; ++m)
#pragma unroll
            for (int i = 0; i < 4; ++i) { const int tl = a * 64 + m * 16 + q4e + i;
                float ss = 0.f;
#pragma unroll
                for (int ww = 0; ww < 8; ++ww) ss += L.stats[ww * 256 + tl];
                const float rs = 1.0f / sqrtf(ss * (1.0f / 128.f) + EPS);
                unsigned eo = ebase + (unsigned)tl * NU; asm volatile("" : "+v"(eo));
                const float z = bf2f(p.u[eo + UA_Z]);
                p.u[eo + UA_Q] = f2bf(O[a][m][i] * rs * gn * silu(z));
                if (i == 3) asm volatile("" ::: "memory"); }
    __syncthreads();
}

struct CLds {
    LAS bf16_t *Qc, *Kc, *Qg, *KhT, *Vt, *Pw, *St, *raw; LAS float *sc;
};
__device__ __forceinline__ CLds c_lds(LAS unsigned char* lds) {
    CLds L; L.Qc = (LAS bf16_t*)lds; L.Kc = L.Qc + 64 * 72; L.Qg = L.Kc + 64 * 72; L.KhT = L.Qg + 64 * 72; L.Vt = L.KhT + 64 * 72; L.Pw = L.Vt + 144 * 72; L.St = L.Pw + 64 * 72;
    L.raw = L.St + 144 * 72; L.sc = (LAS float*)(L.raw + 68 * 136); return L;
}
__device__ __forceinline__ float log_sigmoid(float x) { return fminf(x, 0.f) - log1pf(__expf(-fabsf(x))); }

template <bool WANT_Q>
__device__ __forceinline__ void c_load_qkv(const MP& p, const CLds& L, int b, int tl0  , int h) {
    const int tid = otid();
    const size_t brow = (size_t)b * SEQ;
    for (int c = tid; c < 68 * 16; c += 512) { const int r = c >> 4, ch = c & 15; const int tl = tl0 - 2 + r;
        u32x4 v = (u32x4){0u, 0u, 0u, 0u};
        if (tl >= 0 && tl < SEQ) v = *(const u32x4*)(p.u + (brow + tl) * NU + (ch < 8 ? UC_Q + h * 64 + ch * 8 : UC_K + h * 64 + (ch - 8) * 8));
        *(LAS u32x4*)(L.raw + r * 136 + ch * 8) = v; }
    {
        const int d = tid & 127, sg = tid >> 7;
        unsigned off = (unsigned)((brow + tl0 + sg * 16) * NU + UC_V + h * 128 + d);
        unsigned vp[8];
#pragma unroll
        for (int k = 0; k < 16; ++k) { asm volatile("" : "+v"(off)); const unsigned vv = p.u[off]; if (k & 1) vp[k >> 1] |= vv << 16; else vp[k >> 1] = vv; off += NU; }
        *(LAS u32x4*)(L.Vt + d * 72 + sg * 16) = (u32x4){vp[0], vp[1], vp[2], vp[3]};
        *(LAS u32x4*)(L.Vt + d * 72 + sg * 16 + 8) = (u32x4){vp[4], vp[5], vp[6], vp[7]};
        if (tid < 16 * 8) { const int r = 128 + (tid >> 3), ch = tid & 7; const unsigned one = (r == 128) ? 0x3f803f80u : 0u; *(LAS u32x4*)(L.Vt + r * 72 + ch * 8) = (u32x4){one, one, one, one}; }
    }
    __syncthreads();
    for (int e = tid; e < 64 * 128; e += 512) { const int pp = e >> 7, ch = e & 127;
        if (!WANT_Q && ch < 64) continue;
        const int wc = (ch < 64) ? (h * 64 + ch) : (256 + h * 64 + (ch - 64));
        float s = 0.f;
#pragma unroll
        for (int j = 0; j < 5; ++j) s = fmaf(bf2f(L.raw[(pp + j) * 136 + ch]), p.conv_w[j * 512 + wc], s);
        s = silu(s);
        if (ch < 64) L.Qc[pp * 72 + ch] = f2bf(s * 0.125f); else L.Kc[pp * 72 + (ch - 64)] = f2bf(s); }
}

__device__ __forceinline__ void c_pass1(const MP& p, LAS unsigned char* lds, int item) {
    const int tid = otid(), lane = tid & 63, w = __builtin_amdgcn_readfirstlane(tid >> 6);
    const int dir = item & 1, sc = (item >> 1) & 15, h = (item >> 5) & 3, b = item >> 7;
    const CLds L = c_lds(lds);
    const int q4 = lane >> 4, c16 = lane & 15;
    const size_t brow = (size_t)b * SEQ; const int tls = sc * 256;
    if (w == 0) {
        const float bi = p.gate_b[dir * 4 + h], bf = p.gate_b[8 + dir * 4 + h];
        float lf[4], li[4];
#pragma unroll
        for (int k = 0; k < 4; ++k) { const float* gr = p.gates + (brow + tls + lane * 4 + k) * 16; li[k] = gr[dir * 4 + h] + bi; lf[k] = log_sigmoid(gr[8 + dir * 4 + h] + bf); }
        const float tot4 = (lf[0] + lf[1]) + (lf[2] + lf[3]);
        float incl = tot4;
        if (dir == 0) {
#pragma unroll
            for (int o = 1; o < 64; o <<= 1) { const float t = __shfl_down(incl, o); if (lane + o < 64) incl += t; }
        } else {
#pragma unroll
            for (int o = 1; o < 64; o <<= 1) { const float t = __shfl_up(incl, o); if (lane >= o) incl += t; }
        }
        const float after_lane = incl - tot4;
        float E[4];
        if (dir == 0) { E[3] = after_lane; E[2] = E[3] + lf[3]; E[1] = E[2] + lf[2]; E[0] = E[1] + lf[1]; }
        else { E[0] = after_lane; E[1] = E[0] + lf[0]; E[2] = E[1] + lf[1]; E[3] = E[2] + lf[2]; }
        float a[4], amax = -INFINITY;
#pragma unroll
        for (int k = 0; k < 4; ++k) { a[k] = E[k] + li[k]; amax = fmaxf(amax, a[k]); }
#pragma unroll
        for (int o = 32; o > 0; o >>= 1) amax = fmaxf(amax, __shfl_xor(amax, o));
        float Btot = tot4;
#pragma unroll
        for (int o = 32; o > 0; o >>= 1) Btot += __shfl_xor(Btot, o);
#pragma unroll
        for (int k = 0; k < 4; ++k) L.sc[192 + lane * 4 + k] = __expf(a[k] - amax);
        if (lane == 0) { L.sc[576 + 2] = amax; L.sc[576 + 3] = Btot; }
    }
    f32x4 S[5];
#pragma unroll
    for (int j = 0; j < 5; ++j) S[j] = (f32x4){0.f, 0.f, 0.f, 0.f};
    for (int cc = 0; cc < 4; ++cc) {
        c_load_qkv<false>(p, L, b, tls + cc * 64, h);
        __syncthreads();
        for (int e = tid; e < 64 * 64; e += 512) { const int pp = e & 63, dk = e >> 6;
            L.KhT[dk * 72 + pp] = f2bf(L.sc[192 + cc * 64 + pp] * bf2f(L.Kc[pp * 72 + dk])); }
        __syncthreads();
#pragma unroll
        for (int j = 0; j < 4; ++j) mma_nt<64>(S[j], L.KhT, 72, j * 16, L.Vt, 72, w * 16, lane);
        if (w < 4) mma_nt<64>(S[4], L.KhT, 72, w * 16, L.Vt, 72, 128, lane);
        __syncthreads();
    }
    const size_t sidx = ((size_t)(dir * p.nb * 4 + b * 4 + h) * NSC + sc);
    bf16_t* dst = p.SC + sidx * SC_ELEMS;
#pragma unroll
    for (int j = 0; j < 4; ++j) *(u32x2*)(dst + (size_t)(w * 16 + c16) * 64 + j * 16 + 4 * q4) = (u32x2){pk2(S[j][0], S[j][1]), pk2(S[j][2], S[j][3])};
    if (w < 4) *(u32x2*)(dst + (size_t)(128 + c16) * 64 + w * 16 + 4 * q4) = (u32x2){pk2(S[4][0], S[4][1]), pk2(S[4][2], S[4][3])};
    if (tid == 0) { p.CS[sidx * 4 + 0] = L.sc[576 + 2]; p.CS[sidx * 4 + 1] = L.sc[576 + 3]; }
    __syncthreads();
}

__device__ __forceinline__ void c_scan_unit(const MP& p, int unit) {
    const int e4 = unit % 2304, seq = unit / 2304;
    const int dir = seq / (p.nb * 4);
    float S0 = 0.f, S1 = 0.f, S2 = 0.f, S3 = 0.f, M = 0.f;
    for (int i = 0; i < NSC; ++i) {
        const int sc = dir ? NSC - 1 - i : i;
        const size_t sidx = (size_t)seq * NSC + sc;
        bf16_t* ptr = p.SC + sidx * SC_ELEMS + e4 * 4;
        const u32x2 v = *(const u32x2*)ptr;
        const float A = p.CS[sidx * 4 + 0], B = p.CS[sidx * 4 + 1];
        *(u32x2*)ptr = (u32x2){pk2(S0, S1), pk2(S2, S3)};
        if (e4 == 0) p.CS[sidx * 4 + 2] = M;
        const float Mn = fmaxf(B + M, A);
        const float dc = __expf(B + M - Mn), wn = __expf(A - Mn);
        S0 = dc * S0 + wn * bf2f(v.x & 0xffffu); S1 = dc * S1 + wn * bf2f(v.x >> 16); S2 = dc * S2 + wn * bf2f(v.y & 0xffffu); S3 = dc * S3 + wn * bf2f(v.y >> 16);
        M = Mn;
    }
}

__device__ __forceinline__ void c_pass3(const MP& p, LAS unsigned char* lds, int item) {
    const int tid = otid(), lane = tid & 63, w = __builtin_amdgcn_readfirstlane(tid >> 6);
    const int sc = item & 15, h = (item >> 4) & 3, b = item >> 6;
    const CLds L = c_lds(lds);
    const int q4 = lane >> 4, c16 = lane & 15, mb2 = w >> 1, nh = w & 1;
    const size_t brow = (size_t)b * SEQ; const int tls = sc * 256;
    f32x4 H[4][4];
#pragma unroll
    for (int a = 0; a < 4; ++a)
#pragma unroll
        for (int m = 0; m < 4; ++m) H[a][m] = (f32x4){0.f, 0.f, 0.f, 0.f};
#pragma unroll 1
    for (int dir = 0; dir < 2; ++dir) {
        const size_t sidx = ((size_t)(dir * p.nb * 4 + b * 4 + h) * NSC + sc);
        const bf16_t* sg = p.SC + sidx * SC_ELEMS;
        for (int c = tid; c < 144 * 8; c += 512) { const int r = c >> 3, ch = c & 7; *(LAS u32x4*)(L.St + r * 72 + ch * 8) = *(const u32x4*)(sg + r * 64 + ch * 8); }
        f32x4 S[5];
#pragma unroll
        for (int j = 0; j < 4; ++j) { const u32x2 v = *(const u32x2*)(sg + (size_t)(w * 16 + c16) * 64 + j * 16 + 4 * q4);
            S[j] = (f32x4){bf2f(v.x & 0xffffu), bf2f(v.x >> 16), bf2f(v.y & 0xffffu), bf2f(v.y >> 16)}; }
        S[4] = (f32x4){0.f, 0.f, 0.f, 0.f};
        if (w < 4) { const u32x2 v = *(const u32x2*)(sg + (size_t)(128 + c16) * 64 + w * 16 + 4 * q4);
            S[4] = (f32x4){bf2f(v.x & 0xffffu), bf2f(v.x >> 16), bf2f(v.y & 0xffffu), bf2f(v.y >> 16)}; }
        if (tid == 0) L.sc[576 + 1] = p.CS[sidx * 4 + 2];
#pragma unroll 1
        for (int ci = 0; ci < 4; ++ci) {
            const int cc = dir ? 3 - ci : ci;
            const int tl0 = tls + cc * 64;
            c_load_qkv<true>(p, L, b, tl0, h);
            if (w == 0) {
                const float M = L.sc[576 + 1];
                const float* gr = p.gates + (brow + tl0 + lane) * 16;
                const float li = gr[dir * 4 + h] + p.gate_b[dir * 4 + h];
                const float lf = log_sigmoid(gr[8 + dir * 4 + h] + p.gate_b[8 + dir * 4 + h]);
                float bc = lf;
                if (dir == 0) {
#pragma unroll
                    for (int o = 1; o < 64; o <<= 1) { const float t = __shfl_up(bc, o); if (lane >= o) bc += t; }
                } else {
#pragma unroll
                    for (int o = 1; o < 64; o <<= 1) { const float t = __shfl_down(bc, o); if (lane + o < 64) bc += t; }
                }
                const float cb = li - bc;
                float pm = cb;
                if (dir == 0) {
#pragma unroll
                    for (int o = 1; o < 64; o <<= 1) { const float t = __shfl_up(pm, o); if (lane >= o) pm = fmaxf(pm, t); }
                } else {
#pragma unroll
                    for (int o = 1; o < 64; o <<= 1) { const float t = __shfl_down(pm, o); if (lane + o < 64) pm = fmaxf(pm, t); }
                }
                const float mt = fmaxf(bc + pm, bc + M);
                const float blast = __shfl(bc, dir ? 0 : 63);
                const float a = blast - bc + li;
                float amax = a;
#pragma unroll
                for (int o = 32; o > 0; o >>= 1) amax = fmaxf(amax, __shfl_xor(amax, o));
                const float Mn = fmaxf(blast + M, amax);
                L.sc[lane] = bc - mt; L.sc[64 + lane] = cb; L.sc[128 + lane] = __expf(bc + M - mt); L.sc[192 + lane] = __expf(a - Mn); L.sc[448 + lane] = mt;
                if (lane == 0) { L.sc[576 + 0] = __expf(blast + M - Mn); L.sc[576 + 4] = Mn; }
            }
            __syncthreads();
            for (int e = tid; e < 64 * 64; e += 512) { const int pp = e >> 6, dk = e & 63; L.Qg[pp * 72 + dk] = f2bf(L.sc[128 + pp] * bf2f(L.Qc[pp * 72 + dk])); }
            for (int e = tid; e < 64 * 64; e += 512) { const int pp = e & 63, dk = e >> 6; L.KhT[dk * 72 + pp] = f2bf(L.sc[192 + pp] * bf2f(L.Kc[pp * 72 + dk])); }
#pragma unroll
            for (int n = 0; n < 2; ++n) { f32x4 a = (f32x4){0.f, 0.f, 0.f, 0.f}; const int nb16 = nh * 2 + n;
                mma_nt<64>(a, L.Qc, 72, mb2 * 16, L.Kc, 72, nb16 * 16, lane);
#pragma unroll
                for (int i = 0; i < 4; ++i) { const int pt = mb2 * 16 + 4 * q4 + i, ps = nb16 * 16 + c16;
                    const bool keep = dir ? (ps >= pt) : (ps <= pt);
                    const float wv = keep ? a[i] * __expf(L.sc[pt] + L.sc[64 + ps]) : 0.f;
                    L.Pw[pt * 72 + ps] = f2bf(wv); } }
            __syncthreads();
            f32x4 T[4], Tn = (f32x4){0.f, 0.f, 0.f, 0.f};
#pragma unroll
            for (int m = 0; m < 4; ++m) { T[m] = (f32x4){0.f, 0.f, 0.f, 0.f};
                mma_nt<64>(T[m], L.Pw, 72, m * 16, L.Vt, 72, w * 16, lane);
                mma_nt<64>(T[m], L.Qg, 72, m * 16, L.St, 72, w * 16, lane);
                __builtin_amdgcn_sched_barrier(0); }
            if (w < 4) { mma_nt<64>(Tn, L.Pw, 72, w * 16, L.Vt, 72, 128, lane); mma_nt<64>(Tn, L.Qg, 72, w * 16, L.St, 72, 128, lane);
                if (c16 == 0) {
#pragma unroll
                    for (int i = 0; i < 4; ++i) L.sc[512 + w * 16 + 4 * q4 + i] = Tn[i]; } }
            __syncthreads();
#pragma unroll
            for (int m = 0; m < 4; ++m)
#pragma unroll
                for (int i = 0; i < 4; ++i) { const int pp = m * 16 + 4 * q4 + i; const float inv = 1.0f / fmaxf(fabsf(L.sc[512 + pp]), __expf(-L.sc[448 + pp])); T[m][i] *= inv; }
            if (cc == 0) {
#pragma unroll
                for (int m = 0; m < 4; ++m) H[0][m] += T[m];
            } else if (cc == 1) {
#pragma unroll
                for (int m = 0; m < 4; ++m) H[1][m] += T[m];
            } else if (cc == 2) {
#pragma unroll
                for (int m = 0; m < 4; ++m) H[2][m] += T[m];
            } else {
#pragma unroll
                for (int m = 0; m < 4; ++m) H[3][m] += T[m];
            }
            const float dcy = L.sc[576 + 0];
#pragma unroll
            for (int j = 0; j < 4; ++j) { S[j] = S[j] * dcy; mma_nt<64>(S[j], L.KhT, 72, j * 16, L.Vt, 72, w * 16, lane);
                *(LAS u32x2*)(L.St + (w * 16 + c16) * 72 + j * 16 + 4 * q4) = (u32x2){pk2(S[j][0], S[j][1]), pk2(S[j][2], S[j][3])}; }
            if (w < 4) { S[4] = S[4] * dcy; mma_nt<64>(S[4], L.KhT, 72, w * 16, L.Vt, 72, 128, lane);
                *(LAS u32x2*)(L.St + (128 + c16) * 72 + w * 16 + 4 * q4) = (u32x2){pk2(S[4][0], S[4][1]), pk2(S[4][2], S[4][3])}; }
            if (tid == 0) L.sc[576 + 1] = L.sc[576 + 4];
            __syncthreads();
        }
    }
    LAS float* st1 = L.sc + 640; LAS float* st2 = st1 + 8 * 256;
    int q4e = q4 * 4; asm volatile("" : "+v"(q4e));
    const unsigned ebase = (unsigned)((brow + tls) * NU + h * 128 + w * 16 + c16);
#pragma unroll
    for (int a = 0; a < 4; ++a)
#pragma unroll
        for (int m = 0; m < 4; ++m)
#pragma unroll
            for (int i = 0; i < 4; ++i) { const int tl = a * 64 + m * 16 + q4e + i;
                unsigned eo = ebase + (unsigned)tl * NU; asm volatile("" : "+v"(eo));
                const float og = bf2f(p.u[eo + UC_O]);
                const float v = H[a][m][i] * sigm(og); H[a][m][i] = v;
                const float s = grp16_sum(v);
                if (c16 == 0) st1[w * 256 + tl] = s;
                if (i == 3) asm volatile("" ::: "memory"); }
    __syncthreads();
#pragma unroll
    for (int a = 0; a < 4; ++a)
#pragma unroll
        for (int m = 0; m < 4; ++m)
#pragma unroll
            for (int i = 0; i < 4; ++i) { const int tl = a * 64 + m * 16 + q4e + i;
                float ss = 0.f;
#pragma unroll
                for (int ww = 0; ww < 8; ++ww) ss += st1[ww * 256 + tl];
                const float dv = H[a][m][i] - ss * (1.0f / 128.f); H[a][m][i] = dv;
                const float s = grp16_sum(dv * dv);
                if (c16 == 0) st2[w * 256 + tl] = s; }
    __syncthreads();
    const float gn = p.mlstm_g[h * 128 + w * 16 + c16];
#pragma unroll
    for (int a = 0; a < 4; ++a)
#pragma unroll
        for (int m = 0; m < 4; ++m)
#pragma unroll
            for (int i = 0; i < 4; ++i) { const int tl = a * 64 + m * 16 + q4e + i;
                float ss = 0.f;
#pragma unroll
                for (int ww = 0; ww < 8; ++ww) ss += st2[ww * 256 + tl];
                const float rs = 1.0f / sqrtf(ss * (1.0f / 128.f) + EPS);
                unsigned eo = ebase + (unsigned)tl * NU; asm volatile("" : "+v"(eo));
                const float z = bf2f(p.u[eo + UC_Z]);
                p.u[eo + UC_V] = f2bf(H[a][m][i] * rs * gn * silu(z));
                if (i == 3) asm volatile("" ::: "memory"); }
    __syncthreads();
}
}
#include <hip/hip_cooperative_groups.h>
namespace cg = cooperative_groups;
namespace fr {
using namespace mk;
constexpr int M = 16384, DM = 1024, DIN = 6928, NB = 4;
constexpr size_t MiB = 1u << 20;
constexpr int LDS_BYTES = 147456;
#ifndef MK_MULTI
#define MK_MULTI 0
#endif
constexpr int NPHASE = 12;
constexpr size_t WS_CTL = 0, CTL_ZERO_BYTES = 256 * 1024;
constexpr size_t WS_SS = 64 * 1024;
constexpr size_t WS_LB = 256 * 1024;
constexpr size_t WS_DA = WS_LB + 4096;
constexpr size_t WS_CS = WS_DA + 2 * 16 * 16 * 128 * 4;
constexpr size_t WS_U = 1 * MiB;
constexpr size_t WS_R2 = 217 * MiB;
constexpr size_t WS_WTIN = WS_R2;
constexpr size_t WS_SA = WS_R2;
constexpr size_t WS_SC = WS_R2 + 16 * MiB;
constexpr size_t WS_WTOUT = WS_R2 + 25 * MiB;
constexpr size_t WS_KV = WS_R2 + 33 * MiB;
constexpr size_t WS_GATES = WS_R2 + 37 * MiB;
constexpr size_t WS_CSN = WS_R2 + 38 * MiB;
static_assert(WS_CSN + 1 * MiB == 256 * MiB, "ws map");
static_assert(WS_U + (size_t)M * NU * 2 == WS_R2, "u fills [1, 217) MiB");
constexpr size_t DO_XB = 0;
constexpr size_t DO_LO = 32 * MiB;
constexpr size_t DO_WTKV = 32 * MiB;
constexpr size_t DO_MEMN = 36 * MiB;

struct KP {
    const float* x; const float* mem; const int* pos; const float* norm_g; const float* w_in; const float* lb_logits; const float* hgrn_g; const float* sink;
    const float* conv_w; const float* gate_b; const float* mlstm_g; const float* mem_g; const float* w_kv; const float* w_out; const float* final_g;
    float* out; unsigned char* ws; int ph_lo, ph_hi;
};

__device__ const double INVF[8] = {1.0, 0.19392274474868576, 0.03760603093086393, 0.007292664737217109, 0.001414213562373095, 0.0002742481756762073, 5.318295896944988e-05, 1.031338537721246e-05};
__device__ __forceinline__ float wave_sum(float v) {
#pragma unroll
    for (int o = 1; o < 64; o <<= 1) v += __shfl_xor(v, o);
    return v;
}
__device__ __forceinline__ int new_col_to_old(int c) {
    if (c < 512) return 0 + c;
    if (c < 1024) return 2560 + (c - 512);
    if (c < 1536) return 4352 + (c - 1024);
    if (c < 2048) return 5904 + (c - 1536);
    if (c < 2560) return 512 + (c - 2048);
    if (c < 3072) return 1024 + (c - 2560);
    if (c < 3584) return 1536 + (c - 3072);
    if (c < 4096) return 2048 + (c - 3584);
    if (c < 4224) return 3072 + (c - 4096);
    if (c < 4352) return 3200 + (c - 4224);
    if (c < 4864) return 3328 + (c - 4352);
    if (c < 5120) return 3840 + (c - 4864);
    if (c < 5376) return 4096 + (c - 5120);
    if (c < 5888) return 4864 + (c - 5376);
    if (c < 6400) return 5376 + (c - 5888);
    return 6416 + (c - 6400);
}
__device__ __forceinline__ void transpose_item(const float* W, int K, int N, bf16_t* WT, int k0, int src_col0, int dst_row0, const float* kscale, LAS float* scr, int lane) {
#pragma unroll 8
    for (int i = 0; i < 32; ++i) { const int kk = 2 * i + (lane >> 5); float v = W[(size_t)(k0 + kk) * N + src_col0 + (lane & 31)]; if (kscale) v *= kscale[k0 + kk]; scr[kk * 33 + (lane & 31)] = v; }
    asm volatile("s_waitcnt lgkmcnt(0)" ::: "memory");
    const int c = lane & 7;
#pragma unroll
    for (int j = 0; j < 4; ++j) { const int n = (lane >> 3) + 8 * j; const LAS float* s = scr + (8 * c) * 33 + n;
        u32x4 o; o.x = pk2(s[0 * 33], s[1 * 33]); o.y = pk2(s[2 * 33], s[3 * 33]); o.z = pk2(s[4 * 33], s[5 * 33]); o.w = pk2(s[6 * 33], s[7 * 33]);
        *(u32x4*)(WT + (size_t)(dst_row0 + n) * K + k0 + 8 * c) = o; }
    asm volatile("s_waitcnt lgkmcnt(0)" ::: "memory");
}
__device__ __forceinline__ void convert_wtin(const KP& a, int l, LAS unsigned char* lds, int gw, int ngw, int wave, int lane) {
    LAS float* scr = (LAS float*)(lds + wave * 8448);
    bf16_t* WT = (bf16_t*)(a.ws + WS_WTIN);
    for (int it = gw; it < 16 * 216; it += ngw) { const int kb = it / 216, nbk = it % 216;
        transpose_item(a.w_in + (size_t)l * DM * DIN, DM, DIN, WT, kb * 64, new_col_to_old(nbk * 32), nbk * 32, a.norm_g + l * DM, scr, lane); }
}
__device__ __forceinline__ void gates_block(const KP& a, int l, LAS unsigned char* lds, const bf16_t* xb, const float* ss, int blk) {
    const int tid = otid(), lane = tid & 63, w = __builtin_amdgcn_readfirstlane(tid >> 6);
    float* gates = (float*)(a.ws + WS_GATES);
    LAS bf16_t* A2 = (LAS bf16_t*)lds; LAS bf16_t* B2 = A2 + 64 * 520;
    f32x4 acc = (f32x4){0.f, 0.f, 0.f, 0.f};
    for (int kh = 0; kh < 2; ++kh) {
        for (int c = tid; c < 64 * 64; c += 512) { const int r = c >> 6, ch = c & 63;
            *(LAS u32x4*)(A2 + r * 520 + ch * 8) = *(const u32x4*)(xb + (size_t)(blk * 64 + r) * DM + kh * 512 + ch * 8); }
        for (int c = tid; c < 16 * 512; c += 512) { const int j = c & 15, k = c >> 4; const int kg = kh * 512 + k;
            B2[j * 520 + k] = f2bf(a.w_in[((size_t)l * DM + kg) * DIN + 5888 + j] * a.norm_g[l * DM + kg]); }
        __syncthreads();
        if (w < 4) mma_nt<512>(acc, A2, 520, w * 16, B2, 520, 0, lane);
        __syncthreads();
    }
    if (w < 4) {
#pragma unroll
        for (int i = 0; i < 4; ++i) { const int r = blk * 64 + w * 16 + 4 * (lane >> 4) + i; const float rs = 1.0f / sqrtf(ss[r] * (1.0f / 1024.f) + 1e-6f);
            gates[(size_t)r * 16 + (lane & 15)] = acc[i] * rs; }
    }
}

__device__ __forceinline__ void prologue(const KP& a, LAS unsigned char* lds) {
    const int tid = otid(), lane = tid & 63, wave = __builtin_amdgcn_readfirstlane(tid >> 6);
    const int G = gridDim.x, gw = blockIdx.x * 8 + wave, ngw = G * 8;
    LAS float* scr = (LAS float*)(lds + wave * 8448);
    float* ss0 = (float*)(a.ws + WS_SS);
    bf16_t* xb = (bf16_t*)((unsigned char*)a.out + DO_XB);
    for (int blk = blockIdx.x; blk < M / 64; blk += G) {
        for (int rr = wave; rr < 64; rr += 8) { const int r = blk * 64 + rr;
            const f32x4* xr = (const f32x4*)(a.x + (size_t)r * DM) + lane;
            f32x4 v[4]; float s = 0.f;
#pragma unroll
            for (int j = 0; j < 4; ++j) { v[j] = xr[64 * j]; s += (v[j][0] * v[j][0] + v[j][1] * v[j][1]) + (v[j][2] * v[j][2] + v[j][3] * v[j][3]); }
            s = wave_sum(s);
            if (lane == 0) ss0[r] = s;
            u32x2* o8 = (u32x2*)(xb + (size_t)r * DM) + lane;
#pragma unroll
            for (int j = 0; j < 4; ++j) o8[64 * j] = (u32x2){pk2(v[j][0], v[j][1]), pk2(v[j][2], v[j][3])};
        }
    }
    convert_wtin(a, 0, lds, gw, ngw, wave, lane);
    for (int it = gw; it < 2 * 32 * 32; it += ngw) { const int l = it >> 10, r = it & 1023, kb = r >> 5, nbk = r & 31;
        transpose_item(a.w_out + (size_t)l * 2048 * DM, 2048, DM, (bf16_t*)(a.ws + WS_WTOUT) + (size_t)l * DM * 2048, kb * 64, nbk * 32, nbk * 32, nullptr, scr, lane); }
    for (int it = gw; it < 2 * 16 * 32; it += ngw) { const int l = it >> 9, r = it & 511, kb = r >> 5, nbk = r & 31;
        transpose_item(a.w_kv + (size_t)l * DM * 1024, DM, 1024, (bf16_t*)((unsigned char*)a.out + DO_WTKV) + (size_t)l * 1024 * DM, kb * 64, nbk * 32, nbk * 32, nullptr, scr, lane); }
    for (int it = gw; it < 2 * 1024; it += ngw) { const int l = it >> 10, r = it & 1023;
        const f32x4* xr = (const f32x4*)(a.mem + (size_t)r * DM) + lane; const f32x4* gr = (const f32x4*)(a.mem_g + l * DM) + lane;
        f32x4 v[4]; float s = 0.f;
#pragma unroll
        for (int j = 0; j < 4; ++j) { v[j] = xr[64 * j]; s += (v[j][0] * v[j][0] + v[j][1] * v[j][1]) + (v[j][2] * v[j][2] + v[j][3] * v[j][3]); }
        const float rs = 1.0f / sqrtf(wave_sum(s) * (1.0f / 1024.f) + 1e-6f);
        u32x2* o8 = (u32x2*)((bf16_t*)((unsigned char*)a.out + DO_MEMN) + ((size_t)l * 1024 + r) * DM) + lane;
#pragma unroll
        for (int j = 0; j < 4; ++j) { const f32x4 g = gr[64 * j]; o8[64 * j] = (u32x2){pk2(v[j][0] * rs * g[0], v[j][1] * rs * g[1]), pk2(v[j][2] * rs * g[2], v[j][3] * rs * g[3])}; }
    }
    {
        float* cs = (float*)(a.ws + WS_CSN); float* sn = cs + (size_t)M * 8;
        for (int i = blockIdx.x * 512 + tid; i < M * 8; i += G * 512) { const int t = i >> 3, j = i & 7;
            const double inv = INVF[j];
            const double ang = (double)a.pos[t] * inv;
            const double kq = rint(ang * 0.15915494309189535);
            const float r = (float)fma(-kq, 1.2246467991473532e-16 * 2.0, fma(-kq, 6.283185307179586, ang));
            cs[i] = cosf(r); sn[i] = sinf(r); }
        if (blockIdx.x == 0) { float* lb = (float*)(a.ws + WS_LB);
            const float l0 = a.lb_logits[tid], l1 = a.lb_logits[512 + tid]; const float m = fmaxf(l0, l1); const float e0 = __expf(l0 - m), e1 = __expf(l1 - m);
            lb[tid] = 0.f; lb[512 + tid] = e1 / (e0 + e1); }
    }
    __syncthreads();
}

__device__ __forceinline__ MP make_mp(const KP& a, int l) {
    MP p;
    p.u = (bf16_t*)(a.ws + WS_U); p.gates = (const float*)(a.ws + WS_GATES); p.kv = (const bf16_t*)(a.ws + WS_KV) + (size_t)l * 1024 * 1024;
    p.cs = (const float*)(a.ws + WS_CSN); p.sn = p.cs + (size_t)M * 8; p.lb = (const float*)(a.ws + WS_LB) + l * 512;
    p.hgrn_g = a.hgrn_g + l * 512; p.sink = a.sink + l * 8; p.conv_w = a.conv_w + (size_t)l * 5 * 512; p.gate_b = a.gate_b + l * 16; p.mlstm_g = a.mlstm_g + l * 512;
    p.SA = (bf16_t*)(a.ws + WS_SA); p.DA = (float*)(a.ws + WS_DA); p.SC = (bf16_t*)(a.ws + WS_SC); p.CS = (float*)(a.ws + WS_CS); p.nb = NB;
    return p;
}

__device__ __forceinline__ void phase_g1(const KP& a, int l, LAS unsigned char* lds) {
    const int G = gridDim.x;
    const bf16_t* xb = (const bf16_t*)((unsigned char*)a.out + DO_XB);
    const float* ss = (const float*)(a.ws + WS_SS) + (size_t)l * M;
    for (int blk = blockIdx.x; blk < M / 64; blk += G) gates_block(a, l, lds, xb, ss, blk);
    __syncthreads();
    {
        pg8::Gemm g{xb, (const bf16_t*)(a.ws + WS_WTIN), M, NU, DM, DM};
        pg8::StaticOrder S; S.init(M, NU, G, (int)blockIdx.x);
        pg8::EpiIn E{(bf16_t*)(a.ws + WS_U), NU, ss};
        pg8::gemm_phase<pg8::EpiIn, pg8::StaticOrder, true, true>((PG8_LAS unsigned char*)lds, g, S, E);
    }
    if (l == 0) {
        __syncthreads();
        pg8::Gemm g{(const bf16_t*)((unsigned char*)a.out + DO_MEMN), (const bf16_t*)((unsigned char*)a.out + DO_WTKV), 2048, 2048, DM, DM};
        pg8::KvOrder S{(int)blockIdx.x, G - 64 > 0 ? G - 64 : 0};
        pg8::EpiKv E{(bf16_t*)(a.ws + WS_KV)};
        pg8::gemm_phase<pg8::EpiKv, pg8::KvOrder, false, true>((PG8_LAS unsigned char*)lds, g, S, E);
    }
}
__device__ __forceinline__ void phase_g2(const KP& a, int l, LAS unsigned char* lds) {
    const int tid = otid(), lane = tid & 63, wave = __builtin_amdgcn_readfirstlane(tid >> 6);
    const int G = gridDim.x;
    if (l == 0) { convert_wtin(a, 1, lds, blockIdx.x * 8 + wave, G * 8, wave, lane); __syncthreads(); }
    pg8::Gemm g{(const bf16_t*)(a.ws + WS_U), (const bf16_t*)(a.ws + WS_WTOUT) + (size_t)l * DM * 2048, M, DM, 2048, NU};
    pg8::StaticOrder S; S.init(M, DM, G, (int)blockIdx.x);
    bf16_t* hi = (bf16_t*)((unsigned char*)a.out + DO_XB); bf16_t* lo = (bf16_t*)((unsigned char*)a.out + DO_LO);
    float* ssn = (float*)(a.ws + WS_SS) + (size_t)(l + 1) * M;
    if (l == 0) { pg8::EpiOut<0> E{a.x, hi, lo, nullptr, 0, 0, ssn}; pg8::gemm_phase<pg8::EpiOut<0>, pg8::StaticOrder, false, true>((PG8_LAS unsigned char*)lds, g, S, E); }
    else { pg8::EpiOut<1> E{nullptr, hi, lo, (float*)(a.ws + WS_U), NU / 2, 1024, ssn}; pg8::gemm_phase<pg8::EpiOut<1>, pg8::StaticOrder, false, true>((PG8_LAS unsigned char*)lds, g, S, E); }
}
__device__ __forceinline__ void phase_m1(const MP& p, LAS unsigned char* lds) {
    const int nb = p.nb, G = gridDim.x;
    const int nB = nb * 128, nA = nb * 128, nC = nb * 128, nD = nb * 256;
    for (int it = blockIdx.x; it < nB + nA + nC + nD; it += G) {
        if (it < nB) b_item(p, lds, it);
        else if (it < nB + nA) a_pass1(p, lds, it - nB);
        else if (it < nB + nA + nC) c_pass1(p, lds, it - nB - nA);
        else d_item(p, lds, it - nB - nA - nC);
    }
}
__device__ __forceinline__ void phase_m2(const MP& p) {
    const int nb = p.nb, G = gridDim.x;
    const int nAu = nb * 8 * 4096, nCu = nb * 8 * 2304;
    for (int uu = blockIdx.x * 512 + otid(); uu < nAu + nCu; uu += G * 512) { if (uu < nAu) a_scan_unit(p, uu); else c_scan_unit(p, uu - nAu); }
}
__device__ __forceinline__ void phase_m3(const MP& p, LAS unsigned char* lds) {
    const int nb = p.nb, G = gridDim.x;
    for (int it = blockIdx.x; it < nb * 128; it += G) { if (it < nb * 64) a_pass3(p, lds, it); else c_pass3(p, lds, it - nb * 64); }
}
__device__ __forceinline__ void phase_final(const KP& a) {
    const int tid = otid(), lane = tid & 63, wave = __builtin_amdgcn_readfirstlane(tid >> 6);
    const int gw = blockIdx.x * 8 + wave, ngw = gridDim.x * 8;
    const float* ss2 = (const float*)(a.ws + WS_SS) + (size_t)2 * M;
    const float* x2 = (const float*)(a.ws + WS_U);
    for (int r = gw; r < M; r += ngw) {
        const float rs = 1.0f / sqrtf(ss2[r] * (1.0f / 1024.f) + 1e-6f);
        const f32x4* xr = (const f32x4*)(x2 + (size_t)r * (NU / 2) + 1024) + lane; const f32x4* gr = (const f32x4*)a.final_g + lane;
        f32x4* orow = (f32x4*)(a.out + (size_t)r * DM) + lane;
#pragma unroll
        for (int j = 0; j < 4; ++j) { const f32x4 v = xr[64 * j], g = gr[64 * j]; orow[64 * j] = v * rs * g; }
    }
}

__global__ void __launch_bounds__(512, 2) mega_fwd(KP a) {
    extern __shared__ __attribute__((aligned(16))) unsigned char lds_raw[];
    LAS unsigned char* lds = (LAS unsigned char*)lds_raw;
#if !MK_MULTI
    cg::grid_group grid = cg::this_grid();
#define GRID_SYNC() grid.sync()
#else
#define GRID_SYNC() do {} while (0)
#endif
    for (int ph = a.ph_lo; ph < a.ph_hi; ++ph) {
        if (ph == 0) prologue(a, lds);
        else if (ph == 11) phase_final(a);
        else {
            const int l = (ph - 1) / 5, s = (ph - 1) % 5;
            if (s == 0) phase_g1(a, l, lds);
            else if (s == 4) phase_g2(a, l, lds);
            else { const MP p = make_mp(a, l); if (s == 1) phase_m1(p, lds); else if (s == 2) phase_m2(p); else phase_m3(p, lds); }
        }
        if (ph + 1 < a.ph_hi) GRID_SYNC();
    }
}
}

extern "C" void kernel_launch(void* const* d_in, const int* in_sizes, int n_in,
                              void* d_out, int out_size, void* d_ws, size_t ws_size,
                              hipStream_t stream) {
    using namespace fr;
    static int grid_blocks = 0;
    if (!grid_blocks) {
        int dev = 0, cus = 0, per_cu = 0;
        (void)hipGetDevice(&dev);
        (void)hipDeviceGetAttribute(&cus, hipDeviceAttributeMultiprocessorCount, dev);
        (void)hipFuncSetAttribute((const void*)mega_fwd, hipFuncAttributeMaxDynamicSharedMemorySize, LDS_BYTES);
        (void)hipOccupancyMaxActiveBlocksPerMultiprocessor(&per_cu, (const void*)mega_fwd, 512, LDS_BYTES);
        if (per_cu < 1) per_cu = 1;
        grid_blocks = cus * (per_cu > 1 ? 1 : per_cu);
    }
    KP a{};
    a.x = (const float*)d_in[0]; a.mem = (const float*)d_in[1]; a.pos = (const int*)d_in[2]; a.norm_g = (const float*)d_in[3]; a.w_in = (const float*)d_in[4];
    a.lb_logits = (const float*)d_in[5]; a.hgrn_g = (const float*)d_in[6]; a.sink = (const float*)d_in[7]; a.conv_w = (const float*)d_in[8]; a.gate_b = (const float*)d_in[9];
    a.mlstm_g = (const float*)d_in[10]; a.mem_g = (const float*)d_in[11]; a.w_kv = (const float*)d_in[12]; a.w_out = (const float*)d_in[13]; a.final_g = (const float*)d_in[14];
    a.out = (float*)d_out; a.ws = (unsigned char*)d_ws;
    (void)hipMemsetAsync((char*)d_ws + WS_CTL, 0, CTL_ZERO_BYTES, stream);
#if MK_MULTI
    for (int ph = 0; ph < NPHASE; ++ph) { a.ph_lo = ph; a.ph_hi = ph + 1; hipLaunchKernelGGL(mega_fwd, dim3(grid_blocks), dim3(512), LDS_BYTES, stream, a); }
#else
    a.ph_lo = 0; a.ph_hi = NPHASE;
    void* args[] = {&a};
    (void)hipLaunchCooperativeKernel((const void*)mega_fwd, dim3(grid_blocks), dim3(512), args, LDS_BYTES, stream);
#endif
}
```

```cpp
#include <hip/hip_runtime.h>
#include <math.h>
#define MK_MULTI 0
namespace pg8 {
#define PG8_LAS __attribute__((address_space(3)))
typedef unsigned short bf16_t;
typedef short bf16x8 __attribute__((ext_vector_type(8)));
typedef float f32x4 __attribute__((ext_vector_type(4)));
typedef unsigned u32x4 __attribute__((ext_vector_type(4)));
constexpr int BM = 256, BK = 64, HALF = 128, HTB = HALF * BK * 2  , STAGE_BYTES = 8 * HTB, NXCD = 8, WGM = 8;

__host__ __device__ __forceinline__ int lds_byte(int r, int c) { const int st = (r >> 4) * 2 + (c >> 5), rr = r & 15, cc = c & 31, ob = rr * 64 + cc * 2; return st * 1024 + (ob ^ (((ob >> 9) & 1) << 5)); }
__host__ __device__ __forceinline__ void stage_rc(int b, int& R, int& C) { const int st = b / 1024, sb = b % 1024, swz = sb ^ (((sb >> 9) & 1) << 5); R = (st >> 1) * 16 + swz / 64; C = (st & 1) * 32 + (swz % 64) / 2; }
__host__ __device__ __forceinline__ int perm32(int rho) { const int n = rho >> 4, i = rho & 15; return 8 * (i >> 2) + 4 * n + (i & 3); }

struct Unit { int pm, pn; };
struct Gemm { const bf16_t* A; const bf16_t* Bt; int M, N, K, lda; };

struct StaticOrder {
    int nM, nN, nwg, G, c;
    __host__ __device__ void init(int M, int N, int G_, int c_) { nM = M / BM; nN = N / BM; nwg = nM * nN; G = G_; c = c_; }
    __host__ __device__ bool next(int i, Unit& u) const {
        const long L = (long)i * G + c; if (L >= nwg) return false;
        int wgid = (int)L; { const int q = nwg / NXCD, r = nwg % NXCD, xcd = wgid % NXCD, off = wgid / NXCD; wgid = (xcd < r ? xcd * (q + 1) : r * (q + 1) + (xcd - r) * q) + off; }
        const int nig = WGM * nN, gid = wgid / nig, fm = gid * WGM, gsz = (nM - fm) < WGM ? (nM - fm) : WGM;
        u.pm = fm + ((wgid % nig) % gsz); u.pn = (wgid % nig) / gsz; return true;
    }
    __device__ __forceinline__ void a_ready(const Unit&) const {}
    __device__ __forceinline__ void done(const Unit&) const {}
};

__device__ __forceinline__ unsigned cvt_pk_bf16(float lo, float hi) { unsigned r; asm volatile("v_cvt_pk_bf16_f32 %0, %1, %2" : "=v"(r) : "v"(lo), "v"(hi)); return r; }

__device__ __forceinline__ float bf2f_(unsigned h16) { return __uint_as_float(h16 << 16); }
struct EpiIn {
    static constexpr bool PERM = true, AFTER_DRAIN = false;
    bf16_t* O; int ldc; const float* ss;
    __device__ __forceinline__ void operator()(const f32x4 (&acc)[2][2][4][2], const Unit& u, int wr, int wc, int fr, int fq) const {
        const int row0 = u.pm * BM + wr * 64 + fr; const int col0 = u.pn * BM + wc * 32 + 8 * fq;
#pragma unroll
        for (int ai = 0; ai < 2; ++ai)
#pragma unroll
            for (int m = 0; m < 4; ++m) { const int r = row0 + ai * HALF + m * 16; const float rs = 1.0f / sqrtf(ss[r] * (1.0f / 1024.f) + 1e-6f);
                bf16_t* rowp = O + (size_t)r * ldc + col0;
#pragma unroll
                for (int bj = 0; bj < 2; ++bj) { const f32x4 v0 = acc[ai][bj][m][0] * rs, v1 = acc[ai][bj][m][1] * rs;
                    u32x4 w; w.x = cvt_pk_bf16(v0[0], v0[1]); w.y = cvt_pk_bf16(v0[2], v0[3]); w.z = cvt_pk_bf16(v1[0], v1[1]); w.w = cvt_pk_bf16(v1[2], v1[3]);
                    *(u32x4*)(rowp + bj * HALF) = w; } }
    }
};
struct EpiKv {
    static constexpr bool PERM = true, AFTER_DRAIN = false;
    bf16_t* O;
    __device__ __forceinline__ void operator()(const f32x4 (&acc)[2][2][4][2], const Unit& u, int wr, int wc, int fr, int fq) const {
        const int row0 = u.pm * BM + wr * 64 + fr; const int col0 = (u.pn & 3) * BM + wc * 32 + 8 * fq;
#pragma unroll
        for (int ai = 0; ai < 2; ++ai)
#pragma unroll
            for (int m = 0; m < 4; ++m) { const int r = row0 + ai * HALF + m * 16; bf16_t* rowp = O + (size_t)r * 1024 + col0;
#pragma unroll
                for (int bj = 0; bj < 2; ++bj) { const f32x4 v0 = acc[ai][bj][m][0], v1 = acc[ai][bj][m][1];
                    u32x4 w; w.x = cvt_pk_bf16(v0[0], v0[1]); w.y = cvt_pk_bf16(v0[2], v0[3]); w.z = cvt_pk_bf16(v1[0], v1[1]); w.w = cvt_pk_bf16(v1[2], v1[3]);
                    *(u32x4*)(rowp + bj * HALF) = w; } }
    }
};
typedef unsigned u32x2e __attribute__((ext_vector_type(2)));
template <int LAYER> struct EpiOut {
    static constexpr bool PERM = false, AFTER_DRAIN = false;
    const float* x0; bf16_t* hi; bf16_t* lo; float* x2; int xs, xo; float* ssn;
    __device__ __forceinline__ void operator()(const f32x4 (&acc)[2][2][4][2], const Unit& u, int wr, int wc, int fr, int fq) const {
        const int row0 = u.pm * BM + wr * 64 + fr; const int col0 = u.pn * BM + wc * 32 + 4 * fq;
#pragma unroll
        for (int ai = 0; ai < 2; ++ai)
#pragma unroll
            for (int m = 0; m < 4; ++m) { const int r = row0 + ai * HALF + m * 16; float part = 0.f;
#pragma unroll
                for (int bj = 0; bj < 2; ++bj)
#pragma unroll
                    for (int n = 0; n < 2; ++n) { const int c = col0 + bj * HALF + n * 16; const size_t e = (size_t)r * 1024 + c;
                        f32x4 xv;
                        if (LAYER == 0) xv = *(const f32x4*)(x0 + e);
                        else { const u32x2e h = *(const u32x2e*)(hi + e), l = *(const u32x2e*)(lo + e);
                            xv = (f32x4){bf2f_(h.x & 0xffffu) + bf2f_(l.x & 0xffffu), bf2f_(h.x >> 16) + bf2f_(l.x >> 16), bf2f_(h.y & 0xffffu) + bf2f_(l.y & 0xffffu), bf2f_(h.y >> 16) + bf2f_(l.y >> 16)}; }
                        const f32x4 v = xv + acc[ai][bj][m][n];
                        part += (v[0] * v[0] + v[1] * v[1]) + (v[2] * v[2] + v[3] * v[3]);
                        if (LAYER == 0) {
                            u32x2e hw; hw.x = cvt_pk_bf16(v[0], v[1]); hw.y = cvt_pk_bf16(v[2], v[3]);
                            const f32x4 d = v - (f32x4){bf2f_(hw.x & 0xffffu), bf2f_(hw.x >> 16), bf2f_(hw.y & 0xffffu), bf2f_(hw.y >> 16)};
                            u32x2e lw; lw.x = cvt_pk_bf16(d[0], d[1]); lw.y = cvt_pk_bf16(d[2], d[3]);
                            *(u32x2e*)(hi + e) = hw; *(u32x2e*)(lo + e) = lw;
                        } else { *(f32x4*)(x2 + (size_t)r * xs + xo + c) = v; } }
                part += __shfl_xor(part, 16); part += __shfl_xor(part, 32);
                if (fq == 0) atomicAdd(ssn + r, part); }
    }
};
struct KvOrder {
    int c, c0;
    __device__ bool next(int i, Unit& u) const { const int t = c - c0; if (i != 0 || t < 0 || t >= 32) return false; const int l = t >> 4; u.pm = l * 4 + ((t >> 2) & 3); u.pn = l * 4 + (t & 3); return true; }
    __device__ __forceinline__ void a_ready(const Unit&) const {}
    __device__ __forceinline__ void done(const Unit&) const {}
};

template <class Epi, class Sched, bool ALIGN_EPI = false, bool SP2 = false>
__device__ __forceinline__ void gemm_phase(PG8_LAS unsigned char* lds, const Gemm g, const Sched& S, const Epi& E) {
    int tid = threadIdx.x; asm volatile("" : "+v"(tid)); const int wid = __builtin_amdgcn_readfirstlane(tid >> 6), lane = tid & 63, wr = wid >> 2, wc = wid & 3, fr = lane & 15, fq = lane >> 4;
    const int K = g.K, nt = K / BK;
    unsigned voffA[2], voffB[2];
#pragma unroll
    for (int i = 0; i < 2; ++i) { int R, C; stage_rc(tid * 16 + i * 8192, R, C); const int Rb = Epi::PERM ? ((R & ~31) + perm32(R & 31)) : R;
        voffA[i] = (unsigned)(R * g.lda + C) * 2u; voffB[i] = (unsigned)(Rb * K + C) * 2u; }
    const size_t kstep = (size_t)(BK * 2);
    const size_t hstep = (size_t)HALF * K * 2, hstepA = (size_t)HALF * g.lda * 2;
    const size_t tstep = 2 * hstep, tstepA = 2 * hstepA;
    const unsigned ldsw = (unsigned)wid * 1024u;
    const int aoff = lds_byte(wr * 64 + fr, fq * 8), boff = lds_byte(wc * 32 + fr, fq * 8);
#define PG8_SA(b, h) (((b) * 2 + (h)) * HTB)
#define PG8_SB(b, h) ((4 + (b) * 2 + (h)) * HTB)
#define PG8_STAGE(bufoff, gbase, voff) do { _Pragma("unroll") for (int _i = 0; _i < 2; ++_i) \
        __builtin_amdgcn_global_load_lds((const unsigned*)((const char*)(gbase) + (voff)[_i]), (PG8_LAS unsigned*)(lds + (bufoff) + ldsw + _i * 8192), 16, 0, 0); } while (0)
#define PG8_LDA(dst, b, h) do { _Pragma("unroll") for (int m = 0; m < 4; ++m) _Pragma("unroll") for (int k = 0; k < 2; ++k) dst[m][k] = *(const PG8_LAS bf16x8*)(lds + PG8_SA(b, h) + aoff + m * 2048 + k * 1024); } while (0)
#define PG8_LDB(dst, b, h) do { _Pragma("unroll") for (int n = 0; n < 2; ++n) _Pragma("unroll") for (int k = 0; k < 2; ++k) dst[n][k] = *(const PG8_LAS bf16x8*)(lds + PG8_SB(b, h) + boff + n * 2048 + k * 1024); } while (0)
#define PG8_MMA(ai, bj, At, Bt) do { __builtin_amdgcn_s_setprio(1); _Pragma("unroll") for (int m = 0; m < 4; ++m) _Pragma("unroll") for (int n = 0; n < 2; ++n) _Pragma("unroll") for (int k = 0; k < 2; ++k) \
        acc[ai][bj][m][n] = __builtin_amdgcn_mfma_f32_16x16x32_bf16(Bt[n][k], At[m][k], acc[ai][bj][m][n], 0, 0, 0); __builtin_amdgcn_s_setprio(0); } while (0)
#define PG8_WAIT_V(n) asm volatile("s_waitcnt vmcnt(" #n ")" ::: "memory")
#define PG8_WAIT_L(n) asm volatile("s_waitcnt lgkmcnt(" #n ")" ::: "memory")
#define PG8_BAR __builtin_amdgcn_s_barrier()
#define PG8_SCHED __builtin_amdgcn_sched_barrier(0)
    Unit cur, nxt; int ui = 0;
    if (!S.next(0, cur)) return;
    f32x4 acc[2][2][4][2];
#pragma unroll
    for (int a = 0; a < 2; ++a)
#pragma unroll
        for (int b = 0; b < 2; ++b)
#pragma unroll
            for (int m = 0; m < 4; ++m)
#pragma unroll
                for (int n = 0; n < 2; ++n) acc[a][b][m][n] = (f32x4){0.f, 0.f, 0.f, 0.f};
    bf16x8 At[4][2], B0[2][2], B1[2][2];
    const char* cA = (const char*)g.A + (size_t)cur.pm * tstepA; const char* cB = (const char*)g.Bt + (size_t)cur.pn * tstep;
    S.a_ready(cur);
    if constexpr (SP2) {
        PG8_STAGE(PG8_SB(0, 0), cB, voffB); PG8_STAGE(PG8_SB(0, 1), cB + hstep, voffB); PG8_STAGE(PG8_SA(0, 0), cA, voffA); PG8_STAGE(PG8_SA(0, 1), cA + hstepA, voffA);
        if (wr == 1) PG8_BAR;
        PG8_WAIT_V(2); PG8_BAR;
        PG8_STAGE(PG8_SB(1, 0), cB + kstep, voffB); PG8_STAGE(PG8_SA(1, 0), cA + kstep, voffA); PG8_STAGE(PG8_SB(1, 1), cB + hstep + kstep, voffB);
        PG8_WAIT_V(6); PG8_BAR;
    } else {
        PG8_STAGE(PG8_SB(0, 0), cB, voffB); PG8_STAGE(PG8_SA(0, 0), cA, voffA); PG8_STAGE(PG8_SB(0, 1), cB + hstep, voffB); PG8_STAGE(PG8_SA(0, 1), cA + hstepA, voffA);
        if (wr == 1) PG8_BAR;
        PG8_WAIT_V(4); PG8_BAR;
        PG8_STAGE(PG8_SB(1, 0), cB + kstep, voffB); PG8_STAGE(PG8_SA(1, 0), cA + kstep, voffA); PG8_STAGE(PG8_SB(1, 1), cB + hstep + kstep, voffB);
        PG8_WAIT_V(6); PG8_BAR;
    }
    for (;;) {
        const bool has_next = S.next(ui + 1, nxt);
        const char* nA = has_next ? (const char*)g.A + (size_t)nxt.pm * tstepA : cA; const char* nB = has_next ? (const char*)g.Bt + (size_t)nxt.pn * tstep : cB;
        for (int t = 0; t < nt; t += 2) {
            const bool last = (t == nt - 2);
            const char* a1 = cA + (size_t)(t + 1) * kstep;
            const char* a2 = last ? nA : cA + (size_t)(t + 2) * kstep; const char* b2 = last ? nB : cB + (size_t)(t + 2) * kstep;
            const char* a3 = a2 + kstep; const char* b3 = b2 + kstep;
            if (last && has_next) S.a_ready(nxt);
            if constexpr (SP2) {
            PG8_LDB(B0, 0, 0); PG8_LDB(B1, 0, 1); PG8_SCHED; PG8_LDA(At, 0, 0); PG8_STAGE(PG8_SA(1, 1), a1 + hstepA, voffA);
            PG8_WAIT_V(8); PG8_WAIT_L(0); PG8_BAR; PG8_MMA(0, 0, At, B0); PG8_MMA(0, 1, At, B1); PG8_BAR; PG8_SCHED;
            PG8_LDA(At, 0, 1); PG8_STAGE(PG8_SB(0, 0), b2, voffB); PG8_STAGE(PG8_SB(0, 1), b2 + hstep, voffB); PG8_STAGE(PG8_SA(0, 0), a2, voffA);
            PG8_WAIT_V(8); PG8_WAIT_L(0); PG8_BAR; PG8_MMA(1, 0, At, B0); PG8_MMA(1, 1, At, B1); PG8_BAR; PG8_SCHED;
            PG8_LDB(B0, 1, 0); PG8_LDB(B1, 1, 1); PG8_SCHED; PG8_LDA(At, 1, 0); PG8_STAGE(PG8_SA(0, 1), a2 + hstepA, voffA);
            PG8_WAIT_V(8); PG8_WAIT_L(0); PG8_BAR; PG8_MMA(0, 0, At, B0); PG8_MMA(0, 1, At, B1); PG8_BAR; PG8_SCHED;
            PG8_LDA(At, 1, 1); PG8_STAGE(PG8_SB(1, 0), b3, voffB); PG8_STAGE(PG8_SB(1, 1), b3 + hstep, voffB); PG8_STAGE(PG8_SA(1, 0), a3, voffA);
            PG8_WAIT_V(8); PG8_WAIT_L(0); PG8_BAR; PG8_MMA(1, 0, At, B0); PG8_MMA(1, 1, At, B1); PG8_BAR; PG8_SCHED;
            } else {
            PG8_LDB(B0, 0, 0); PG8_SCHED; PG8_LDA(At, 0, 0); PG8_STAGE(PG8_SA(1, 1), a1 + hstepA, voffA);
            PG8_WAIT_L(8); PG8_BAR; PG8_WAIT_L(0); PG8_MMA(0, 0, At, B0); PG8_BAR; PG8_SCHED;
            PG8_LDB(B1, 0, 1); PG8_STAGE(PG8_SB(0, 0), b2, voffB);
            PG8_BAR; PG8_WAIT_L(0); PG8_MMA(0, 1, At, B1); PG8_BAR;
            PG8_LDA(At, 0, 1); PG8_STAGE(PG8_SA(0, 0), a2, voffA);
            PG8_BAR; PG8_WAIT_L(0); PG8_MMA(1, 0, At, B0); PG8_BAR; PG8_SCHED;
            PG8_STAGE(PG8_SB(0, 1), b2 + hstep, voffB);
            PG8_WAIT_V(6); PG8_BAR; PG8_MMA(1, 1, At, B1); PG8_BAR;
            PG8_LDB(B0, 1, 0); PG8_SCHED; PG8_LDA(At, 1, 0); PG8_STAGE(PG8_SA(0, 1), a2 + hstepA, voffA);
            PG8_WAIT_L(8); PG8_BAR; PG8_WAIT_L(0); PG8_MMA(0, 0, At, B0); PG8_BAR; PG8_SCHED;
            PG8_LDB(B1, 1, 1); PG8_STAGE(PG8_SB(1, 0), b3, voffB);
            PG8_BAR; PG8_WAIT_L(0); PG8_MMA(0, 1, At, B1); PG8_BAR;
            PG8_LDA(At, 1, 1); PG8_STAGE(PG8_SA(1, 0), a3, voffA);
            PG8_BAR; PG8_WAIT_L(0); PG8_MMA(1, 0, At, B0); PG8_BAR; PG8_SCHED;
            PG8_STAGE(PG8_SB(1, 1), b3 + hstep, voffB);
            PG8_WAIT_V(6); PG8_BAR; PG8_MMA(1, 1, At, B1); PG8_BAR;
            }
        }
        if constexpr (ALIGN_EPI) { if (wr == 0) PG8_BAR; }
        if constexpr (!Epi::AFTER_DRAIN) { E(acc, cur, wr, wc, fr, fq); S.done(cur); }
        if (!has_next) break;
#pragma unroll
        for (int a = 0; a < 2; ++a)
#pragma unroll
            for (int b = 0; b < 2; ++b)
#pragma unroll
                for (int m = 0; m < 4; ++m)
#pragma unroll
                    for (int n = 0; n < 2; ++n) acc[a][b][m][n] = (f32x4){0.f, 0.f, 0.f, 0.f};
        cur = nxt; cA = nA; cB = nB; ++ui;
        if constexpr (ALIGN_EPI) { if (wr == 1) PG8_BAR; }
    }
    PG8_WAIT_V(0);
    if constexpr (!ALIGN_EPI) { if (wr == 0) PG8_BAR; }
    PG8_BAR;
    if constexpr (Epi::AFTER_DRAIN) { E.fused(acc, cur, wr, wc, fr, fq, lds, wid, lane); S.done(cur); }
#undef PG8_SA
#undef PG8_SB
#undef PG8_STAGE
#undef PG8_LDA
#undef PG8_LDB
#undef PG8_MMA
#undef PG8_WAIT_V
#undef PG8_WAIT_L
#undef PG8_BAR
#undef PG8_SCHED
}
}
namespace mk {
#define LAS __attribute__((address_space(3)))
typedef unsigned short bf16_t;
typedef short bf16x8 __attribute__((ext_vector_type(8)));
typedef float f32x4 __attribute__((ext_vector_type(4)));
typedef unsigned u32x4 __attribute__((ext_vector_type(4)));
typedef unsigned u32x2 __attribute__((ext_vector_type(2)));

constexpr int SEQ = 4096, NU = 6912;
constexpr float EPS = 1e-6f;
constexpr int UA_Q = 0, UB_Q = 512, UC_V = 1024, UD_Q = 1536, UA_I = 2048, UA_FF = 2560, UA_FB = 3072, UA_Z = 3584;
constexpr int UB_K = 4096, UB_V = 4224, UB_Z = 4352, UC_Q = 4864, UC_K = 5120, UC_O = 5376, UC_Z = 5888, UD_Z = 6400;
constexpr int NSC = 16;
constexpr int SA_ELEMS = 128 * 128;
constexpr int SC_ROWS = 144, SC_ELEMS = SC_ROWS * 64;

struct MP {
    bf16_t* u;
    const float* gates;
    const bf16_t* kv;
    const float* cs; const float* sn;
    const float* lb;
    const float* hgrn_g; const float* sink; const float* conv_w; const float* gate_b; const float* mlstm_g;
    bf16_t* SA; float* DA;
    bf16_t* SC; float* CS;
    int nb;
};

__device__ __forceinline__ int otid() { int t = threadIdx.x; asm volatile("" : "+v"(t)); return t; }
__device__ __forceinline__ float bf2f(unsigned short h) { return __uint_as_float((unsigned)h << 16); }
__device__ __forceinline__ unsigned short f2bf(float f) { unsigned u = __float_as_uint(f); return (unsigned short)((u + 0x7fffu + ((u >> 16) & 1u)) >> 16); }
__device__ __forceinline__ unsigned pk2(float lo, float hi) { return (unsigned)f2bf(lo) | ((unsigned)f2bf(hi) << 16); }
__device__ __forceinline__ float sigm(float x) { return 1.0f / (1.0f + __expf(-x)); }
__device__ __forceinline__ float silu(float x) { return x / (1.0f + __expf(-x)); }

template <int K>
__device__ __forceinline__ void mma_nt(f32x4& acc, const LAS bf16_t* A, int lda, int m0, const LAS bf16_t* Bt, int ldb, int n0, int lane) {
    const LAS bf16_t* ap = A + (m0 + (lane & 15)) * lda + 8 * (lane >> 4);
    const LAS bf16_t* bp = Bt + (n0 + (lane & 15)) * ldb + 8 * (lane >> 4);
#pragma unroll
    for (int k0 = 0; k0 < K; k0 += 32) {
        const bf16x8 a = *(const LAS bf16x8*)(ap + k0);
        const bf16x8 b = *(const LAS bf16x8*)(bp + k0);
        acc = __builtin_amdgcn_mfma_f32_16x16x32_bf16(a, b, acc, 0, 0, 0);
    }
}
__device__ __forceinline__ float grp16_max(float v) { v = fmaxf(v, __shfl_xor(v, 1)); v = fmaxf(v, __shfl_xor(v, 2)); v = fmaxf(v, __shfl_xor(v, 4)); v = fmaxf(v, __shfl_xor(v, 8)); return v; }
__device__ __forceinline__ float grp16_sum(float v) { v += __shfl_xor(v, 1); v += __shfl_xor(v, 2); v += __shfl_xor(v, 4); v += __shfl_xor(v, 8); return v; }

__device__ __forceinline__ void d_item(const MP& p, LAS unsigned char* lds, int item) {
    const int tid = otid(), lane = tid & 63, w = __builtin_amdgcn_readfirstlane(tid >> 6);
    const int qt = item & 63, h = (item >> 6) & 3, b = item >> 8;
    const size_t row0 = (size_t)b * SEQ + qt * 64;
    LAS bf16_t* Qs = (LAS bf16_t*)lds;
    LAS bf16_t* KV = Qs + 64 * 136;
    LAS bf16_t* Ps = KV + 256 * 136;
    LAS float* red = (LAS float*)(Ps + 64 * 264);
    for (int c = tid; c < 64 * 16; c += 512) { const int r = c >> 4, ch = c & 15;
        const u32x4 v = *(const u32x4*)(p.u + (row0 + r) * NU + UD_Q + h * 128 + ch * 8); *(LAS u32x4*)(Qs + r * 136 + ch * 8) = v; }
    for (int c = tid; c < 256 * 16; c += 512) { const int r = c >> 4, ch = c & 15;
        const u32x4 v = *(const u32x4*)(p.kv + ((size_t)b * 256 + r) * 1024 + h * 128 + ch * 8); *(LAS u32x4*)(KV + r * 136 + ch * 8) = v; }
    __syncthreads();
    const int mb = w >> 1, nh = w & 1, q4 = lane >> 4, c16 = lane & 15;
    f32x4 s[8];
#pragma unroll
    for (int j = 0; j < 8; ++j) { s[j] = (f32x4){0.f, 0.f, 0.f, 0.f}; mma_nt<128>(s[j], Qs, 136, mb * 16, KV, 136, nh * 128 + j * 16, lane); }
    const float scale = 0.08838834764831845f;
    float mx[4];
#pragma unroll
    for (int i = 0; i < 4; ++i) { float m = -INFINITY;
#pragma unroll
        for (int j = 0; j < 8; ++j) { s[j][i] *= scale; m = fmaxf(m, s[j][i]); }
        mx[i] = grp16_max(m); }
    if (c16 == 0) {
#pragma unroll
        for (int i = 0; i < 4; ++i) red[nh * 64 + mb * 16 + 4 * q4 + i] = mx[i]; }
    __syncthreads();
#pragma unroll
    for (int i = 0; i < 4; ++i) { const int r = mb * 16 + 4 * q4 + i; const float m = fmaxf(red[r], red[64 + r]); float sum = 0.f;
#pragma unroll
        for (int j = 0; j < 8; ++j) { const float e = __expf(s[j][i] - m); sum += e; Ps[r * 264 + nh * 128 + j * 16 + c16] = f2bf(e); }
        sum = grp16_sum(sum);
        if (c16 == 0) red[128 + nh * 64 + r] = sum; }
    __syncthreads();
    for (int c = tid; c < 256 * 16; c += 512) { const int j = c & 255, ch = c >> 8;
        const u32x4 v = *(const u32x4*)(p.kv + ((size_t)b * 256 + j) * 1024 + 512 + h * 128 + ch * 8);
        LAS bf16_t* d = KV + (ch * 8) * 264 + j;
        d[0 * 264] = (bf16_t)(v.x & 0xffffu); d[1 * 264] = (bf16_t)(v.x >> 16); d[2 * 264] = (bf16_t)(v.y & 0xffffu); d[3 * 264] = (bf16_t)(v.y >> 16);
        d[4 * 264] = (bf16_t)(v.z & 0xffffu); d[5 * 264] = (bf16_t)(v.z >> 16); d[6 * 264] = (bf16_t)(v.w & 0xffffu); d[7 * 264] = (bf16_t)(v.w >> 16); }
    __syncthreads();
    f32x4 o[4];
#pragma unroll
    for (int n = 0; n < 4; ++n) { o[n] = (f32x4){0.f, 0.f, 0.f, 0.f}; mma_nt<256>(o[n], Ps, 264, mb * 16, KV, 264, (nh * 4 + n) * 16, lane); }
#pragma unroll
    for (int i = 0; i < 4; ++i) { const int r = mb * 16 + 4 * q4 + i; const float inv = 1.0f / (red[128 + r] + red[192 + r]);
        bf16_t* urow = p.u + (row0 + r) * NU;
#pragma unroll
        for (int n = 0; n < 4; ++n) { const int col = h * 128 + (nh * 4 + n) * 16 + c16;
            const float z = bf2f(urow[UD_Z + col]); urow[UD_Q + col] = f2bf(o[n][i] * inv * silu(z)); } }
    __syncthreads();
}

__device__ __forceinline__ void b_item(const MP& p, LAS unsigned char* lds, int item) {
    const int tid = otid(), lane = tid & 63, w = __builtin_amdgcn_readfirstlane(tid >> 6);
    const int qt = item & 63, kvh = (item >> 6) & 1, b = item >> 7;
    const int t0 = qt * 64; const size_t brow = (size_t)b * SEQ;
    LAS bf16_t* Ks = (LAS bf16_t*)lds;
    LAS bf16_t* Vt = Ks + 320 * 72;
    LAS bf16_t* Qs = Vt + 64 * 328;
    LAS bf16_t* Ps = Qs + 64 * 72;
    LAS float* red = (LAS float*)(Ps + 64 * 328);
    const int k0 = t0 - 128;
    for (int c = tid; c < 320 * 4; c += 512) { const int j = c >> 2, part = c & 3; const int kp = k0 + j;
        u32x4 a = (u32x4){0u, 0u, 0u, 0u}, bb = a;
        if (kp >= 0 && kp < SEQ) {
            const bf16_t* src = p.u + (brow + kp) * NU + UB_K + kvh * 64 + part * 16;
            a = *(const u32x4*)src; bb = *(const u32x4*)(src + 8);
            if (part == 0) {
                const float* cs = p.cs + (brow + kp) * 8; const float* sn = p.sn + (brow + kp) * 8;
                float x1[8], x2[8];
                x1[0] = bf2f(a.x & 0xffffu); x1[1] = bf2f(a.x >> 16); x1[2] = bf2f(a.y & 0xffffu); x1[3] = bf2f(a.y >> 16); x1[4] = bf2f(a.z & 0xffffu); x1[5] = bf2f(a.z >> 16); x1[6] = bf2f(a.w & 0xffffu); x1[7] = bf2f(a.w >> 16);
                x2[0] = bf2f(bb.x & 0xffffu); x2[1] = bf2f(bb.x >> 16); x2[2] = bf2f(bb.y & 0xffffu); x2[3] = bf2f(bb.y >> 16); x2[4] = bf2f(bb.z & 0xffffu); x2[5] = bf2f(bb.z >> 16); x2[6] = bf2f(bb.w & 0xffffu); x2[7] = bf2f(bb.w >> 16);
                float r1[8], r2[8];
#pragma unroll
                for (int e = 0; e < 8; ++e) { const float cc = cs[e], ss = sn[e]; r1[e] = x1[e] * cc - x2[e] * ss; r2[e] = x2[e] * cc + x1[e] * ss; }
                a = (u32x4){pk2(r1[0], r1[1]), pk2(r1[2], r1[3]), pk2(r1[4], r1[5]), pk2(r1[6], r1[7])};
                bb = (u32x4){pk2(r2[0], r2[1]), pk2(r2[2], r2[3]), pk2(r2[4], r2[5]), pk2(r2[6], r2[7])};
            }
        }
        *(LAS u32x4*)(Ks + j * 72 + part * 16) = a; *(LAS u32x4*)(Ks + j * 72 + part * 16 + 8) = bb; }
    for (int c = tid; c < 320 * 8; c += 512) { const int j = c % 320, ch = c / 320; const int kp = k0 + j;
        u32x4 v = (u32x4){0u, 0u, 0u, 0u};
        if (kp >= 0 && kp < SEQ) v = *(const u32x4*)(p.u + (brow + kp) * NU + UB_V + kvh * 64 + ch * 8);
        LAS bf16_t* d = Vt + (ch * 8) * 328 + j;
        d[0 * 328] = (bf16_t)(v.x & 0xffffu); d[1 * 328] = (bf16_t)(v.x >> 16); d[2 * 328] = (bf16_t)(v.y & 0xffffu); d[3 * 328] = (bf16_t)(v.y >> 16);
        d[4 * 328] = (bf16_t)(v.z & 0xffffu); d[5 * 328] = (bf16_t)(v.z >> 16); d[6 * 328] = (bf16_t)(v.w & 0xffffu); d[7 * 328] = (bf16_t)(v.w >> 16); }
    const int mb = w >> 1, nh = w & 1, q4 = lane >> 4, c16 = lane & 15;
    for (int g = 0; g < 4; ++g) {
        const int hq = kvh * 4 + g;
        for (int c = tid; c < 64 * 4; c += 512) { const int r = c >> 2, part = c & 3;
            const bf16_t* src = p.u + (brow + t0 + r) * NU + UB_Q + hq * 64 + part * 16;
            u32x4 a = *(const u32x4*)src, bb = *(const u32x4*)(src + 8);
            if (part == 0) {
                const float* cs = p.cs + (brow + t0 + r) * 8; const float* sn = p.sn + (brow + t0 + r) * 8;
                float x1[8], x2[8];
                x1[0] = bf2f(a.x & 0xffffu); x1[1] = bf2f(a.x >> 16); x1[2] = bf2f(a.y & 0xffffu); x1[3] = bf2f(a.y >> 16); x1[4] = bf2f(a.z & 0xffffu); x1[5] = bf2f(a.z >> 16); x1[6] = bf2f(a.w & 0xffffu); x1[7] = bf2f(a.w >> 16);
                x2[0] = bf2f(bb.x & 0xffffu); x2[1] = bf2f(bb.x >> 16); x2[2] = bf2f(bb.y & 0xffffu); x2[3] = bf2f(bb.y >> 16); x2[4] = bf2f(bb.z & 0xffffu); x2[5] = bf2f(bb.z >> 16); x2[6] = bf2f(bb.w & 0xffffu); x2[7] = bf2f(bb.w >> 16);
                float r1[8], r2[8];
#pragma unroll
                for (int e = 0; e < 8; ++e) { const float cc = cs[e], ss = sn[e]; r1[e] = x1[e] * cc - x2[e] * ss; r2[e] = x2[e] * cc + x1[e] * ss; }
                a = (u32x4){pk2(r1[0], r1[1]), pk2(r1[2], r1[3]), pk2(r1[4], r1[5]), pk2(r1[6], r1[7])};
                bb = (u32x4){pk2(r2[0], r2[1]), pk2(r2[2], r2[3]), pk2(r2[4], r2[5]), pk2(r2[6], r2[7])};
            }
            *(LAS u32x4*)(Qs + r * 72 + part * 16) = a; *(LAS u32x4*)(Qs + r * 72 + part * 16 + 8) = bb; }
        __syncthreads();
        f32x4 s[10];
#pragma unroll
        for (int j = 0; j < 10; ++j) { s[j] = (f32x4){0.f, 0.f, 0.f, 0.f}; mma_nt<64>(s[j], Qs, 72, mb * 16, Ks, 72, nh * 160 + j * 16, lane); }
        const float sk = p.sink[hq];
        float mx[4];
#pragma unroll
        for (int i = 0; i < 4; ++i) { const int qp = t0 + mb * 16 + 4 * q4 + i; float m = -INFINITY;
#pragma unroll
            for (int j = 0; j < 10; ++j) { const int kp = k0 + nh * 160 + j * 16 + c16; const int df = kp - qp;
                const bool ok = (kp >= 0) && (kp < SEQ) && (df <= 128) && (df >= -128);
                const float v = ok ? s[j][i] * 0.125f : -INFINITY; s[j][i] = v; m = fmaxf(m, v); }
            mx[i] = grp16_max(m); }
        if (c16 == 0) {
#pragma unroll
            for (int i = 0; i < 4; ++i) red[nh * 64 + mb * 16 + 4 * q4 + i] = mx[i]; }
        __syncthreads();
#pragma unroll
        for (int i = 0; i < 4; ++i) { const int r = mb * 16 + 4 * q4 + i; const float m = fmaxf(fmaxf(red[r], red[64 + r]), sk); float sum = 0.f;
#pragma unroll
            for (int j = 0; j < 10; ++j) { const float e = __expf(s[j][i] - m); sum += e; Ps[r * 328 + nh * 160 + j * 16 + c16] = f2bf(e); }
            sum = grp16_sum(sum);
            if (c16 == 0) { red[128 + nh * 64 + r] = sum; if (nh == 0) red[256 + r] = __expf(sk - m); } }
        __syncthreads();
        f32x4 o[2];
#pragma unroll
        for (int n = 0; n < 2; ++n) { o[n] = (f32x4){0.f, 0.f, 0.f, 0.f}; mma_nt<320>(o[n], Ps, 328, mb * 16, Vt, 328, (nh * 2 + n) * 16, lane); }
#pragma unroll
        for (int i = 0; i < 4; ++i) { const int r = mb * 16 + 4 * q4 + i; const float inv = 1.0f / (red[128 + r] + red[192 + r] + red[256 + r]);
            bf16_t* urow = p.u + (brow + t0 + r) * NU;
#pragma unroll
            for (int n = 0; n < 2; ++n) { const int col = hq * 64 + (nh * 2 + n) * 16 + c16;
                const float z = bf2f(urow[UB_Z + col]); urow[UB_Q + col] = f2bf(o[n][i] * inv * silu(z)); } }
        __syncthreads();
    }
}

struct ALds {
    LAS bf16_t *Qt, *Kt, *Qh, *KhT, *Vt, *Pm, *St; LAS float *seg, *Dl, *stats;
};
__device__ __forceinline__ ALds a_lds(LAS unsigned char* lds) {
    ALds L; L.Qt = (LAS bf16_t*)lds; L.Kt = L.Qt + 64 * 136; L.Qh = L.Kt + 64 * 136; L.KhT = L.Qh + 64 * 136; L.Vt = L.KhT + 128 * 72; L.Pm = L.Vt + 128 * 72;
    L.St = L.Pm + 64 * 72; L.seg = (LAS float*)(L.St + 128 * 136); L.Dl = L.seg + 512; L.stats = L.Dl + 128; return L;
}
template <int MODE>
__device__ __forceinline__ float a_gates(const MP& p, const ALds& L, size_t tbase, int h, int dir, float carry) {
    const int tid = otid(), d = tid & 127, sg = tid >> 7;
    const float lbv = p.lb[h * 128 + d];
    unsigned off = (unsigned)((tbase + sg * 16) * NU + h * 128 + d);
    float g[16], kk[16]; unsigned qp[8], vp[8];
#pragma unroll
    for (int k = 0; k < 16; ++k) {
        asm volatile("" : "+v"(off));
        const float z = bf2f(p.u[off + (dir ? UA_FB : UA_FF)]);
        const unsigned vv = p.u[off + UA_I];
        if (k & 1) vp[k >> 1] |= vv << 16; else vp[k >> 1] = vv;
        if (MODE == 1) { const unsigned qq = p.u[off + UA_Q]; if (k & 1) qp[k >> 1] |= qq << 16; else qp[k >> 1] = qq; }
        const float f = lbv + (1.f - lbv) * sigm(z);
        g[k] = __logf(f); kk[k] = 1.f - f;
        off += NU; }
    if (dir == 0) {
#pragma unroll
        for (int k = 1; k < 16; ++k) g[k] += g[k - 1];
        L.seg[sg * 128 + d] = g[15];
    } else {
#pragma unroll
        for (int k = 14; k >= 0; --k) g[k] += g[k + 1];
        L.seg[sg * 128 + d] = g[0];
    }
    __syncthreads();
    const float s0 = L.seg[d], s1 = L.seg[128 + d], s2 = L.seg[256 + d], s3 = L.seg[384 + d];
    const float tot = (s0 + s1) + (s2 + s3);
    float pre;
    if (dir == 0) pre = (sg > 0 ? s0 : 0.f) + (sg > 1 ? s1 : 0.f) + (sg > 2 ? s2 : 0.f);
    else pre = (sg < 3 ? s3 : 0.f) + (sg < 2 ? s2 : 0.f) + (sg < 1 ? s1 : 0.f);
    const float ref = dir == 0 ? (s0 + s1) : (s2 + s3);
    unsigned khp[8];
#pragma unroll
    for (int k = 0; k < 16; ++k) { const float bk = pre + g[k];
        const int pp = sg * 16 + k;
        const unsigned khb = f2bf(kk[k] * __expf((tot - bk) + carry));
        if (k & 1) khp[k >> 1] |= khb << 16; else khp[k >> 1] = khb;
        if (MODE == 1) {
            const float qv = bf2f((unsigned short)((k & 1) ? (qp[k >> 1] >> 16) : (qp[k >> 1] & 0xffffu)));
            L.Qt[pp * 136 + d] = f2bf(qv * __expf(bk - ref));
            L.Kt[pp * 136 + d] = f2bf(kk[k] * __expf(ref - bk));
            L.Qh[pp * 136 + d] = f2bf(qv * __expf(bk));
        } }
    *(LAS u32x4*)(L.KhT + d * 72 + sg * 16) = (u32x4){khp[0], khp[1], khp[2], khp[3]};
    *(LAS u32x4*)(L.KhT + d * 72 + sg * 16 + 8) = (u32x4){khp[4], khp[5], khp[6], khp[7]};
    if (MODE == 1 && sg == 0) L.Dl[d] = __expf(tot);
    *(LAS u32x4*)(L.Vt + d * 72 + sg * 16) = (u32x4){vp[0], vp[1], vp[2], vp[3]};
    *(LAS u32x4*)(L.Vt + d * 72 + sg * 16 + 8) = (u32x4){vp[4], vp[5], vp[6], vp[7]};
    return tot;
}

__device__ __forceinline__ void a_pass1(const MP& p, LAS unsigned char* lds, int item) {
    const int tid = otid(), lane = tid & 63, w = __builtin_amdgcn_readfirstlane(tid >> 6);
    const int dir = item & 1, sc = (item >> 1) & 15, h = (item >> 5) & 3, b = item >> 7;
    const ALds L = a_lds(lds);
    const int q4 = lane >> 4, c16 = lane & 15;
    f32x4 S[8];
#pragma unroll
    for (int j = 0; j < 8; ++j) S[j] = (f32x4){0.f, 0.f, 0.f, 0.f};
    float carry = 0.f;
    for (int ci = 0; ci < 4; ++ci) {
        const int cc = dir ? ci : 3 - ci;
        const size_t tbase = (size_t)b * SEQ + sc * 256 + cc * 64;
        const float tot = a_gates<0>(p, L, tbase, h, dir, carry);
        carry += tot;
        __syncthreads();
#pragma unroll
        for (int j = 0; j < 8; ++j) mma_nt<64>(S[j], L.KhT, 72, j * 16, L.Vt, 72, w * 16, lane);
        __syncthreads();
    }
    const size_t sidx = ((size_t)(dir * p.nb * 4 + b * 4 + h) * NSC + sc);
    bf16_t* dst = p.SA + sidx * SA_ELEMS;
#pragma unroll
    for (int j = 0; j < 8; ++j) {
        *(u32x2*)(dst + (size_t)(w * 16 + c16) * 128 + j * 16 + 4 * q4) = (u32x2){pk2(S[j][0], S[j][1]), pk2(S[j][2], S[j][3])}; }
    if (tid < 128) p.DA[sidx * 128 + tid] = __expf(carry);
}

__device__ __forceinline__ void a_scan_unit(const MP& p, int unit) {
    const int e4 = unit & 4095, seq = unit >> 12;
    const int dir = seq / (p.nb * 4);
    const int dk = (e4 * 4) & 127;
    float S0 = 0.f, S1 = 0.f, S2 = 0.f, S3 = 0.f;
    for (int i = 0; i < NSC; ++i) {
        const int sc = dir ? NSC - 1 - i : i;
        bf16_t* ptr = p.SA + ((size_t)seq * NSC + sc) * SA_ELEMS + e4 * 4;
        const u32x2 v = *(const u32x2*)ptr;
        const f32x4 D = *(const f32x4*)(p.DA + ((size_t)seq * NSC + sc) * 128 + dk);
        *(u32x2*)ptr = (u32x2){pk2(S0, S1), pk2(S2, S3)};
        S0 = D[0] * S0 + bf2f(v.x & 0xffffu); S1 = D[1] * S1 + bf2f(v.x >> 16); S2 = D[2] * S2 + bf2f(v.y & 0xffffu); S3 = D[3] * S3 + bf2f(v.y >> 16);
    }
}

__device__ __forceinline__ void a_pass3(const MP& p, LAS unsigned char* lds, int item) {
    const int tid = otid(), lane = tid & 63, w = __builtin_amdgcn_readfirstlane(tid >> 6);
    const int sc = item & 15, h = (item >> 4) & 3, b = item >> 6;
    const ALds L = a_lds(lds);
    const int q4 = lane >> 4, c16 = lane & 15, mb2 = w >> 1, nh = w & 1;
    f32x4 O[4][4];
#pragma unroll
    for (int a = 0; a < 4; ++a)
#pragma unroll
        for (int m = 0; m < 4; ++m) O[a][m] = (f32x4){0.f, 0.f, 0.f, 0.f};
#pragma unroll 1
    for (int dir = 0; dir < 2; ++dir) {
        const size_t sidx = ((size_t)(dir * p.nb * 4 + b * 4 + h) * NSC + sc);
        const bf16_t* sg = p.SA + sidx * SA_ELEMS;
        for (int c = tid; c < 128 * 16; c += 512) { const int r = c >> 4, ch = c & 15; *(LAS u32x4*)(L.St + r * 136 + ch * 8) = *(const u32x4*)(sg + r * 128 + ch * 8); }
        f32x4 S[8];
#pragma unroll
        for (int j = 0; j < 8; ++j) { const u32x2 v = *(const u32x2*)(sg + (size_t)(w * 16 + c16) * 128 + j * 16 + 4 * q4);
            S[j] = (f32x4){bf2f(v.x & 0xffffu), bf2f(v.x >> 16), bf2f(v.y & 0xffffu), bf2f(v.y >> 16)}; }
#pragma unroll 1
        for (int ci = 0; ci < 4; ++ci) {
            const int cc = dir ? 3 - ci : ci;
            const size_t tbase = (size_t)b * SEQ + sc * 256 + cc * 64;
            (void)a_gates<1>(p, L, tbase, h, dir, 0.f);
            __syncthreads();
#pragma unroll
            for (int n = 0; n < 2; ++n) { f32x4 a = (f32x4){0.f, 0.f, 0.f, 0.f}; const int nb16 = nh * 2 + n;
                mma_nt<128>(a, L.Qt, 136, mb2 * 16, L.Kt, 136, nb16 * 16, lane);
#pragma unroll
                for (int i = 0; i < 4; ++i) { const int pt = mb2 * 16 + 4 * q4 + i, ps = nb16 * 16 + c16;
                    const bool keep = dir ? (ps >= pt) : (ps <= pt);
                    L.Pm[pt * 72 + ps] = f2bf(keep ? a[i] : 0.f); } }
            __syncthreads();
            f32x4 T[4];
#pragma unroll
            for (int m = 0; m < 4; ++m) { T[m] = (f32x4){0.f, 0.f, 0.f, 0.f};
                mma_nt<64>(T[m], L.Pm, 72, m * 16, L.Vt, 72, w * 16, lane);
                mma_nt<128>(T[m], L.Qh, 136, m * 16, L.St, 136, w * 16, lane);
                __builtin_amdgcn_sched_barrier(0); }
            if (cc == 0) {
#pragma unroll
                for (int m = 0; m < 4; ++m) O[0][m] += T[m];
            } else if (cc == 1) {
#pragma unroll
                for (int m = 0; m < 4; ++m) O[1][m] += T[m];
            } else if (cc == 2) {
#pragma unroll
                for (int m = 0; m < 4; ++m) O[2][m] += T[m];
            } else {
#pragma unroll
                for (int m = 0; m < 4; ++m) O[3][m] += T[m];
            }
#pragma unroll
            for (int j = 0; j < 8; ++j) { const f32x4 D = *(const LAS f32x4*)(L.Dl + j * 16 + 4 * q4);
                S[j] = S[j] * D;
                mma_nt<64>(S[j], L.KhT, 72, j * 16, L.Vt, 72, w * 16, lane);
                *(LAS u32x2*)(L.St + (w * 16 + c16) * 136 + j * 16 + 4 * q4) = (u32x2){pk2(S[j][0], S[j][1]), pk2(S[j][2], S[j][3])};
                __builtin_amdgcn_sched_barrier(0); }
            __syncthreads();
        }
    }
    int q4e = q4 * 4; asm volatile("" : "+v"(q4e));
#pragma unroll
    for (int a = 0; a < 4; ++a)
#pragma unroll
        for (int m = 0; m < 4; ++m)
#pragma unroll
            for (int i = 0; i < 4; ++i) { const float v = O[a][m][i]; const float s = grp16_sum(v * v);
                if (c16 == 0) L.stats[w * 256 + a * 64 + m * 16 + q4e + i] = s; }
    __syncthreads();
    const float gn = p.hgrn_g[h * 128 + w * 16 + c16];
    const unsigned ebase = (unsigned)(((size_t)b * SEQ + sc * 256) * NU + h * 128 + w * 16 + c16);
#pragma unroll
    for (int a = 0; a < 4; ++a)
#pragma unroll
        for (int m = 0; m < 4; ++m)
#pragma unroll
            for (int i = 0; i < 4; ++i) { const int tl = a * 64 + m * 16 + q4e + i;
                float ss = 0.f;
#pragma unroll
                for (int ww = 0; ww < 8; ++ww) ss += L.stats[ww * 256 + tl];
                const float rs = 1.0f / sqrtf(ss * (1.0f / 128.f) + EPS);
                unsigned eo = ebase + (unsigned)tl * NU; asm volatile("" : "+v"(eo));
                const float z = bf2f(p.u[eo + UA_Z]);
                p.u[eo + UA_Q] = f2bf(O[a][m][i] * rs * gn * silu(z));
                if (i == 3) asm volatile("" ::: "memory"); }
    __syncthreads();
}

struct CLds {
    LAS bf16_t *Qc, *Kc, *Qg, *KhT, *Vt, *Pw, *St, *raw; LAS float *sc;
};
__device__ __forceinline__ CLds c_lds(LAS unsigned char* lds) {
    CLds L; L.Qc = (LAS bf16_t*)lds; L.Kc = L.Qc + 64 * 72; L.Qg = L.Kc + 64 * 72; L.KhT = L.Qg + 64 * 72; L.Vt = L.KhT + 64 * 72; L.Pw = L.Vt + 144 * 72; L.St = L.Pw + 64 * 72;
    L.raw = L.St + 144 * 72; L.sc = (LAS float*)(L.raw + 68 * 136); return L;
}
__device__ __forceinline__ float log_sigmoid(float x) { return fminf(x, 0.f) - log1pf(__expf(-fabsf(x))); }

template <bool WANT_Q>
__device__ __forceinline__ void c_load_qkv(const MP& p, const CLds& L, int b, int tl0  , int h) {
    const int tid = otid();
    const size_t brow = (size_t)b * SEQ;
    for (int c = tid; c < 68 * 16; c += 512) { const int r = c >> 4, ch = c & 15; const int tl = tl0 - 2 + r;
        u32x4 v = (u32x4){0u, 0u, 0u, 0u};
        if (tl >= 0 && tl < SEQ) v = *(const u32x4*)(p.u + (brow + tl) * NU + (ch < 8 ? UC_Q + h * 64 + ch * 8 : UC_K + h * 64 + (ch - 8) * 8));
        *(LAS u32x4*)(L.raw + r * 136 + ch * 8) = v; }
    {
        const int d = tid & 127, sg = tid >> 7;
        unsigned off = (unsigned)((brow + tl0 + sg * 16) * NU + UC_V + h * 128 + d);
        unsigned vp[8];
#pragma unroll
        for (int k = 0; k < 16; ++k) { asm volatile("" : "+v"(off)); const unsigned vv = p.u[off]; if (k & 1) vp[k >> 1] |= vv << 16; else vp[k >> 1] = vv; off += NU; }
        *(LAS u32x4*)(L.Vt + d * 72 + sg * 16) = (u32x4){vp[0], vp[1], vp[2], vp[3]};
        *(LAS u32x4*)(L.Vt + d * 72 + sg * 16 + 8) = (u32x4){vp[4], vp[5], vp[6], vp[7]};
        if (tid < 16 * 8) { const int r = 128 + (tid >> 3), ch = tid & 7; const unsigned one = (r == 128) ? 0x3f803f80u : 0u; *(LAS u32x4*)(L.Vt + r * 72 + ch * 8) = (u32x4){one, one, one, one}; }
    }
    __syncthreads();
    for (int e = tid; e < 64 * 128; e += 512) { const int pp = e >> 7, ch = e & 127;
        if (!WANT_Q && ch < 64) continue;
        const int wc = (ch < 64) ? (h * 64 + ch) : (256 + h * 64 + (ch - 64));
        float s = 0.f;
#pragma unroll
        for (int j = 0; j < 5; ++j) s = fmaf(bf2f(L.raw[(pp + j) * 136 + ch]), p.conv_w[j * 512 + wc], s);
        s = silu(s);
        if (ch < 64) L.Qc[pp * 72 + ch] = f2bf(s * 0.125f); else L.Kc[pp * 72 + (ch - 64)] = f2bf(s); }
}

__device__ __forceinline__ void c_pass1(const MP& p, LAS unsigned char* lds, int item) {
    const int tid = otid(), lane = tid & 63, w = __builtin_amdgcn_readfirstlane(tid >> 6);
    const int dir = item & 1, sc = (item >> 1) & 15, h = (item >> 5) & 3, b = item >> 7;
    const CLds L = c_lds(lds);
    const int q4 = lane >> 4, c16 = lane & 15;
    const size_t brow = (size_t)b * SEQ; const int tls = sc * 256;
    if (w == 0) {
        const float bi = p.gate_b[dir * 4 + h], bf = p.gate_b[8 + dir * 4 + h];
        float lf[4], li[4];
#pragma unroll
        for (int k = 0; k < 4; ++k) { const float* gr = p.gates + (brow + tls + lane * 4 + k) * 16; li[k] = gr[dir * 4 + h] + bi; lf[k] = log_sigmoid(gr[8 + dir * 4 + h] + bf); }
        const float tot4 = (lf[0] + lf[1]) + (lf[2] + lf[3]);
        float incl = tot4;
        if (dir == 0) {
#pragma unroll
            for (int o = 1; o < 64; o <<= 1) { const float t = __shfl_down(incl, o); if (lane + o < 64) incl += t; }
        } else {
#pragma unroll
            for (int o = 1; o < 64; o <<= 1) { const float t = __shfl_up(incl, o); if (lane >= o) incl += t; }
        }
        const float after_lane = incl - tot4;
        float E[4];
        if (dir == 0) { E[3] = after_lane; E[2] = E[3] + lf[3]; E[1] = E[2] + lf[2]; E[0] = E[1] + lf[1]; }
        else { E[0] = after_lane; E[1] = E[0] + lf[0]; E[2] = E[1] + lf[1]; E[3] = E[2] + lf[2]; }
        float a[4], amax = -INFINITY;
#pragma unroll
        for (int k = 0; k < 4; ++k) { a[k] = E[k] + li[k]; amax = fmaxf(amax, a[k]); }
#pragma unroll
        for (int o = 32; o > 0; o >>= 1) amax = fmaxf(amax, __shfl_xor(amax, o));
        float Btot = tot4;
#pragma unroll
        for (int o = 32; o > 0; o >>= 1) Btot += __shfl_xor(Btot, o);
#pragma unroll
        for (int k = 0; k < 4; ++k) L.sc[192 + lane * 4 + k] = __expf(a[k] - amax);
        if (lane == 0) { L.sc[576 + 2] = amax; L.sc[576 + 3] = Btot; }
    }
    f32x4 S[5];
#pragma unroll
    for (int j = 0; j < 5; ++j) S[j] = (f32x4){0.f, 0.f, 0.f, 0.f};
    for (int cc = 0; cc < 4; ++cc) {
        c_load_qkv<false>(p, L, b, tls + cc * 64, h);
        __syncthreads();
        for (int e = tid; e < 64 * 64; e += 512) { const int pp = e & 63, dk = e >> 6;
            L.KhT[dk * 72 + pp] = f2bf(L.sc[192 + cc * 64 + pp] * bf2f(L.Kc[pp * 72 + dk])); }
        __syncthreads();
#pragma unroll
        for (int j = 0; j < 4; ++j) mma_nt<64>(S[j], L.KhT, 72, j * 16, L.Vt, 72, w * 16, lane);
        if (w < 4) mma_nt<64>(S[4], L.KhT, 72, w * 16, L.Vt, 72, 128, lane);
        __syncthreads();
    }
    const size_t sidx = ((size_t)(dir * p.nb * 4 + b * 4 + h) * NSC + sc);
    bf16_t* dst = p.SC + sidx * SC_ELEMS;
#pragma unroll
    for (int j = 0; j < 4; ++j) *(u32x2*)(dst + (size_t)(w * 16 + c16) * 64 + j * 16 + 4 * q4) = (u32x2){pk2(S[j][0], S[j][1]), pk2(S[j][2], S[j][3])};
    if (w < 4) *(u32x2*)(dst + (size_t)(128 + c16) * 64 + w * 16 + 4 * q4) = (u32x2){pk2(S[4][0], S[4][1]), pk2(S[4][2], S[4][3])};
    if (tid == 0) { p.CS[sidx * 4 + 0] = L.sc[576 + 2]; p.CS[sidx * 4 + 1] = L.sc[576 + 3]; }
    __syncthreads();
}

__device__ __forceinline__ void c_scan_unit(const MP& p, int unit) {
    const int e4 = unit % 2304, seq = unit / 2304;
    const int dir = seq / (p.nb * 4);
    float S0 = 0.f, S1 = 0.f, S2 = 0.f, S3 = 0.f, M = 0.f;
    for (int i = 0; i < NSC; ++i) {
        const int sc = dir ? NSC - 1 - i : i;
        const size_t sidx = (size_t)seq * NSC + sc;
        bf16_t* ptr = p.SC + sidx * SC_ELEMS + e4 * 4;
        const u32x2 v = *(const u32x2*)ptr;
        const float A = p.CS[sidx * 4 + 0], B = p.CS[sidx * 4 + 1];
        *(u32x2*)ptr = (u32x2){pk2(S0, S1), pk2(S2, S3)};
        if (e4 == 0) p.CS[sidx * 4 + 2] = M;
        const float Mn = fmaxf(B + M, A);
        const float dc = __expf(B + M - Mn), wn = __expf(A - Mn);
        S0 = dc * S0 + wn * bf2f(v.x & 0xffffu); S1 = dc * S1 + wn * bf2f(v.x >> 16); S2 = dc * S2 + wn * bf2f(v.y & 0xffffu); S3 = dc * S3 + wn * bf2f(v.y >> 16);
        M = Mn;
    }
}

__device__ __forceinline__ void c_pass3(const MP& p, LAS unsigned char* lds, int item) {
    const int tid = otid(), lane = tid & 63, w = __builtin_amdgcn_readfirstlane(tid >> 6);
    const int sc = item & 15, h = (item >> 4) & 3, b = item >> 6;
    const CLds L = c_lds(lds);
    const int q4 = lane >> 4, c16 = lane & 15, mb2 = w >> 1, nh = w & 1;
    const size_t brow = (size_t)b * SEQ; const int tls = sc * 256;
    f32x4 H[4][4];
#pragma unroll
    for (int a = 0; a < 4; ++a)
#pragma unroll
        for (int m = 0; m < 4; ++m) H[a][m] = (f32x4){0.f, 0.f, 0.f, 0.f};
#pragma unroll 1
    for (int dir = 0; dir < 2; ++dir) {
        const size_t sidx = ((size_t)(dir * p.nb * 4 + b * 4 + h) * NSC + sc);
        const bf16_t* sg = p.SC + sidx * SC_ELEMS;
        for (int c = tid; c < 144 * 8; c += 512) { const int r = c >> 3, ch = c & 7; *(LAS u32x4*)(L.St + r * 72 + ch * 8) = *(const u32x4*)(sg + r * 64 + ch * 8); }
        f32x4 S[5];
#pragma unroll
        for (int j = 0; j < 4; ++j) { const u32x2 v = *(const u32x2*)(sg + (size_t)(w * 16 + c16) * 64 + j * 16 + 4 * q4);
            S[j] = (f32x4){bf2f(v.x & 0xffffu), bf2f(v.x >> 16), bf2f(v.y & 0xffffu), bf2f(v.y >> 16)}; }
        S[4] = (f32x4){0.f, 0.f, 0.f, 0.f};
        if (w < 4) { const u32x2 v = *(const u32x2*)(sg + (size_t)(128 + c16) * 64 + w * 16 + 4 * q4);
            S[4] = (f32x4){bf2f(v.x & 0xffffu), bf2f(v.x >> 16), bf2f(v.y & 0xffffu), bf2f(v.y >> 16)}; }
        if (tid == 0) L.sc[576 + 1] = p.CS[sidx * 4 + 2];
#pragma unroll 1
        for (int ci = 0; ci < 4; ++ci) {
            const int cc = dir ? 3 - ci : ci;
            const int tl0 = tls + cc * 64;
            c_load_qkv<true>(p, L, b, tl0, h);
            if (w == 0) {
                const float M = L.sc[576 + 1];
                const float* gr = p.gates + (brow + tl0 + lane) * 16;
                const float li = gr[dir * 4 + h] + p.gate_b[dir * 4 + h];
                const float lf = log_sigmoid(gr[8 + dir * 4 + h] + p.gate_b[8 + dir * 4 + h]);
                float bc = lf;
                if (dir == 0) {
#pragma unroll
                    for (int o = 1; o < 64; o <<= 1) { const float t = __shfl_up(bc, o); if (lane >= o) bc += t; }
                } else {
#pragma unroll
                    for (int o = 1; o < 64; o <<= 1) { const float t = __shfl_down(bc, o); if (lane + o < 64) bc += t; }
                }
                const float cb = li - bc;
                float pm = cb;
                if (dir == 0) {
#pragma unroll
                    for (int o = 1; o < 64; o <<= 1) { const float t = __shfl_up(pm, o); if (lane >= o) pm = fmaxf(pm, t); }
                } else {
#pragma unroll
                    for (int o = 1; o < 64; o <<= 1) { const float t = __shfl_down(pm, o); if (lane + o < 64) pm = fmaxf(pm, t); }
                }
                const float mt = fmaxf(bc + pm, bc + M);
                const float blast = __shfl(bc, dir ? 0 : 63);
                const float a = blast - bc + li;
                float amax = a;
#pragma unroll
                for (int o = 32; o > 0; o >>= 1) amax = fmaxf(amax, __shfl_xor(amax, o));
                const float Mn = fmaxf(blast + M, amax);
                L.sc[lane] = bc - mt; L.sc[64 + lane] = cb; L.sc[128 + lane] = __expf(bc + M - mt); L.sc[192 + lane] = __expf(a - Mn); L.sc[448 + lane] = mt;
                if (lane == 0) { L.sc[576 + 0] = __expf(blast + M - Mn); L.sc[576 + 4] = Mn; }
            }
            __syncthreads();
            for (int e = tid; e < 64 * 64; e += 512) { const int pp = e >> 6, dk = e & 63; L.Qg[pp * 72 + dk] = f2bf(L.sc[128 + pp] * bf2f(L.Qc[pp * 72 + dk])); }
            for (int e = tid; e < 64 * 64; e += 512) { const int pp = e & 63, dk = e >> 6; L.KhT[dk * 72 + pp] = f2bf(L.sc[192 + pp] * bf2f(L.Kc[pp * 72 + dk])); }
#pragma unroll
            for (int n = 0; n < 2; ++n) { f32x4 a = (f32x4){0.f, 0.f, 0.f, 0.f}; const int nb16 = nh * 2 + n;
                mma_nt<64>(a, L.Qc, 72, mb2 * 16, L.Kc, 72, nb16 * 16, lane);
#pragma unroll
                for (int i = 0; i < 4; ++i) { const int pt = mb2 * 16 + 4 * q4 + i, ps = nb16 * 16 + c16;
                    const bool keep = dir ? (ps >= pt) : (ps <= pt);
                    const float wv = keep ? a[i] * __expf(L.sc[pt] + L.sc[64 + ps]) : 0.f;
                    L.Pw[pt * 72 + ps] = f2bf(wv); } }
            __syncthreads();
            f32x4 T[4], Tn = (f32x4){0.f, 0.f, 0.f, 0.f};
#pragma unroll
            for (int m = 0; m < 4; ++m) { T[m] = (f32x4){0.f, 0.f, 0.f, 0.f};
                mma_nt<64>(T[m], L.Pw, 72, m * 16, L.Vt, 72, w * 16, lane);
                mma_nt<64>(T[m], L.Qg, 72, m * 16, L.St, 72, w * 16, lane);
                __builtin_amdgcn_sched_barrier(0); }
            if (w < 4) { mma_nt<64>(Tn, L.Pw, 72, w * 16, L.Vt, 72, 128, lane); mma_nt<64>(Tn, L.Qg, 72, w * 16, L.St, 72, 128, lane);
                if (c16 == 0) {
#pragma unroll
                    for (int i = 0; i < 4; ++i) L.sc[512 + w * 16 + 4 * q4 + i] = Tn[i]; } }
            __syncthreads();
#pragma unroll
            for (int m = 0; m < 4; ++m)
#pragma unroll
                for (int i = 0; i < 4; ++i) { const int pp = m * 16 + 4 * q4 + i; const float inv = 1.0f / fmaxf(fabsf(L.sc[512 + pp]), __expf(-L.sc[448 + pp])); T[m][i] *= inv; }
            if (cc == 0) {
#pragma unroll
                for (int m = 0; m < 4; ++m) H[0][m] += T[m];
            } else if (cc == 1) {
#pragma unroll
                for (int m = 0; m < 4; ++m) H[1][m] += T[m];
            } else if (cc == 2) {
#pragma unroll
                for (int m = 0; m < 4; ++m) H[2][m] += T[m];
            } else {
#pragma unroll
                for (int m = 0; m < 4; ++m) H[3][m] += T[m];
            }
            const float dcy = L.sc[576 + 0];
#pragma unroll
            for (int j = 0; j < 4; ++j) { S[j] = S[j] * dcy; mma_nt<64>(S[j], L.KhT, 72, j * 16, L.Vt, 72, w * 16, lane);
                *(LAS u32x2*)(L.St + (w * 16 + c16) * 72 + j * 16 + 4 * q4) = (u32x2){pk2(S[j][0], S[j][1]), pk2(S[j][2], S[j][3])}; }
            if (w < 4) { S[4] = S[4] * dcy; mma_nt<64>(S[4], L.KhT, 72, w * 16, L.Vt, 72, 128, lane);
                *(LAS u32x2*)(L.St + (128 + c16) * 72 + w * 16 + 4 * q4) = (u32x2){pk2(S[4][0], S[4][1]), pk2(S[4][2], S[4][3])}; }
            if (tid == 0) L.sc[576 + 1] = L.sc[576 + 4];
            __syncthreads();
        }
    }
    LAS float* st1 = L.sc + 640; LAS float* st2 = st1 + 8 * 256;
    int q4e = q4 * 4; asm volatile("" : "+v"(q4e));
    const unsigned ebase = (unsigned)((brow + tls) * NU + h * 128 + w * 16 + c16);
#pragma unroll
    for (int a = 0; a < 4; ++a)
#pragma unroll
        for (int m = 0; m < 4; ++m)
#pragma unroll
            for (int i = 0; i < 4; ++i) { const int tl = a * 64 + m * 16 + q4e + i;
                unsigned eo = ebase + (unsigned)tl * NU; asm volatile("" : "+v"(eo));
                const float og = bf2f(p.u[eo + UC_O]);
                const float v = H[a][m][i] * sigm(og); H[a][m][i] = v;
                const float s = grp16_sum(v);
                if (c16 == 0) st1[w * 256 + tl] = s;
                if (i == 3) asm volatile("" ::: "memory"); }
    __syncthreads();
#pragma unroll
    for (int a = 0; a < 4; ++a)
#pragma unroll
        for (int m = 0; m < 4; ++m)
#pragma unroll
            for (int i = 0; i < 4; ++i) { const int tl = a * 64 + m * 16 + q4e + i;
                float ss = 0.f;
#pragma unroll
                for (int ww = 0; ww < 8; ++ww) ss += st1[ww * 256 + tl];
                const float dv = H[a][m][i] - ss * (1.0f / 128.f); H[a][m][i] = dv;
                const float s = grp16_sum(dv * dv);
                if (c16 == 0) st2[w * 256 + tl] = s; }
    __syncthreads();
    const float gn = p.mlstm_g[h * 128 + w * 16 + c16];
#pragma unroll
    for (int a = 0; a < 4; ++a)
#pragma unroll
        for (int m = 0; m < 4; ++m)
#pragma unroll
            for (int i = 0; i < 4; ++i) { const int tl = a * 64 + m * 16 + q4e + i;
                float ss = 0.f;
#pragma unroll
                for (int ww = 0; ww < 8; ++ww) ss += st2[ww * 256 + tl];
                const float rs = 1.0f / sqrtf(ss * (1.0f / 128.f) + EPS);
                unsigned eo = ebase + (unsigned)tl * NU; asm volatile("" : "+v"(eo));
                const float z = bf2f(p.u[eo + UC_Z]);
                p.u[eo + UC_V] = f2bf(H[a][m][i] * rs * gn * silu(z));
                if (i == 3) asm volatile("" ::: "memory"); }
    __syncthreads();
}
}
#include <hip/hip_cooperative_groups.h>
namespace cg = cooperative_groups;
namespace fr {
using namespace mk;
constexpr int M = 16384, DM = 1024, DIN = 6928, NB = 4;
constexpr size_t MiB = 1u << 20;
constexpr int LDS_BYTES = 147456;
#ifndef MK_MULTI
#define MK_MULTI 0
#endif
constexpr int NPHASE = 12;
constexpr size_t WS_CTL = 0, CTL_ZERO_BYTES = 256 * 1024;
constexpr size_t WS_BAR = 16 * 1024;
constexpr size_t WS_SS = 64 * 1024;
constexpr size_t WS_LB = 256 * 1024;
constexpr size_t WS_DA = WS_LB + 4096;
constexpr size_t WS_CS = WS_DA + 2 * 16 * 16 * 128 * 4;
constexpr size_t WS_U = 1 * MiB;
constexpr size_t WS_R2 = 217 * MiB;
constexpr size_t WS_WTIN = WS_R2;
constexpr size_t WS_SA = WS_R2;
constexpr size_t WS_SC = WS_R2 + 16 * MiB;
constexpr size_t WS_WTOUT = WS_R2 + 25 * MiB;
constexpr size_t WS_KV = WS_R2 + 33 * MiB;
constexpr size_t WS_GATES = WS_R2 + 37 * MiB;
constexpr size_t WS_CSN = WS_R2 + 38 * MiB;
static_assert(WS_CSN + 1 * MiB == 256 * MiB, "ws map");
static_assert(WS_U + (size_t)M * NU * 2 == WS_R2, "u fills [1, 217) MiB");
constexpr size_t DO_XB = 0;
constexpr size_t DO_LO = 32 * MiB;
constexpr size_t DO_WTKV = 32 * MiB;
constexpr size_t DO_MEMN = 36 * MiB;

#define XB_TMO      128
#define XB_XCNT(j)  (256  + 64 * (j))
#define XB_XSUB(j)  (1280 + 64 * (j))
#define XB_XGEN(j)  (2304 + 64 * (j))
#define XB_TOP      3328
#define XB_TOPGEN   3392
#define XCD_BAR_WORDS 3456
#define XB_SPIN_CAP (1u << 18)

__device__ __forceinline__ unsigned xb_ld(unsigned* p)              { return __hip_atomic_load(p, __ATOMIC_RELAXED, __HIP_MEMORY_SCOPE_AGENT); }
__device__ __forceinline__ unsigned xb_add(unsigned* p, unsigned v) { return __hip_atomic_fetch_add(p, v, __ATOMIC_RELAXED, __HIP_MEMORY_SCOPE_AGENT); }
__device__ __forceinline__ unsigned xb_xcc_id() { return (unsigned)__builtin_amdgcn_s_getreg((3 << 11) | 20) & 0xFu; }
#define XB_SPIN(cond, bar) do { unsigned _sp = 0; while (cond) { __builtin_amdgcn_s_sleep(1); \
    if ((++_sp & 255u) == 0u) { if (xb_ld(&(bar)[XB_TMO])) break; if (_sp > XB_SPIN_CAP) { atomicAdd(&(bar)[XB_TMO], 1u); break; } } } } while (0)

struct XcdBarrier {
    unsigned* bar; unsigned x;
    volatile LAS unsigned* st;
};

__device__ __forceinline__ XcdBarrier xcd_barrier_post(unsigned* bar, volatile LAS unsigned* st) {
    XcdBarrier b; b.bar = bar; b.x = xb_xcc_id(); b.st = st;
    if (threadIdx.x == 0) (void)xb_add(&bar[XB_XCNT(b.x)], 1u);
    return b;
}
__device__ __forceinline__ void xcd_barrier_complete(unsigned* bar, unsigned x, unsigned& nloc, unsigned& nx) {
    const unsigned G = gridDim.x * gridDim.y * gridDim.z;
    unsigned sum, cnt, mine, sp = 0u;
    for (;;) {
        sum = 0u; cnt = 0u; mine = 0u;
#pragma unroll
        for (unsigned j = 0; j < 16; ++j) { const unsigned c = xb_ld(&bar[XB_XCNT(j)]); sum += c; cnt += (c > 0u) ? 1u : 0u; mine = (j == x) ? c : mine; }
        if (sum == G) break;
        __builtin_amdgcn_s_sleep(1);
        if ((++sp & 255u) == 0u) { if (xb_ld(&bar[XB_TMO])) break; if (sp > XB_SPIN_CAP) { atomicAdd(&bar[XB_TMO], 1u); break; } }
    }
    nloc = mine > 0u ? mine : 1u; nx = cnt > 0u ? cnt : 1u;
}

__device__ __forceinline__ void xcd_barrier(const XcdBarrier& b) {
    asm volatile("s_waitcnt vmcnt(0)" ::: "memory");
    __syncthreads();
    if (threadIdx.x == 0) {
        unsigned* bar = b.bar;
        __builtin_amdgcn_s_waitcnt(0);
        unsigned nloc = b.st[0], nx = b.st[1];
        if (nloc == 0u) { xcd_barrier_complete(bar, b.x, nloc, nx); b.st[0] = nloc; b.st[1] = nx; }
        const unsigned old = xb_add(&bar[XB_XSUB(b.x)], 1u);
        const unsigned gen = old / nloc;
        if (old + 1u == (gen + 1u) * nloc) {
            __builtin_amdgcn_fence(__ATOMIC_RELEASE, "agent");
            asm volatile("s_waitcnt vmcnt(0)" ::: "memory");
            const unsigned og = xb_add(&bar[XB_TOP], 1u);
            const unsigned tg = og / nx;
            if (og + 1u == (tg + 1u) * nx) xb_add(&bar[XB_TOPGEN], 1u);
            else XB_SPIN(xb_ld(&bar[XB_TOPGEN]) == tg, bar);
            __builtin_amdgcn_fence(__ATOMIC_ACQUIRE, "agent");
            xb_add(&bar[XB_XGEN(b.x)], 1u);
            asm volatile("s_waitcnt vmcnt(0)" ::: "memory");
        } else {
            XB_SPIN(xb_ld(&bar[XB_XGEN(b.x)]) == gen, bar);
            __builtin_amdgcn_fence(__ATOMIC_ACQUIRE, "agent");
            asm volatile("s_waitcnt vmcnt(0)" ::: "memory");
        }
    }
    __syncthreads();
}


struct KP {
    const float* x; const float* mem; const int* pos; const float* norm_g; const float* w_in; const float* lb_logits; const float* hgrn_g; const float* sink;
    const float* conv_w; const float* gate_b; const float* mlstm_g; const float* mem_g; const float* w_kv; const float* w_out; const float* final_g;
    float* out; unsigned char* ws; int ph_lo, ph_hi;
};

__device__ const double INVF[8] = {1.0, 0.19392274474868576, 0.03760603093086393, 0.007292664737217109, 0.001414213562373095, 0.0002742481756762073, 5.318295896944988e-05, 1.031338537721246e-05};
__device__ __forceinline__ float wave_sum(float v) {
#pragma unroll
    for (int o = 1; o < 64; o <<= 1) v += __shfl_xor(v, o);
    return v;
}
__device__ __forceinline__ int new_col_to_old(int c) {
    if (c < 512) return 0 + c;
    if (c < 1024) return 2560 + (c - 512);
    if (c < 1536) return 4352 + (c - 1024);
    if (c < 2048) return 5904 + (c - 1536);
    if (c < 2560) return 512 + (c - 2048);
    if (c < 3072) return 1024 + (c - 2560);
    if (c < 3584) return 1536 + (c - 3072);
    if (c < 4096) return 2048 + (c - 3584);
    if (c < 4224) return 3072 + (c - 4096);
    if (c < 4352) return 3200 + (c - 4224);
    if (c < 4864) return 3328 + (c - 4352);
    if (c < 5120) return 3840 + (c - 4864);
    if (c < 5376) return 4096 + (c - 5120);
    if (c < 5888) return 4864 + (c - 5376);
    if (c < 6400) return 5376 + (c - 5888);
    return 6416 + (c - 6400);
}
__device__ __forceinline__ void transpose_item(const float* W, int K, int N, bf16_t* WT, int k0, int src_col0, int dst_row0, const float* kscale, LAS float* scr, int lane) {
#pragma unroll 8
    for (int i = 0; i < 32; ++i) { const int kk = 2 * i + (lane >> 5); float v = W[(size_t)(k0 + kk) * N + src_col0 + (lane & 31)]; if (kscale) v *= kscale[k0 + kk]; scr[kk * 33 + (lane & 31)] = v; }
    asm volatile("s_waitcnt lgkmcnt(0)" ::: "memory");
    const int c = lane & 7;
#pragma unroll
    for (int j = 0; j < 4; ++j) { const int n = (lane >> 3) + 8 * j; const LAS float* s = scr + (8 * c) * 33 + n;
        u32x4 o; o.x = pk2(s[0 * 33], s[1 * 33]); o.y = pk2(s[2 * 33], s[3 * 33]); o.z = pk2(s[4 * 33], s[5 * 33]); o.w = pk2(s[6 * 33], s[7 * 33]);
        *(u32x4*)(WT + (size_t)(dst_row0 + n) * K + k0 + 8 * c) = o; }
    asm volatile("s_waitcnt lgkmcnt(0)" ::: "memory");
}
__device__ __forceinline__ void convert_wtin(const KP& a, int l, LAS unsigned char* lds, int gw, int ngw, int wave, int lane) {
    LAS float* scr = (LAS float*)(lds + wave * 8448);
    bf16_t* WT = (bf16_t*)(a.ws + WS_WTIN);
    for (int it = gw; it < 16 * 216; it += ngw) { const int kb = it / 216, nbk = it % 216;
        transpose_item(a.w_in + (size_t)l * DM * DIN, DM, DIN, WT, kb * 64, new_col_to_old(nbk * 32), nbk * 32, a.norm_g + l * DM, scr, lane); }
}
__device__ __forceinline__ void gates_block(const KP& a, int l, LAS unsigned char* lds, const bf16_t* xb, const float* ss, int blk) {
    const int tid = otid(), lane = tid & 63, w = __builtin_amdgcn_readfirstlane(tid >> 6);
    float* gates = (float*)(a.ws + WS_GATES);
    LAS bf16_t* A2 = (LAS bf16_t*)lds; LAS bf16_t* B2 = A2 + 64 * 520;
    f32x4 acc = (f32x4){0.f, 0.f, 0.f, 0.f};
    for (int kh = 0; kh < 2; ++kh) {
        for (int c = tid; c < 64 * 64; c += 512) { const int r = c >> 6, ch = c & 63;
            *(LAS u32x4*)(A2 + r * 520 + ch * 8) = *(const u32x4*)(xb + (size_t)(blk * 64 + r) * DM + kh * 512 + ch * 8); }
        for (int c = tid; c < 16 * 512; c += 512) { const int j = c & 15, k = c >> 4; const int kg = kh * 512 + k;
            B2[j * 520 + k] = f2bf(a.w_in[((size_t)l * DM + kg) * DIN + 5888 + j] * a.norm_g[l * DM + kg]); }
        __syncthreads();
        if (w < 4) mma_nt<512>(acc, A2, 520, w * 16, B2, 520, 0, lane);
        __syncthreads();
    }
    if (w < 4) {
#pragma unroll
        for (int i = 0; i < 4; ++i) { const int r = blk * 64 + w * 16 + 4 * (lane >> 4) + i; const float rs = 1.0f / sqrtf(ss[r] * (1.0f / 1024.f) + 1e-6f);
            gates[(size_t)r * 16 + (lane & 15)] = acc[i] * rs; }
    }
}

__device__ __forceinline__ void prologue(const KP& a, LAS unsigned char* lds) {
    const int tid = otid(), lane = tid & 63, wave = __builtin_amdgcn_readfirstlane(tid >> 6);
    const int G = gridDim.x, gw = blockIdx.x * 8 + wave, ngw = G * 8;
    LAS float* scr = (LAS float*)(lds + wave * 8448);
    float* ss0 = (float*)(a.ws + WS_SS);
    bf16_t* xb = (bf16_t*)((unsigned char*)a.out + DO_XB);
    for (int blk = blockIdx.x; blk < M / 64; blk += G) {
        for (int rr = wave; rr < 64; rr += 8) { const int r = blk * 64 + rr;
            const f32x4* xr = (const f32x4*)(a.x + (size_t)r * DM) + lane;
            f32x4 v[4]; float s = 0.f;
#pragma unroll
            for (int j = 0; j < 4; ++j) { v[j] = xr[64 * j]; s += (v[j][0] * v[j][0] + v[j][1] * v[j][1]) + (v[j][2] * v[j][2] + v[j][3] * v[j][3]); }
            s = wave_sum(s);
            if (lane == 0) ss0[r] = s;
            u32x2* o8 = (u32x2*)(xb + (size_t)r * DM) + lane;
#pragma unroll
            for (int j = 0; j < 4; ++j) o8[64 * j] = (u32x2){pk2(v[j][0], v[j][1]), pk2(v[j][2], v[j][3])};
        }
    }
    convert_wtin(a, 0, lds, gw, ngw, wave, lane);
    for (int it = gw; it < 2 * 32 * 32; it += ngw) { const int l = it >> 10, r = it & 1023, kb = r >> 5, nbk = r & 31;
        transpose_item(a.w_out + (size_t)l * 2048 * DM, 2048, DM, (bf16_t*)(a.ws + WS_WTOUT) + (size_t)l * DM * 2048, kb * 64, nbk * 32, nbk * 32, nullptr, scr, lane); }
    for (int it = gw; it < 2 * 16 * 32; it += ngw) { const int l = it >> 9, r = it & 511, kb = r >> 5, nbk = r & 31;
        transpose_item(a.w_kv + (size_t)l * DM * 1024, DM, 1024, (bf16_t*)((unsigned char*)a.out + DO_WTKV) + (size_t)l * 1024 * DM, kb * 64, nbk * 32, nbk * 32, nullptr, scr, lane); }
    for (int it = gw; it < 2 * 1024; it += ngw) { const int l = it >> 10, r = it & 1023;
        const f32x4* xr = (const f32x4*)(a.mem + (size_t)r * DM) + lane; const f32x4* gr = (const f32x4*)(a.mem_g + l * DM) + lane;
        f32x4 v[4]; float s = 0.f;
#pragma unroll
        for (int j = 0; j < 4; ++j) { v[j] = xr[64 * j]; s += (v[j][0] * v[j][0] + v[j][1] * v[j][1]) + (v[j][2] * v[j][2] + v[j][3] * v[j][3]); }
        const float rs = 1.0f / sqrtf(wave_sum(s) * (1.0f / 1024.f) + 1e-6f);
        u32x2* o8 = (u32x2*)((bf16_t*)((unsigned char*)a.out + DO_MEMN) + ((size_t)l * 1024 + r) * DM) + lane;
#pragma unroll
        for (int j = 0; j < 4; ++j) { const f32x4 g = gr[64 * j]; o8[64 * j] = (u32x2){pk2(v[j][0] * rs * g[0], v[j][1] * rs * g[1]), pk2(v[j][2] * rs * g[2], v[j][3] * rs * g[3])}; }
    }
    {
        float* cs = (float*)(a.ws + WS_CSN); float* sn = cs + (size_t)M * 8;
        for (int i = blockIdx.x * 512 + tid; i < M * 8; i += G * 512) { const int t = i >> 3, j = i & 7;
            const double inv = INVF[j];
            const double ang = (double)a.pos[t] * inv;
            const double kq = rint(ang * 0.15915494309189535);
            const float r = (float)fma(-kq, 1.2246467991473532e-16 * 2.0, fma(-kq, 6.283185307179586, ang));
            cs[i] = cosf(r); sn[i] = sinf(r); }
        if (blockIdx.x == 0) { float* lb = (float*)(a.ws + WS_LB);
            const float l0 = a.lb_logits[tid], l1 = a.lb_logits[512 + tid]; const float m = fmaxf(l0, l1); const float e0 = __expf(l0 - m), e1 = __expf(l1 - m);
            lb[tid] = 0.f; lb[512 + tid] = e1 / (e0 + e1); }
    }
    __syncthreads();
}

__device__ __forceinline__ MP make_mp(const KP& a, int l) {
    MP p;
    p.u = (bf16_t*)(a.ws + WS_U); p.gates = (const float*)(a.ws + WS_GATES); p.kv = (const bf16_t*)(a.ws + WS_KV) + (size_t)l * 1024 * 1024;
    p.cs = (const float*)(a.ws + WS_CSN); p.sn = p.cs + (size_t)M * 8; p.lb = (const float*)(a.ws + WS_LB) + l * 512;
    p.hgrn_g = a.hgrn_g + l * 512; p.sink = a.sink + l * 8; p.conv_w = a.conv_w + (size_t)l * 5 * 512; p.gate_b = a.gate_b + l * 16; p.mlstm_g = a.mlstm_g + l * 512;
    p.SA = (bf16_t*)(a.ws + WS_SA); p.DA = (float*)(a.ws + WS_DA); p.SC = (bf16_t*)(a.ws + WS_SC); p.CS = (float*)(a.ws + WS_CS); p.nb = NB;
    return p;
}

__device__ __forceinline__ void phase_g1(const KP& a, int l, LAS unsigned char* lds) {
    const int G = gridDim.x;
    const bf16_t* xb = (const bf16_t*)((unsigned char*)a.out + DO_XB);
    const float* ss = (const float*)(a.ws + WS_SS) + (size_t)l * M;
    for (int blk = blockIdx.x; blk < M / 64; blk += G) gates_block(a, l, lds, xb, ss, blk);
    __syncthreads();
    {
        pg8::Gemm g{xb, (const bf16_t*)(a.ws + WS_WTIN), M, NU, DM, DM};
        pg8::StaticOrder S; S.init(M, NU, G, (int)blockIdx.x);
        pg8::EpiIn E{(bf16_t*)(a.ws + WS_U), NU, ss};
        pg8::gemm_phase<pg8::EpiIn, pg8::StaticOrder, true, true>((PG8_LAS unsigned char*)lds, g, S, E);
    }
    if (l == 0) {
        __syncthreads();
        pg8::Gemm g{(const bf16_t*)((unsigned char*)a.out + DO_MEMN), (const bf16_t*)((unsigned char*)a.out + DO_WTKV), 2048, 2048, DM, DM};
        pg8::KvOrder S{(int)blockIdx.x, G - 64 > 0 ? G - 64 : 0};
        pg8::EpiKv E{(bf16_t*)(a.ws + WS_KV)};
        pg8::gemm_phase<pg8::EpiKv, pg8::KvOrder, false, true>((PG8_LAS unsigned char*)lds, g, S, E);
    }
}
__device__ __forceinline__ void phase_g2(const KP& a, int l, LAS unsigned char* lds) {
    const int tid = otid(), lane = tid & 63, wave = __builtin_amdgcn_readfirstlane(tid >> 6);
    const int G = gridDim.x;
    if (l == 0) { convert_wtin(a, 1, lds, blockIdx.x * 8 + wave, G * 8, wave, lane); __syncthreads(); }
    pg8::Gemm g{(const bf16_t*)(a.ws + WS_U), (const bf16_t*)(a.ws + WS_WTOUT) + (size_t)l * DM * 2048, M, DM, 2048, NU};
    pg8::StaticOrder S; S.init(M, DM, G, (int)blockIdx.x);
    bf16_t* hi = (bf16_t*)((unsigned char*)a.out + DO_XB); bf16_t* lo = (bf16_t*)((unsigned char*)a.out + DO_LO);
    float* ssn = (float*)(a.ws + WS_SS) + (size_t)(l + 1) * M;
    if (l == 0) { pg8::EpiOut<0> E{a.x, hi, lo, nullptr, 0, 0, ssn}; pg8::gemm_phase<pg8::EpiOut<0>, pg8::StaticOrder, false, true>((PG8_LAS unsigned char*)lds, g, S, E); }
    else { pg8::EpiOut<1> E{nullptr, hi, lo, (float*)(a.ws + WS_U), NU / 2, 1024, ssn}; pg8::gemm_phase<pg8::EpiOut<1>, pg8::StaticOrder, false, true>((PG8_LAS unsigned char*)lds, g, S, E); }
}
__device__ __forceinline__ void phase_m1(const MP& p, LAS unsigned char* lds) {
    const int nb = p.nb, G = gridDim.x;
    const int nB = nb * 128, nA = nb * 128, nC = nb * 128, nD = nb * 256;
    for (int it = blockIdx.x; it < nB + nA + nC + nD; it += G) {
        if (it < nB) b_item(p, lds, it);
        else if (it < nB + nA) a_pass1(p, lds, it - nB);
        else if (it < nB + nA + nC) c_pass1(p, lds, it - nB - nA);
        else d_item(p, lds, it - nB - nA - nC);
    }
}
__device__ __forceinline__ void phase_m2(const MP& p) {
    const int nb = p.nb, G = gridDim.x;
    const int nAu = nb * 8 * 4096, nCu = nb * 8 * 2304;
    for (int uu = blockIdx.x * 512 + otid(); uu < nAu + nCu; uu += G * 512) { if (uu < nAu) a_scan_unit(p, uu); else c_scan_unit(p, uu - nAu); }
}
__device__ __forceinline__ void phase_m3(const MP& p, LAS unsigned char* lds) {
    const int nb = p.nb, G = gridDim.x;
    for (int it = blockIdx.x; it < nb * 128; it += G) { if (it < nb * 64) a_pass3(p, lds, it); else c_pass3(p, lds, it - nb * 64); }
}
__device__ __forceinline__ void phase_final(const KP& a) {
    const int tid = otid(), lane = tid & 63, wave = __builtin_amdgcn_readfirstlane(tid >> 6);
    const int gw = blockIdx.x * 8 + wave, ngw = gridDim.x * 8;
    const float* ss2 = (const float*)(a.ws + WS_SS) + (size_t)2 * M;
    const float* x2 = (const float*)(a.ws + WS_U);
    for (int r = gw; r < M; r += ngw) {
        const float rs = 1.0f / sqrtf(ss2[r] * (1.0f / 1024.f) + 1e-6f);
        const f32x4* xr = (const f32x4*)(x2 + (size_t)r * (NU / 2) + 1024) + lane; const f32x4* gr = (const f32x4*)a.final_g + lane;
        f32x4* orow = (f32x4*)(a.out + (size_t)r * DM) + lane;
#pragma unroll
        for (int j = 0; j < 4; ++j) { const f32x4 v = xr[64 * j], g = gr[64 * j]; orow[64 * j] = v * rs * g; }
    }
}

__global__ void __launch_bounds__(512, 2) mega_fwd(KP a) {
    extern __shared__ __attribute__((aligned(16))) unsigned char lds_raw[];
    LAS unsigned char* lds = (LAS unsigned char*)lds_raw;
#if !MK_MULTI
    cg::grid_group grid = cg::this_grid();
    volatile LAS unsigned* xst = (volatile LAS unsigned*)(lds + LDS_BYTES - 16);
    if (threadIdx.x < 4) xst[threadIdx.x] = 0u;
    __syncthreads();
    XcdBarrier xbar = xcd_barrier_post((unsigned*)(a.ws + WS_BAR), xst);
#define GRID_SYNC() do { if (ph == 0) grid.sync(); else xcd_barrier(xbar); } while (0)
#else
#define GRID_SYNC() do {} while (0)
#endif
    for (int ph = a.ph_lo; ph < a.ph_hi; ++ph) {
        if (ph == 0) prologue(a, lds);
        else if (ph == 11) phase_final(a);
        else {
            const int l = (ph - 1) / 5, s = (ph - 1) % 5;
            if (s == 0) phase_g1(a, l, lds);
            else if (s == 4) phase_g2(a, l, lds);
            else { const MP p = make_mp(a, l); if (s == 1) phase_m1(p, lds); else if (s == 2) phase_m2(p); else phase_m3(p, lds); }
        }
        if (ph + 1 < a.ph_hi) GRID_SYNC();
    }
}
}

extern "C" void kernel_launch(void* const* d_in, const int* in_sizes, int n_in,
                              void* d_out, int out_size, void* d_ws, size_t ws_size,
                              hipStream_t stream) {
    using namespace fr;
    static int grid_blocks = 0;
    if (!grid_blocks) {
        int dev = 0, cus = 0, per_cu = 0;
        (void)hipGetDevice(&dev);
        (void)hipDeviceGetAttribute(&cus, hipDeviceAttributeMultiprocessorCount, dev);
        (void)hipFuncSetAttribute((const void*)mega_fwd, hipFuncAttributeMaxDynamicSharedMemorySize, LDS_BYTES);
        (void)hipOccupancyMaxActiveBlocksPerMultiprocessor(&per_cu, (const void*)mega_fwd, 512, LDS_BYTES);
        if (per_cu < 1) per_cu = 1;
        grid_blocks = cus * (per_cu > 1 ? 1 : per_cu);
    }
    KP a{};
    a.x = (const float*)d_in[0]; a.mem = (const float*)d_in[1]; a.pos = (const int*)d_in[2]; a.norm_g = (const float*)d_in[3]; a.w_in = (const float*)d_in[4];
    a.lb_logits = (const float*)d_in[5]; a.hgrn_g = (const float*)d_in[6]; a.sink = (const float*)d_in[7]; a.conv_w = (const float*)d_in[8]; a.gate_b = (const float*)d_in[9];
    a.mlstm_g = (const float*)d_in[10]; a.mem_g = (const float*)d_in[11]; a.w_kv = (const float*)d_in[12]; a.w_out = (const float*)d_in[13]; a.final_g = (const float*)d_in[14];
    a.out = (float*)d_out; a.ws = (unsigned char*)d_ws;
    (void)hipMemsetAsync((char*)d_ws + WS_CTL, 0, CTL_ZERO_BYTES, stream);
#if MK_MULTI
    for (int ph = 0; ph < NPHASE; ++ph) { a.ph_lo = ph; a.ph_hi = ph + 1; hipLaunchKernelGGL(mega_fwd, dim3(grid_blocks), dim3(512), LDS_BYTES, stream, a); }
#else
    a.ph_lo = 0; a.ph_hi = NPHASE;
    void* args[] = {&a};
    (void)hipLaunchCooperativeKernel((const void*)mega_fwd, dim3(grid_blocks), dim3(512), args, LDS_BYTES, stream);
#endif
}
```

```cpp
#include <hip/hip_runtime.h>
#include <math.h>
namespace pg8 {
#define PG8_LAS __attribute__((address_space(3)))
typedef unsigned short bf16_t;
typedef short bf16x8 __attribute__((ext_vector_type(8)));
typedef float f32x4 __attribute__((ext_vector_type(4)));
typedef unsigned u32x4 __attribute__((ext_vector_type(4)));
constexpr int BM = 256, BK = 64, HALF = 128, HTB = HALF * BK * 2  , STAGE_BYTES = 8 * HTB, NXCD = 8, WGM = 8;

__host__ __device__ __forceinline__ int lds_byte(int r, int c) { const int st = (r >> 4) * 2 + (c >> 5), rr = r & 15, cc = c & 31, ob = rr * 64 + cc * 2; return st * 1024 + (ob ^ (((ob >> 9) & 1) << 5)); }
__host__ __device__ __forceinline__ void stage_rc(int b, int& R, int& C) { const int st = b / 1024, sb = b % 1024, swz = sb ^ (((sb >> 9) & 1) << 5); R = (st >> 1) * 16 + swz / 64; C = (st & 1) * 32 + (swz % 64) / 2; }
__host__ __device__ __forceinline__ int perm32(int rho) { const int n = rho >> 4, i = rho & 15; return 8 * (i >> 2) + 4 * n + (i & 3); }

struct Unit { int pm, pn; };
struct Gemm { const bf16_t* A; const bf16_t* Bt; int M, N, K, lda; };

struct StaticOrder {
    int nM, nN, nwg, G, c;
    __host__ __device__ void init(int M, int N, int G_, int c_) { nM = M / BM; nN = N / BM; nwg = nM * nN; G = G_; c = c_; }
    __host__ __device__ bool next(int i, Unit& u) const {
        const long L = (long)i * G + c; if (L >= nwg) return false;
        int wgid = (int)L; { const int q = nwg / NXCD, r = nwg % NXCD, xcd = wgid % NXCD, off = wgid / NXCD; wgid = (xcd < r ? xcd * (q + 1) : r * (q + 1) + (xcd - r) * q) + off; }
        const int nig = WGM * nN, gid = wgid / nig, fm = gid * WGM, gsz = (nM - fm) < WGM ? (nM - fm) : WGM;
        u.pm = fm + ((wgid % nig) % gsz); u.pn = (wgid % nig) / gsz; return true;
    }
    __device__ __forceinline__ void a_ready(const Unit&) const {}
    __device__ __forceinline__ void done(const Unit&) const {}
};

__device__ __forceinline__ unsigned cvt_pk_bf16(float lo, float hi) { unsigned r; asm volatile("v_cvt_pk_bf16_f32 %0, %1, %2" : "=v"(r) : "v"(lo), "v"(hi)); return r; }

__device__ __forceinline__ float bf2f_(unsigned h16) { return __uint_as_float(h16 << 16); }
struct EpiIn {
    static constexpr bool PERM = true, AFTER_DRAIN = false;
    bf16_t* O; int ldc; const float* ss;
    __device__ __forceinline__ void operator()(const f32x4 (&acc)[2][2][4][2], const Unit& u, int wr, int wc, int fr, int fq) const {
        const int row0 = u.pm * BM + wr * 64 + fr; const int col0 = u.pn * BM + wc * 32 + 8 * fq;
#pragma unroll
        for (int ai = 0; ai < 2; ++ai)
#pragma unroll
            for (int m = 0; m < 4; ++m) { const int r = row0 + ai * HALF + m * 16; const float rs = 1.0f / sqrtf(ss[r] * (1.0f / 1024.f) + 1e-6f);
                bf16_t* rowp = O + (size_t)r * ldc + col0;
#pragma unroll
                for (int bj = 0; bj < 2; ++bj) { const f32x4 v0 = acc[ai][bj][m][0] * rs, v1 = acc[ai][bj][m][1] * rs;
                    u32x4 w; w.x = cvt_pk_bf16(v0[0], v0[1]); w.y = cvt_pk_bf16(v0[2], v0[3]); w.z = cvt_pk_bf16(v1[0], v1[1]); w.w = cvt_pk_bf16(v1[2], v1[3]);
                    *(u32x4*)(rowp + bj * HALF) = w; } }
    }
};
struct EpiKv {
    static constexpr bool PERM = true, AFTER_DRAIN = false;
    bf16_t* O;
    __device__ __forceinline__ void operator()(const f32x4 (&acc)[2][2][4][2], const Unit& u, int wr, int wc, int fr, int fq) const {
        const int l = u.pm >> 2, rl0 = (u.pm & 3) * BM + wr * 64 + fr; const int col0 = (u.pn & 3) * BM + wc * 32 + 8 * fq;
        bf16_t* Ol = O + (size_t)l * 1024 * 1024;
#pragma unroll
        for (int ai = 0; ai < 2; ++ai)
#pragma unroll
            for (int m = 0; m < 4; ++m) { const int r = rl0 + ai * HALF + m * 16;
#pragma unroll
                for (int bj = 0; bj < 2; ++bj) { const f32x4 v0 = acc[ai][bj][m][0], v1 = acc[ai][bj][m][1]; const int c = col0 + bj * HALF;
                    u32x4 w; w.x = cvt_pk_bf16(v0[0], v0[1]); w.y = cvt_pk_bf16(v0[2], v0[3]); w.z = cvt_pk_bf16(v1[0], v1[1]); w.w = cvt_pk_bf16(v1[2], v1[3]);
                    if (c < 512) *(u32x4*)(Ol + (size_t)r * 512 + c) = w;
                    else { bf16_t* vt = Ol + 512 * 1024 + ((size_t)(r >> 8) * 512 + (c - 512)) * 256 + (r & 255);
                        vt[0 * 256] = (bf16_t)(w.x & 0xffffu); vt[1 * 256] = (bf16_t)(w.x >> 16); vt[2 * 256] = (bf16_t)(w.y & 0xffffu); vt[3 * 256] = (bf16_t)(w.y >> 16);
                        vt[4 * 256] = (bf16_t)(w.z & 0xffffu); vt[5 * 256] = (bf16_t)(w.z >> 16); vt[6 * 256] = (bf16_t)(w.w & 0xffffu); vt[7 * 256] = (bf16_t)(w.w >> 16); } } }
    }
};
typedef unsigned u32x2e __attribute__((ext_vector_type(2)));
template <int LAYER> struct EpiOut {
    static constexpr bool PERM = true, AFTER_DRAIN = false;
    const float* x0; bf16_t* hi; bf16_t* lo; float* x2; int xs, xo; float* ssn; int dry;
    __device__ __forceinline__ void operator()(const f32x4 (&acc)[2][2][4][2], const Unit& u, int wr, int wc, int fr, int fq) const {
        const int row0 = u.pm * BM + wr * 64 + fr; const int col0 = u.pn * BM + wc * 32 + 8 * fq;
#pragma unroll
        for (int ai = 0; ai < 2; ++ai)
#pragma unroll
            for (int m = 0; m < 4; ++m) { const int r = row0 + ai * HALF + m * 16; float part = 0.f;
#pragma unroll
                for (int bj = 0; bj < 2; ++bj) { const int c = col0 + bj * HALF; const size_t e = (size_t)r * 1024 + c;
                    f32x4 xa, xb;
                    if (LAYER == 0) { xa = *(const f32x4*)(x0 + e); xb = *(const f32x4*)(x0 + e + 4); }
                    else { const u32x4 h = *(const u32x4*)(hi + e), l = *(const u32x4*)(lo + e);
                        xa = (f32x4){bf2f_(h.x & 0xffffu) + bf2f_(l.x & 0xffffu), bf2f_(h.x >> 16) + bf2f_(l.x >> 16), bf2f_(h.y & 0xffffu) + bf2f_(l.y & 0xffffu), bf2f_(h.y >> 16) + bf2f_(l.y >> 16)};
                        xb = (f32x4){bf2f_(h.z & 0xffffu) + bf2f_(l.z & 0xffffu), bf2f_(h.z >> 16) + bf2f_(l.z >> 16), bf2f_(h.w & 0xffffu) + bf2f_(l.w & 0xffffu), bf2f_(h.w >> 16) + bf2f_(l.w >> 16)}; }
                    const f32x4 va = xa + acc[ai][bj][m][0], vb = xb + acc[ai][bj][m][1];
                    part += ((va[0] * va[0] + va[1] * va[1]) + (va[2] * va[2] + va[3] * va[3])) + ((vb[0] * vb[0] + vb[1] * vb[1]) + (vb[2] * vb[2] + vb[3] * vb[3]));
                    if (LAYER == 0) {
                        u32x4 hw; hw.x = cvt_pk_bf16(va[0], va[1]); hw.y = cvt_pk_bf16(va[2], va[3]); hw.z = cvt_pk_bf16(vb[0], vb[1]); hw.w = cvt_pk_bf16(vb[2], vb[3]);
                        const f32x4 da = va - (f32x4){bf2f_(hw.x & 0xffffu), bf2f_(hw.x >> 16), bf2f_(hw.y & 0xffffu), bf2f_(hw.y >> 16)};
                        const f32x4 db = vb - (f32x4){bf2f_(hw.z & 0xffffu), bf2f_(hw.z >> 16), bf2f_(hw.w & 0xffffu), bf2f_(hw.w >> 16)};
                        u32x4 lw; lw.x = cvt_pk_bf16(da[0], da[1]); lw.y = cvt_pk_bf16(da[2], da[3]); lw.z = cvt_pk_bf16(db[0], db[1]); lw.w = cvt_pk_bf16(db[2], db[3]);
                        if (!dry) { *(u32x4*)(hi + e) = hw; *(u32x4*)(lo + e) = lw; }
                    } else { if (!dry) { *(f32x4*)(x2 + (size_t)r * xs + xo + c) = va; *(f32x4*)(x2 + (size_t)r * xs + xo + c + 4) = vb; } } }
                part += __shfl_xor(part, 16); part += __shfl_xor(part, 32);
                if (fq == 0 && !dry) atomicAdd(ssn + r, part); }
    }
};
struct KvOrder {
    int c, c0;
    __device__ bool next(int i, Unit& u) const { const int t = c - c0; if (i != 0 || t < 0 || t >= 32) return false; const int l = t >> 4; u.pm = l * 4 + ((t >> 2) & 3); u.pn = l * 4 + (t & 3); return true; }
    __device__ __forceinline__ void a_ready(const Unit&) const {}
    __device__ __forceinline__ void done(const Unit&) const {}
};

template <class Epi, class Sched, bool ALIGN_EPI = false, bool SP2 = false>
__device__ __forceinline__ void gemm_phase(PG8_LAS unsigned char* lds, const Gemm g, const Sched& S, const Epi& E) {
    int tid = threadIdx.x; asm volatile("" : "+v"(tid)); const int wid = __builtin_amdgcn_readfirstlane(tid >> 6), lane = tid & 63, wr = wid >> 2, wc = wid & 3, fr = lane & 15, fq = lane >> 4;
    const int K = g.K, nt = K / BK;
    unsigned voffA[2], voffB[2];
#pragma unroll
    for (int i = 0; i < 2; ++i) { int R, C; stage_rc(tid * 16 + i * 8192, R, C); const int Rb = Epi::PERM ? ((R & ~31) + perm32(R & 31)) : R;
        voffA[i] = (unsigned)(R * g.lda + C) * 2u; voffB[i] = (unsigned)(Rb * K + C) * 2u; }
    const size_t kstep = (size_t)(BK * 2);
    const size_t hstep = (size_t)HALF * K * 2, hstepA = (size_t)HALF * g.lda * 2;
    const size_t tstep = 2 * hstep, tstepA = 2 * hstepA;
    const unsigned ldsw = (unsigned)wid * 1024u;
    const int aoff = lds_byte(wr * 64 + fr, fq * 8), boff = lds_byte(wc * 32 + fr, fq * 8);
#define PG8_SA(b, h) (((b) * 2 + (h)) * HTB)
#define PG8_SB(b, h) ((4 + (b) * 2 + (h)) * HTB)
#define PG8_STAGE(bufoff, gbase, voff) do { _Pragma("unroll") for (int _i = 0; _i < 2; ++_i) \
        __builtin_amdgcn_global_load_lds((const unsigned*)((const char*)(gbase) + (voff)[_i]), (PG8_LAS unsigned*)(lds + (bufoff) + ldsw + _i * 8192), 16, 0, 0); } while (0)
#define PG8_LDA(dst, b, h) do { _Pragma("unroll") for (int m = 0; m < 4; ++m) _Pragma("unroll") for (int k = 0; k < 2; ++k) dst[m][k] = *(const PG8_LAS bf16x8*)(lds + PG8_SA(b, h) + aoff + m * 2048 + k * 1024); } while (0)
#define PG8_LDB(dst, b, h) do { _Pragma("unroll") for (int n = 0; n < 2; ++n) _Pragma("unroll") for (int k = 0; k < 2; ++k) dst[n][k] = *(const PG8_LAS bf16x8*)(lds + PG8_SB(b, h) + boff + n * 2048 + k * 1024); } while (0)
#define PG8_MMA(ai, bj, At, Bt) do { __builtin_amdgcn_s_setprio(1); _Pragma("unroll") for (int m = 0; m < 4; ++m) _Pragma("unroll") for (int n = 0; n < 2; ++n) _Pragma("unroll") for (int k = 0; k < 2; ++k) \
        acc[ai][bj][m][n] = __builtin_amdgcn_mfma_f32_16x16x32_bf16(Bt[n][k], At[m][k], acc[ai][bj][m][n], 0, 0, 0); __builtin_amdgcn_s_setprio(0); } while (0)
#define PG8_WAIT_V(n) asm volatile("s_waitcnt vmcnt(" #n ")" ::: "memory")
#define PG8_WAIT_L(n) asm volatile("s_waitcnt lgkmcnt(" #n ")" ::: "memory")
#define PG8_BAR __builtin_amdgcn_s_barrier()
#define PG8_SCHED __builtin_amdgcn_sched_barrier(0)
    Unit cur, nxt; int ui = 0;
    if (!S.next(0, cur)) return;
    f32x4 acc[2][2][4][2];
#pragma unroll
    for (int a = 0; a < 2; ++a)
#pragma unroll
        for (int b = 0; b < 2; ++b)
#pragma unroll
            for (int m = 0; m < 4; ++m)
#pragma unroll
                for (int n = 0; n < 2; ++n) acc[a][b][m][n] = (f32x4){0.f, 0.f, 0.f, 0.f};
    bf16x8 At[4][2], B0[2][2], B1[2][2];
    const char* cA = (const char*)g.A + (size_t)cur.pm * tstepA; const char* cB = (const char*)g.Bt + (size_t)cur.pn * tstep;
    S.a_ready(cur);
    if constexpr (SP2) {
        PG8_STAGE(PG8_SB(0, 0), cB, voffB); PG8_STAGE(PG8_SB(0, 1), cB + hstep, voffB); PG8_STAGE(PG8_SA(0, 0), cA, voffA); PG8_STAGE(PG8_SA(0, 1), cA + hstepA, voffA);
        if (wr == 1) PG8_BAR;
        PG8_WAIT_V(2); PG8_BAR;
        PG8_STAGE(PG8_SB(1, 0), cB + kstep, voffB); PG8_STAGE(PG8_SA(1, 0), cA + kstep, voffA); PG8_STAGE(PG8_SB(1, 1), cB + hstep + kstep, voffB);
        PG8_WAIT_V(6); PG8_BAR;
    } else {
        PG8_STAGE(PG8_SB(0, 0), cB, voffB); PG8_STAGE(PG8_SA(0, 0), cA, voffA); PG8_STAGE(PG8_SB(0, 1), cB + hstep, voffB); PG8_STAGE(PG8_SA(0, 1), cA + hstepA, voffA);
        if (wr == 1) PG8_BAR;
        PG8_WAIT_V(4); PG8_BAR;
        PG8_STAGE(PG8_SB(1, 0), cB + kstep, voffB); PG8_STAGE(PG8_SA(1, 0), cA + kstep, voffA); PG8_STAGE(PG8_SB(1, 1), cB + hstep + kstep, voffB);
        PG8_WAIT_V(6); PG8_BAR;
    }
    for (;;) {
        const bool has_next = S.next(ui + 1, nxt);
        const char* nA = has_next ? (const char*)g.A + (size_t)nxt.pm * tstepA : cA; const char* nB = has_next ? (const char*)g.Bt + (size_t)nxt.pn * tstep : cB;
        for (int t = 0; t < nt; t += 2) {
            const bool last = (t == nt - 2);
            const char* a1 = cA + (size_t)(t + 1) * kstep;
            const char* a2 = last ? nA : cA + (size_t)(t + 2) * kstep; const char* b2 = last ? nB : cB + (size_t)(t + 2) * kstep;
            const char* a3 = a2 + kstep; const char* b3 = b2 + kstep;
            if (last && has_next) S.a_ready(nxt);
            if constexpr (SP2) {
            PG8_LDB(B0, 0, 0); PG8_LDB(B1, 0, 1); PG8_SCHED; PG8_LDA(At, 0, 0); PG8_STAGE(PG8_SA(1, 1), a1 + hstepA, voffA);
            PG8_WAIT_V(8); PG8_WAIT_L(0); PG8_BAR; PG8_MMA(0, 0, At, B0); PG8_MMA(0, 1, At, B1); PG8_BAR; PG8_SCHED;
            PG8_LDA(At, 0, 1); PG8_STAGE(PG8_SB(0, 0), b2, voffB); PG8_STAGE(PG8_SB(0, 1), b2 + hstep, voffB); PG8_STAGE(PG8_SA(0, 0), a2, voffA);
            PG8_WAIT_V(8); PG8_WAIT_L(0); PG8_BAR; PG8_MMA(1, 0, At, B0); PG8_MMA(1, 1, At, B1); PG8_BAR; PG8_SCHED;
            PG8_LDB(B0, 1, 0); PG8_LDB(B1, 1, 1); PG8_SCHED; PG8_LDA(At, 1, 0); PG8_STAGE(PG8_SA(0, 1), a2 + hstepA, voffA);
            PG8_WAIT_V(8); PG8_WAIT_L(0); PG8_BAR; PG8_MMA(0, 0, At, B0); PG8_MMA(0, 1, At, B1); PG8_BAR; PG8_SCHED;
            PG8_LDA(At, 1, 1); PG8_STAGE(PG8_SB(1, 0), b3, voffB); PG8_STAGE(PG8_SB(1, 1), b3 + hstep, voffB); PG8_STAGE(PG8_SA(1, 0), a3, voffA);
            PG8_WAIT_V(8); PG8_WAIT_L(0); PG8_BAR; PG8_MMA(1, 0, At, B0); PG8_MMA(1, 1, At, B1); PG8_BAR; PG8_SCHED;
            } else {
            PG8_LDB(B0, 0, 0); PG8_SCHED; PG8_LDA(At, 0, 0); PG8_STAGE(PG8_SA(1, 1), a1 + hstepA, voffA);
            PG8_WAIT_L(8); PG8_BAR; PG8_WAIT_L(0); PG8_MMA(0, 0, At, B0); PG8_BAR; PG8_SCHED;
            PG8_LDB(B1, 0, 1); PG8_STAGE(PG8_SB(0, 0), b2, voffB);
            PG8_BAR; PG8_WAIT_L(0); PG8_MMA(0, 1, At, B1); PG8_BAR;
            PG8_LDA(At, 0, 1); PG8_STAGE(PG8_SA(0, 0), a2, voffA);
            PG8_BAR; PG8_WAIT_L(0); PG8_MMA(1, 0, At, B0); PG8_BAR; PG8_SCHED;
            PG8_STAGE(PG8_SB(0, 1), b2 + hstep, voffB);
            PG8_WAIT_V(6); PG8_BAR; PG8_MMA(1, 1, At, B1); PG8_BAR;
            PG8_LDB(B0, 1, 0); PG8_SCHED; PG8_LDA(At, 1, 0); PG8_STAGE(PG8_SA(0, 1), a2 + hstepA, voffA);
            PG8_WAIT_L(8); PG8_BAR; PG8_WAIT_L(0); PG8_MMA(0, 0, At, B0); PG8_BAR; PG8_SCHED;
            PG8_LDB(B1, 1, 1); PG8_STAGE(PG8_SB(1, 0), b3, voffB);
            PG8_BAR; PG8_WAIT_L(0); PG8_MMA(0, 1, At, B1); PG8_BAR;
            PG8_LDA(At, 1, 1); PG8_STAGE(PG8_SA(1, 0), a3, voffA);
            PG8_BAR; PG8_WAIT_L(0); PG8_MMA(1, 0, At, B0); PG8_BAR; PG8_SCHED;
            PG8_STAGE(PG8_SB(1, 1), b3 + hstep, voffB);
            PG8_WAIT_V(6); PG8_BAR; PG8_MMA(1, 1, At, B1); PG8_BAR;
            }
        }
        if constexpr (ALIGN_EPI) { if (wr == 0) PG8_BAR; }
        if constexpr (!Epi::AFTER_DRAIN) { E(acc, cur, wr, wc, fr, fq); S.done(cur); }
        if (!has_next) break;
#pragma unroll
        for (int a = 0; a < 2; ++a)
#pragma unroll
            for (int b = 0; b < 2; ++b)
#pragma unroll
                for (int m = 0; m < 4; ++m)
#pragma unroll
                    for (int n = 0; n < 2; ++n) acc[a][b][m][n] = (f32x4){0.f, 0.f, 0.f, 0.f};
        cur = nxt; cA = nA; cB = nB; ++ui;
        if constexpr (ALIGN_EPI) { if (wr == 1) PG8_BAR; }
    }
    PG8_WAIT_V(0);
    if constexpr (!ALIGN_EPI) { if (wr == 0) PG8_BAR; }
    PG8_BAR;
    if constexpr (Epi::AFTER_DRAIN) { E.fused(acc, cur, wr, wc, fr, fq, lds, wid, lane); S.done(cur); }
#undef PG8_SA
#undef PG8_SB
#undef PG8_STAGE
#undef PG8_LDA
#undef PG8_LDB
#undef PG8_MMA
#undef PG8_WAIT_V
#undef PG8_WAIT_L
#undef PG8_BAR
#undef PG8_SCHED
}
}
namespace mk {
#define LAS __attribute__((address_space(3)))
typedef unsigned short bf16_t;
typedef short bf16x8 __attribute__((ext_vector_type(8)));
typedef float f32x4 __attribute__((ext_vector_type(4)));
typedef unsigned u32x4 __attribute__((ext_vector_type(4)));
typedef unsigned u32x2 __attribute__((ext_vector_type(2)));

constexpr int SEQ = 4096, NU = 6912;
constexpr float EPS = 1e-6f;
constexpr int UA_Q = 0, UB_Q = 512, UC_V = 1024, UD_Q = 1536, UA_I = 2048, UA_FF = 2560, UA_FB = 3072, UA_Z = 3584;
constexpr int UB_K = 4096, UB_V = 4224, UB_Z = 4352, UC_Q = 4864, UC_K = 5120, UC_O = 5376, UC_Z = 5888, UD_Z = 6400;
constexpr int NSC = 16;
constexpr int SA_ELEMS = 128 * 128;
constexpr int SC_ROWS = 144, SC_ELEMS = SC_ROWS * 64;

struct MP {
    bf16_t* u;
    const float* gates;
    const bf16_t* kv;
    const float* cs; const float* sn;
    const float* lb;
    const float* hgrn_g; const float* sink; const float* conv_w; const float* gate_b; const float* mlstm_g;
    bf16_t* SA; float* DA;
    bf16_t* SC; float* CS;
    int nb;
};

__device__ __forceinline__ int otid() { int t = threadIdx.x; asm volatile("" : "+v"(t)); return t; }
#define UP(p, e) ((bf16_t*)((char*)(p).u + (size_t)(((unsigned)(e)) << 1)))
__device__ __forceinline__ float bf2f(unsigned short h) { return __uint_as_float((unsigned)h << 16); }
typedef float f32x2_t __attribute__((ext_vector_type(2))); typedef __bf16 bf16x2_t __attribute__((ext_vector_type(2)));
__device__ __forceinline__ unsigned pk2(float lo, float hi) { f32x2_t v = {lo, hi}; bf16x2_t b = __builtin_convertvector(v, bf16x2_t); return __builtin_bit_cast(unsigned, b); }
__device__ __forceinline__ unsigned short f2bf(float f) { return (unsigned short)(pk2(f, 0.f) & 0xffffu); }
__device__ __forceinline__ float sigm(float x) { return __builtin_amdgcn_rcpf(1.0f + __expf(-x)); }
__device__ __forceinline__ float silu(float x) { return x * __builtin_amdgcn_rcpf(1.0f + __expf(-x)); }
__device__ __forceinline__ float frsqrt(float x) { return __builtin_amdgcn_rsqf(x); }

template <int K>
__device__ __forceinline__ void mma_nt(f32x4& acc, const LAS bf16_t* A, int lda, int m0, const LAS bf16_t* Bt, int ldb, int n0, int lane) {
    const LAS bf16_t* ap = A + (m0 + (lane & 15)) * lda + 8 * (lane >> 4);
    const LAS bf16_t* bp = Bt + (n0 + (lane & 15)) * ldb + 8 * (lane >> 4);
#pragma unroll
    for (int k0 = 0; k0 < K; k0 += 32) {
        const bf16x8 a = *(const LAS bf16x8*)(ap + k0);
        const bf16x8 b = *(const LAS bf16x8*)(bp + k0);
        acc = __builtin_amdgcn_mfma_f32_16x16x32_bf16(a, b, acc, 0, 0, 0);
    }
}
template <int K>
__device__ __forceinline__ void ld_frags(bf16x8 (&f)[K / 32], const LAS bf16_t* T, int ld, int r0, int lane) {
    const LAS bf16_t* q = T + (r0 + (lane & 15)) * ld + 8 * (lane >> 4);
#pragma unroll
    for (int k = 0; k < K / 32; ++k) f[k] = *(const LAS bf16x8*)(q + 32 * k);
}
template <int K>
__device__ __forceinline__ void mma_fb(f32x4& acc, const LAS bf16_t* A, int lda, int m0, const bf16x8 (&b)[K / 32], int lane) {
    const LAS bf16_t* ap = A + (m0 + (lane & 15)) * lda + 8 * (lane >> 4);
#pragma unroll
    for (int k = 0; k < K / 32; ++k) { const bf16x8 a = *(const LAS bf16x8*)(ap + 32 * k); acc = __builtin_amdgcn_mfma_f32_16x16x32_bf16(a, b[k], acc, 0, 0, 0); }
}
template <int K>
__device__ __forceinline__ void mma_fa(f32x4& acc, const bf16x8 (&a)[K / 32], const LAS bf16_t* Bt, int ldb, int n0, int lane) {
    const LAS bf16_t* bp = Bt + (n0 + (lane & 15)) * ldb + 8 * (lane >> 4);
#pragma unroll
    for (int k = 0; k < K / 32; ++k) { const bf16x8 b = *(const LAS bf16x8*)(bp + 32 * k); acc = __builtin_amdgcn_mfma_f32_16x16x32_bf16(a[k], b, acc, 0, 0, 0); }
}
__device__ __forceinline__ float dpp_sum16(float v) {
    v += __builtin_bit_cast(float, __builtin_amdgcn_mov_dpp(__builtin_bit_cast(int, v), 0xB1, 0xF, 0xF, true));
    v += __builtin_bit_cast(float, __builtin_amdgcn_mov_dpp(__builtin_bit_cast(int, v), 0x4E, 0xF, 0xF, true));
    v += __builtin_bit_cast(float, __builtin_amdgcn_mov_dpp(__builtin_bit_cast(int, v), 0x141, 0xF, 0xF, true));
    v += __builtin_bit_cast(float, __builtin_amdgcn_mov_dpp(__builtin_bit_cast(int, v), 0x140, 0xF, 0xF, true));
    return v;
}
__device__ __forceinline__ float grp16_max(float v) { v = fmaxf(v, __shfl_xor(v, 1)); v = fmaxf(v, __shfl_xor(v, 2)); v = fmaxf(v, __shfl_xor(v, 4)); v = fmaxf(v, __shfl_xor(v, 8)); return v; }
__device__ __forceinline__ float grp16_sum(float v) { v += __shfl_xor(v, 1); v += __shfl_xor(v, 2); v += __shfl_xor(v, 4); v += __shfl_xor(v, 8); return v; }

__device__ __forceinline__ bf16x8 vt_frag(const LAS bf16_t* Vt, int ld, int dv, int s, int q4) {
    const u32x2 lo = *(const LAS u32x2*)(Vt + dv * ld + 32 * s + 4 * q4), hi = *(const LAS u32x2*)(Vt + dv * ld + 32 * s + 16 + 4 * q4);
    return __builtin_bit_cast(bf16x8, (u32x4){lo.x, lo.y, hi.x, hi.y});
}
__device__ __forceinline__ bf16x8 vt_frag2(const LAS bf16_t* Vt, int ld, int dv, int blk_lo, int blk_hi, int q4) {
    const u32x2 lo = *(const LAS u32x2*)(Vt + dv * ld + 16 * blk_lo + 4 * q4), hi = *(const LAS u32x2*)(Vt + dv * ld + 16 * blk_hi + 4 * q4);
    return __builtin_bit_cast(bf16x8, (u32x4){lo.x, lo.y, hi.x, hi.y});
}
__device__ __forceinline__ bf16x8 p_frag(const f32x4& a, const f32x4& b) {
    return __builtin_bit_cast(bf16x8, (u32x4){pk2(a[0], a[1]), pk2(a[2], a[3]), pk2(b[0], b[1]), pk2(b[2], b[3])});
}
__device__ __forceinline__ float quad_max(float v) { v = fmaxf(v, __shfl_xor(v, 16)); return fmaxf(v, __shfl_xor(v, 32)); }
__device__ __forceinline__ float quad_sum(float v) { v += __shfl_xor(v, 16); return v + __shfl_xor(v, 32); }
__device__ __forceinline__ u32x4 gate8(u32x4 y, u32x4 z) {
    float r[8];
    const unsigned yy[4] = {y.x, y.y, y.z, y.w}, zz[4] = {z.x, z.y, z.z, z.w};
#pragma unroll
    for (int e = 0; e < 4; ++e) { r[2 * e] = bf2f((unsigned short)(yy[e] & 0xffffu)) * silu(bf2f((unsigned short)(zz[e] & 0xffffu))); r[2 * e + 1] = bf2f((unsigned short)(yy[e] >> 16)) * silu(bf2f((unsigned short)(zz[e] >> 16))); }
    return (u32x4){pk2(r[0], r[1]), pk2(r[2], r[3]), pk2(r[4], r[5]), pk2(r[6], r[7])};
}

__device__ __forceinline__ void d_item(const MP& p, LAS unsigned char* lds, int item, bool dry = false) {
    const int tid = otid(), lane = tid & 63, w = __builtin_amdgcn_readfirstlane(tid >> 6);
    const int qt = item & 15, h = (item >> 4) & 3, b = item >> 6;
    const size_t row0 = (size_t)b * SEQ + qt * 256;
    LAS bf16_t* Qs = (LAS bf16_t*)lds;
    LAS bf16_t* KV = Qs + 256 * 136;
    const int q4 = lane >> 4, c16 = lane & 15;
#pragma unroll
    for (int it = 0; it < 8; ++it) { const int c = tid + it * 512; const int r = c >> 4, ch = c & 15;
        *(LAS u32x4*)(Qs + r * 136 + ch * 8) = *(const u32x4*)UP(p, (unsigned)(row0 + r) * NU + UD_Q + h * 128 + ch * 8); }
#pragma unroll
    for (int it = 0; it < 8; ++it) { const int c = tid + it * 512; const int r = c >> 4, ch = c & 15;
        *(LAS u32x4*)(KV + r * 136 + ch * 8) = *(const u32x4*)(p.kv + ((size_t)b * 256 + r) * 512 + h * 128 + ch * 8); }
    __syncthreads();
    bf16x8 pb[2][8]; float inv[2];
#pragma unroll
    for (int un = 0; un < 2; ++un) {
        bf16x8 qf[4]; ld_frags<128>(qf, Qs, 136, (w * 2 + un) * 16, lane);
        f32x4 S[16];
#pragma unroll
        for (int be = 0; be < 16; ++be) { S[be] = (f32x4){0.f, 0.f, 0.f, 0.f}; mma_fb<128>(S[be], KV, 136, be * 16, qf, lane); }
        const float c1 = 0.08838834764831845f * 1.4426950408889634f;
        float m = -INFINITY;
#pragma unroll
        for (int be = 0; be < 16; ++be)
#pragma unroll
            for (int i = 0; i < 4; ++i) m = fmaxf(m, S[be][i]);
        m = quad_max(m);
        const float m2 = m * c1;
        float sum = 0.f;
#pragma unroll
        for (int be = 0; be < 16; ++be)
#pragma unroll
            for (int i = 0; i < 4; ++i) { const float e = __builtin_amdgcn_exp2f(fmaf(S[be][i], c1, -m2)); S[be][i] = e; sum += e; }
        inv[un] = __builtin_amdgcn_rcpf(quad_sum(sum));
#pragma unroll
        for (int s8 = 0; s8 < 8; ++s8) pb[un][s8] = p_frag(S[2 * s8], S[2 * s8 + 1]);
        __builtin_amdgcn_sched_barrier(0);
    }
    u32x4 vr[8];
    { const int t3 = otid();
#pragma unroll
      for (int it = 0; it < 8; ++it) { const int c = t3 + it * 512; const int dvr = c >> 5, ch = c & 31; vr[it] = *(const u32x4*)(p.kv + 512 * 1024 + ((size_t)b * 512 + h * 128 + dvr) * 256 + ch * 8); } }
    __syncthreads();
#pragma unroll
    for (int it = 0; it < 8; ++it) { const int c = tid + it * 512; const int dvr = c >> 5, ch = c & 31; *(LAS u32x4*)(KV + dvr * 264 + ch * 8) = vr[it]; }
    u32x4 zr[8];
#pragma unroll
    for (int it = 0; it < 8; ++it) { const int c = tid + it * 512; const int r = c >> 4, ch = c & 15; zr[it] = *(const u32x4*)UP(p, (unsigned)(row0 + r) * NU + UD_Z + h * 128 + ch * 8); }
    __syncthreads();
#pragma unroll
    for (int dvb = 0; dvb < 8; ++dvb) { f32x4 o0 = (f32x4){0.f, 0.f, 0.f, 0.f}, o1 = o0;
#pragma unroll
        for (int s8 = 0; s8 < 8; ++s8) { const bf16x8 a = vt_frag(KV, 264, dvb * 16 + c16, s8, q4);
            o0 = __builtin_amdgcn_mfma_f32_16x16x32_bf16(a, pb[0][s8], o0, 0, 0, 0); o1 = __builtin_amdgcn_mfma_f32_16x16x32_bf16(a, pb[1][s8], o1, 0, 0, 0); }
        *(LAS u32x2*)(Qs + ((w * 2) * 16 + c16) * 136 + dvb * 16 + 4 * q4) = (u32x2){pk2(o0[0] * inv[0], o0[1] * inv[0]), pk2(o0[2] * inv[0], o0[3] * inv[0])};
        *(LAS u32x2*)(Qs + ((w * 2 + 1) * 16 + c16) * 136 + dvb * 16 + 4 * q4) = (u32x2){pk2(o1[0] * inv[1], o1[1] * inv[1]), pk2(o1[2] * inv[1], o1[3] * inv[1])}; }
    __syncthreads();
#pragma unroll
    for (int it = 0; it < 8; ++it) { const int c = tid + it * 512; const int r = c >> 4, ch = c & 15;
        const u32x4 yv = gate8(*(const LAS u32x4*)(Qs + r * 136 + ch * 8), zr[it]);
        if (!dry) *(u32x4*)UP(p, (unsigned)(row0 + r) * NU + UD_Q + h * 128 + ch * 8) = yv; }
    __syncthreads();
}

__device__ __forceinline__ void b_item(const MP& p, LAS unsigned char* lds, int item, bool dry = false) {
    const int tid = otid(), lane = tid & 63, w = __builtin_amdgcn_readfirstlane(tid >> 6);
    const int qt = item & 63, kvh = (item >> 6) & 1, b = item >> 7;
    const int t0 = qt * 64; const size_t brow = (size_t)b * SEQ;
    LAS bf16_t* Ks = (LAS bf16_t*)lds;
    LAS bf16_t* Vt = Ks + 320 * 72;
    LAS bf16_t* Qs = Vt + 64 * 328;
    const int k0 = t0 - 128;
    const int q4 = lane >> 4, c16 = lane & 15;
#pragma unroll
    for (int it = 0; it < 5; ++it) { const int kb = k0 + 64 * it; const int r = tid >> 3, ch = tid & 7;
        u32x4 v = (u32x4){0u, 0u, 0u, 0u};
        if (kb >= 0 && kb < SEQ) v = *(const u32x4*)UP(p, (unsigned)(brow + kb + r) * NU + UB_K + kvh * 64 + ch * 8);
        *(LAS u32x4*)(Ks + (it * 64 + r) * 72 + ch * 8) = v; }
#pragma unroll
    for (int it = 0; it < 5; ++it) { const int kb = k0 + 64 * it; const int d = tid >> 3, ch = tid & 7;
        u32x4 v = (u32x4){0u, 0u, 0u, 0u};
        if (kb >= 0 && kb < SEQ) v = *(const u32x4*)UP(p, (unsigned)(brow + kb + d) * NU + UB_V + kvh * 64 + ch * 8);
        *(LAS u32x4*)(Vt + d * 328 + it * 64 + ch * 8) = v; }
#pragma unroll
    for (int g = 0; g < 4; ++g) { const int r = tid >> 3, ch = tid & 7; const bf16_t* ur = UP(p, (unsigned)(brow + t0 + r) * NU + (kvh * 4 + g) * 64 + ch * 8);
        *(LAS u32x4*)(Qs + (g * 64 + r) * 72 + ch * 8) = *(const u32x4*)(ur + UB_Q); }
    __syncthreads();
#pragma unroll 1
    for (int uu = w; uu < 16; uu += 8) {
        const int g = uu >> 2, qb = uu & 3;
        const float sk = p.sink[kvh * 4 + g];
        bf16x8 qf[2]; ld_frags<64>(qf, Qs + g * 64 * 72, 72, qb * 16, lane);
        f32x4 S[18];
#pragma unroll
        for (int rb = 0; rb < 17; ++rb) { S[rb] = (f32x4){0.f, 0.f, 0.f, 0.f}; mma_fb<64>(S[rb], Ks, 72, (qb + rb) * 16, qf, lane); }
        S[17] = (f32x4){0.f, 0.f, 0.f, 0.f};
        const bool edge = (t0 < 128) || (t0 + 192 > SEQ);
        float mr = -INFINITY;
#pragma unroll
        for (int rb = 0; rb < 17; ++rb)
#pragma unroll
            for (int i = 0; i < 4; ++i) { const int kq = 4 * q4 + i;
                bool ok = (rb == 0) ? (kq >= c16) : (rb == 16) ? (kq <= c16) : true;
                if (edge) { const int kp = k0 + (qb + rb) * 16 + kq; ok = ok && (kp >= 0) && (kp < SEQ); }
                const float v = ok ? S[rb][i] : -INFINITY; S[rb][i] = v; mr = fmaxf(mr, v); }
        const float c1 = 0.125f * 1.4426950408889634f;
        const float m = fmaxf(quad_max(mr) * 0.125f, sk), m2 = m * 1.4426950408889634f;
        float sum = 0.f;
#pragma unroll
        for (int rb = 0; rb < 17; ++rb)
#pragma unroll
            for (int i = 0; i < 4; ++i) { const float e = __builtin_amdgcn_exp2f(fmaf(S[rb][i], c1, -m2)); S[rb][i] = e; sum += e; }
        const float inv = __builtin_amdgcn_rcpf(quad_sum(sum) + __expf(sk - m));
#pragma unroll
        for (int dvb = 0; dvb < 4; ++dvb) { f32x4 o = (f32x4){0.f, 0.f, 0.f, 0.f};
#pragma unroll
            for (int s9 = 0; s9 < 9; ++s9) o = __builtin_amdgcn_mfma_f32_16x16x32_bf16(vt_frag2(Vt, 328, dvb * 16 + c16, qb + 2 * s9, qb + (s9 < 8 ? 2 * s9 + 1 : 2 * s9), q4), p_frag(S[2 * s9], S[2 * s9 + 1]), o, 0, 0, 0);
            *(LAS u32x2*)(Qs + (g * 64 + qb * 16 + c16) * 72 + dvb * 16 + 4 * q4) = (u32x2){pk2(o[0] * inv, o[1] * inv), pk2(o[2] * inv, o[3] * inv)}; }
    }
    u32x4 zr[4];
    { const int t3 = otid();
#pragma unroll
      for (int g = 0; g < 4; ++g) zr[g] = *(const u32x4*)UP(p, (unsigned)(brow + t0 + (t3 >> 3)) * NU + UB_Z + (kvh * 4 + g) * 64 + (t3 & 7) * 8); }
    __syncthreads();
#pragma unroll
    for (int g = 0; g < 4; ++g) { const int r = tid >> 3, ch = tid & 7;
        const u32x4 yv = gate8(*(const LAS u32x4*)(Qs + (g * 64 + r) * 72 + ch * 8), zr[g]);
        if (!dry) *(u32x4*)UP(p, (unsigned)(brow + t0 + r) * NU + UB_Q + (kvh * 4 + g) * 64 + ch * 8) = yv; }
    __syncthreads();
}

struct ALds {
    LAS bf16_t *Qt, *Kt, *KhT, *Vt, *Pm, *St; LAS float *seg, *Dl, *Er, *stats;
};
__device__ __forceinline__ ALds a_lds(LAS unsigned char* lds) {
    ALds L; L.Qt = (LAS bf16_t*)lds; L.Kt = L.Qt + 64 * 136; L.KhT = L.Kt + 64 * 136; L.Vt = L.KhT + 128 * 72; L.Pm = L.Vt + 128 * 72;
    L.St = L.Pm + 64 * 72; L.seg = (LAS float*)(L.St + 128 * 136); L.Dl = L.seg + 512; L.Er = L.Dl + 128; L.stats = L.Er + 128; return L;
}
template <int MODE>
__device__ __forceinline__ float a_gates(const MP& p, const ALds& L, size_t tbase, int h, int dir, float carry) {
    const int tid = otid(), d = tid & 127, sg = tid >> 7;
    const float lbv = p.lb[h * 128 + d];
    unsigned off = (unsigned)((tbase + sg * 16) * NU + h * 128 + d) * 2u;
    const char* bz = (const char*)(p.u + (dir ? UA_FB : UA_FF)); const char* bvv = (const char*)(p.u + UA_I); const char* bq = (const char*)(p.u + UA_Q);
    float g[16], kk[16]; unsigned qp[8], vp[8], zp[8];
#pragma unroll
    for (int k = 0; k < 16; ++k) {
        asm volatile("" : "+v"(off));
        const unsigned zz = *(const unsigned short*)(bz + off);
        if (k & 1) zp[k >> 1] |= zz << 16; else zp[k >> 1] = zz;
        const unsigned vv = *(const unsigned short*)(bvv + off);
        if (k & 1) vp[k >> 1] |= vv << 16; else vp[k >> 1] = vv;
        if (MODE == 1) { const unsigned qq = *(const unsigned short*)(bq + off); if (k & 1) qp[k >> 1] |= qq << 16; else qp[k >> 1] = qq; }
        off += NU * 2; }
#pragma unroll
    for (int k = 0; k < 16; ++k) {
        const float z = bf2f((unsigned short)((k & 1) ? (zp[k >> 1] >> 16) : (zp[k >> 1] & 0xffffu)));
        const float f = lbv + (1.f - lbv) * sigm(z);
        g[k] = __builtin_amdgcn_logf(f) * 0.69314718056f; kk[k] = 1.f - f; }
    if (dir == 0) {
#pragma unroll
        for (int k = 1; k < 16; ++k) g[k] += g[k - 1];
        L.seg[sg * 128 + d] = g[15];
    } else {
#pragma unroll
        for (int k = 14; k >= 0; --k) g[k] += g[k + 1];
        L.seg[sg * 128 + d] = g[0];
    }
    __syncthreads();
    const float s0 = L.seg[d], s1 = L.seg[128 + d], s2 = L.seg[256 + d], s3 = L.seg[384 + d];
    const float tot = (s0 + s1) + (s2 + s3);
    float pre;
    if (dir == 0) pre = (sg > 0 ? s0 : 0.f) + (sg > 1 ? s1 : 0.f) + (sg > 2 ? s2 : 0.f);
    else pre = (sg < 3 ? s3 : 0.f) + (sg < 2 ? s2 : 0.f) + (sg < 1 ? s1 : 0.f);
    const float ref = dir == 0 ? (s0 + s1) : (s2 + s3);
    unsigned khp[8];
    const float c2 = (MODE == 1) ? __expf(tot - ref) : 0.f;
#pragma unroll
    for (int k = 0; k < 16; k += 2) {
        float khv[2];
#pragma unroll
        for (int e = 0; e < 2; ++e) { const int kx = k + e; const float bk = pre + g[kx];
            const int pp = sg * 16 + kx;
            if (MODE == 1) {
                const float e1 = __expf(bk - ref), r1 = __builtin_amdgcn_rcpf(e1);
                const float qv = bf2f((unsigned short)(e ? (qp[k >> 1] >> 16) : (qp[k >> 1] & 0xffffu)));
                const float kt = kk[kx] * r1;
                L.Qt[pp * 136 + d] = f2bf(qv * e1);
                L.Kt[pp * 136 + d] = f2bf(kt);
                khv[e] = kt * c2;
            } else khv[e] = kk[kx] * __expf((tot - bk) + carry);
        }
        khp[k >> 1] = pk2(khv[0], khv[1]); }
    *(LAS u32x4*)(L.KhT + d * 72 + sg * 16) = (u32x4){khp[0], khp[1], khp[2], khp[3]};
    *(LAS u32x4*)(L.KhT + d * 72 + sg * 16 + 8) = (u32x4){khp[4], khp[5], khp[6], khp[7]};
    if (MODE == 1 && sg == 0) { L.Dl[d] = __expf(tot); L.Er[d] = __expf(ref); }
    *(LAS u32x4*)(L.Vt + d * 72 + sg * 16) = (u32x4){vp[0], vp[1], vp[2], vp[3]};
    *(LAS u32x4*)(L.Vt + d * 72 + sg * 16 + 8) = (u32x4){vp[4], vp[5], vp[6], vp[7]};
    return tot;
}

__device__ __forceinline__ void a_pass1(const MP& p, LAS unsigned char* lds, int item) {
    const int tid = otid(), lane = tid & 63, w = __builtin_amdgcn_readfirstlane(tid >> 6);
    const int dir = item & 1, sc = (item >> 1) & 15, h = (item >> 5) & 3, b = item >> 7;
    const ALds L = a_lds(lds);
    const int q4 = lane >> 4, c16 = lane & 15;
    f32x4 S[8];
#pragma unroll
    for (int j = 0; j < 8; ++j) S[j] = (f32x4){0.f, 0.f, 0.f, 0.f};
    float carry = 0.f;
    for (int ci = 0; ci < 4; ++ci) {
        const int cc = dir ? ci : 3 - ci;
        const size_t tbase = (size_t)b * SEQ + sc * 256 + cc * 64;
        const float tot = a_gates<0>(p, L, tbase, h, dir, carry);
        carry += tot;
        __syncthreads();
        { bf16x8 bv[2]; ld_frags<64>(bv, L.Vt, 72, w * 16, lane);
#pragma unroll
          for (int j = 0; j < 8; ++j) mma_fb<64>(S[j], L.KhT, 72, j * 16, bv, lane); }
        __syncthreads();
    }
    const size_t sidx = ((size_t)(dir * p.nb * 4 + b * 4 + h) * NSC + sc);
    bf16_t* dst = p.SA + sidx * SA_ELEMS;
#pragma unroll
    for (int j = 0; j < 8; ++j) {
        *(u32x2*)(dst + (size_t)(w * 16 + c16) * 128 + j * 16 + 4 * q4) = (u32x2){pk2(S[j][0], S[j][1]), pk2(S[j][2], S[j][3])}; }
    if (tid < 128) p.DA[sidx * 128 + tid] = __expf(carry);
}

__device__ __forceinline__ void a_scan_unit(const MP& p, int unit, bool dry = false) {
    const int e4 = unit & 4095, seq = unit >> 12;
    const int dir = seq / (p.nb * 4);
    const int dk = (e4 * 4) & 127;
    u32x2 v[NSC]; f32x4 D[NSC];
#pragma unroll
    for (int i = 0; i < NSC; ++i) {
        const int sc = dir ? NSC - 1 - i : i;
        v[i] = *(const u32x2*)(p.SA + ((size_t)seq * NSC + sc) * SA_ELEMS + e4 * 4);
        D[i] = *(const f32x4*)(p.DA + ((size_t)seq * NSC + sc) * 128 + dk); }
    float S0 = 0.f, S1 = 0.f, S2 = 0.f, S3 = 0.f;
#pragma unroll
    for (int i = 0; i < NSC; ++i) {
        const int sc = dir ? NSC - 1 - i : i;
        if (!dry) *(u32x2*)(p.SA + ((size_t)seq * NSC + sc) * SA_ELEMS + e4 * 4) = (u32x2){pk2(S0, S1), pk2(S2, S3)};
        S0 = D[i][0] * S0 + bf2f(v[i].x & 0xffffu); S1 = D[i][1] * S1 + bf2f(v[i].x >> 16); S2 = D[i][2] * S2 + bf2f(v[i].y & 0xffffu); S3 = D[i][3] * S3 + bf2f(v[i].y >> 16);
    }
}

__device__ __forceinline__ void a_pass3(const MP& p, LAS unsigned char* lds, int item, bool dry = false) {
    const int tid = otid(), lane = tid & 63, w = __builtin_amdgcn_readfirstlane(tid >> 6);
    const int sc = item & 15, h = (item >> 4) & 3, b = item >> 6;
    const ALds L = a_lds(lds);
    const int q4 = lane >> 4, c16 = lane & 15, mb2 = w >> 1, nh = w & 1;
    f32x4 O[4][4];
#pragma unroll
    for (int a = 0; a < 4; ++a)
#pragma unroll
        for (int m = 0; m < 4; ++m) O[a][m] = (f32x4){0.f, 0.f, 0.f, 0.f};
#pragma unroll 1
    for (int dir = 0; dir < 2; ++dir) {
        const size_t sidx = ((size_t)(dir * p.nb * 4 + b * 4 + h) * NSC + sc);
        const bf16_t* sg = p.SA + sidx * SA_ELEMS;
        f32x4 S[8];
#pragma unroll
        for (int j = 0; j < 8; ++j) { const u32x2 v = *(const u32x2*)(sg + (size_t)(w * 16 + c16) * 128 + j * 16 + 4 * q4);
            S[j] = (f32x4){bf2f(v.x & 0xffffu), bf2f(v.x >> 16), bf2f(v.y & 0xffffu), bf2f(v.y >> 16)}; }
#pragma unroll 1
        for (int ci = 0; ci < 4; ++ci) {
            const int cc = dir ? 3 - ci : ci;
            const size_t tbase = (size_t)b * SEQ + sc * 256 + cc * 64;
            (void)a_gates<1>(p, L, tbase, h, dir, 0.f);
            __syncthreads();
            { bf16x8 aq[4]; ld_frags<128>(aq, L.Qt, 136, mb2 * 16, lane);
#pragma unroll
              for (int n = 0; n < 2; ++n) { f32x4 a = (f32x4){0.f, 0.f, 0.f, 0.f}; const int nb16 = nh * 2 + n;
                mma_fa<128>(a, aq, L.Kt, 136, nb16 * 16, lane);
                const int ps = nb16 * 16 + c16, pt0 = mb2 * 16 + 4 * q4;
#pragma unroll
                for (int i = 0; i < 4; ++i) { const int pt = pt0 + i; const bool keep = dir ? (ps >= pt) : (ps <= pt);
                    L.Pm[pt * 72 + ps] = f2bf(keep ? a[i] : 0.f); } } }
#pragma unroll
            for (int j = 0; j < 8; ++j) { const f32x4 E = *(const LAS f32x4*)(L.Er + j * 16 + 4 * q4);
                *(LAS u32x2*)(L.St + (w * 16 + c16) * 136 + j * 16 + 4 * q4) = (u32x2){pk2(S[j][0] * E[0], S[j][1] * E[1]), pk2(S[j][2] * E[2], S[j][3] * E[3])}; }
            __syncthreads();
            bf16x8 bv[2], bs[4];
            ld_frags<64>(bv, L.Vt, 72, w * 16, lane); ld_frags<128>(bs, L.St, 136, w * 16, lane);
            f32x4 T[4];
#pragma unroll
            for (int m = 0; m < 4; ++m) { T[m] = (f32x4){0.f, 0.f, 0.f, 0.f};
                mma_fb<64>(T[m], L.Pm, 72, m * 16, bv, lane);
                mma_fb<128>(T[m], L.Qt, 136, m * 16, bs, lane); }
            if (cc == 0) {
#pragma unroll
                for (int m = 0; m < 4; ++m) O[0][m] += T[m];
            } else if (cc == 1) {
#pragma unroll
                for (int m = 0; m < 4; ++m) O[1][m] += T[m];
            } else if (cc == 2) {
#pragma unroll
                for (int m = 0; m < 4; ++m) O[2][m] += T[m];
            } else {
#pragma unroll
                for (int m = 0; m < 4; ++m) O[3][m] += T[m];
            }
#pragma unroll
            for (int j = 0; j < 8; ++j) { const f32x4 D = *(const LAS f32x4*)(L.Dl + j * 16 + 4 * q4);
                S[j] = S[j] * D;
                mma_fb<64>(S[j], L.KhT, 72, j * 16, bv, lane); }
            __syncthreads();
        }
    }
    {
        const int t2 = otid();
        LAS bf16_t* Zt = (LAS bf16_t*)lds;
        LAS float* rsr = L.seg;
        const size_t rowb = (size_t)b * SEQ + sc * 256;
        u32x4 zr[8];
#pragma unroll
        for (int it = 0; it < 8; ++it) { const int c = t2 + it * 512; const int r = c >> 4, ch = c & 15; zr[it] = *(const u32x4*)UP(p, (unsigned)(rowb + r) * NU + UA_Z + h * 128 + ch * 8); }
        int q4e = (t2 >> 4 & 3) * 4; asm volatile("" : "+v"(q4e));
#pragma unroll
        for (int a = 0; a < 4; ++a)
#pragma unroll
            for (int m = 0; m < 4; ++m) { f32x4 sq;
#pragma unroll
                for (int i = 0; i < 4; ++i) { const float v = O[a][m][i]; sq[i] = dpp_sum16(v * v); }
                if (c16 == 0) *(LAS f32x4*)(L.stats + w * 256 + a * 64 + m * 16 + q4e) = sq; }
#pragma unroll
        for (int it = 0; it < 8; ++it) { const int c = t2 + it * 512; const int r = c >> 4, ch = c & 15; *(LAS u32x4*)(Zt + r * 136 + ch * 8) = zr[it]; }
        __syncthreads();
        if (t2 < 256) { float ss = 0.f;
#pragma unroll
            for (int ww = 0; ww < 8; ++ww) ss += L.stats[ww * 256 + t2];
            rsr[t2] = frsqrt(ss * (1.0f / 128.f) + EPS); }
        __syncthreads();
        const float gn = p.hgrn_g[h * 128 + w * 16 + c16];
#pragma unroll
        for (int a = 0; a < 4; ++a)
#pragma unroll
            for (int m = 0; m < 4; ++m) { const f32x4 rs4 = *(const LAS f32x4*)(rsr + a * 64 + m * 16 + q4e);
#pragma unroll
                for (int i = 0; i < 4; ++i) { LAS bf16_t* zp = Zt + (a * 64 + m * 16 + q4e + i) * 136 + w * 16 + c16;
                    *zp = f2bf(O[a][m][i] * rs4[i] * gn * silu(bf2f(*zp))); } }
        __syncthreads();
        if (!dry) {
#pragma unroll
            for (int it = 0; it < 8; ++it) { const int c = t2 + it * 512; const int r = c >> 4, ch = c & 15;
                *(u32x4*)UP(p, (unsigned)(rowb + r) * NU + UA_Q + h * 128 + ch * 8) = *(const LAS u32x4*)(Zt + r * 136 + ch * 8); }
        }
        __syncthreads();
    }
}

struct CLds {
    LAS bf16_t *Qc, *Kc, *KhT, *Vt, *Pw, *St; LAS float *sc;
};
__device__ __forceinline__ CLds c_lds(LAS unsigned char* lds) {
    CLds L; L.Qc = (LAS bf16_t*)lds; L.Kc = L.Qc + 64 * 72; L.KhT = L.Kc + 64 * 72; L.Vt = L.KhT + 64 * 72; L.Pw = L.Vt + 144 * 72; L.St = L.Pw + 64 * 72;
    L.sc = (LAS float*)(L.St + 144 * 72); return L;
}
__device__ __forceinline__ float log_sigmoid(float x) { return fminf(x, 0.f) - log1pf(__expf(-fabsf(x))); }
__device__ __forceinline__ void c_ones_rows(const CLds& L, int tid) {
    if (tid < 16 * 8) { const int r = 128 + (tid >> 3), ch = tid & 7; const unsigned one = (r == 128) ? 0x3f803f80u : 0u; *(LAS u32x4*)(L.Vt + r * 72 + ch * 8) = (u32x4){one, one, one, one}; }
}
struct CRegs { u32x4 q, k, v0, v1; };
template <bool WANT_Q>
__device__ __forceinline__ void c_issue(CRegs& R, const MP& p, size_t row0  , int h, int tid) {
    const int r = tid & 63, ch = tid >> 6;
    const bf16_t* ur = UP(p, (unsigned)(row0 + r) * NU + h * 64 + ch * 8);
    if (WANT_Q) R.q = *(const u32x4*)(ur + UC_Q);
    R.k = *(const u32x4*)(ur + UC_K);
    const bf16_t* vr = UP(p, (unsigned)(row0 + r) * NU + UC_V + h * 128 + ch * 16);
    R.v0 = *(const u32x4*)vr; R.v1 = *(const u32x4*)(vr + 8);
}
template <bool WANT_Q>
__device__ __forceinline__ void c_store(const CRegs& R, const CLds& L, float wsr, int tid) {
    const int r = tid & 63, ch = tid >> 6;
    if (WANT_Q) { *(LAS u32x4*)(L.Qc + r * 72 + ch * 8) = R.q; *(LAS u32x4*)(L.Kc + r * 72 + ch * 8) = R.k; }
    {
        LAS bf16_t* vd = L.Vt + (ch * 16) * 72 + r;
        vd[0 * 72] = (bf16_t)(R.v0.x & 0xffffu); vd[1 * 72] = (bf16_t)(R.v0.x >> 16); vd[2 * 72] = (bf16_t)(R.v0.y & 0xffffu); vd[3 * 72] = (bf16_t)(R.v0.y >> 16);
        vd[4 * 72] = (bf16_t)(R.v0.z & 0xffffu); vd[5 * 72] = (bf16_t)(R.v0.z >> 16); vd[6 * 72] = (bf16_t)(R.v0.w & 0xffffu); vd[7 * 72] = (bf16_t)(R.v0.w >> 16);
        vd[8 * 72] = (bf16_t)(R.v1.x & 0xffffu); vd[9 * 72] = (bf16_t)(R.v1.x >> 16); vd[10 * 72] = (bf16_t)(R.v1.y & 0xffffu); vd[11 * 72] = (bf16_t)(R.v1.y >> 16);
        vd[12 * 72] = (bf16_t)(R.v1.z & 0xffffu); vd[13 * 72] = (bf16_t)(R.v1.z >> 16); vd[14 * 72] = (bf16_t)(R.v1.w & 0xffffu); vd[15 * 72] = (bf16_t)(R.v1.w >> 16);
    }
    LAS bf16_t* dst = L.KhT + (ch * 8) * 72 + r;
    dst[0 * 72] = f2bf(wsr * bf2f(R.k.x & 0xffffu)); dst[1 * 72] = f2bf(wsr * bf2f(R.k.x >> 16)); dst[2 * 72] = f2bf(wsr * bf2f(R.k.y & 0xffffu)); dst[3 * 72] = f2bf(wsr * bf2f(R.k.y >> 16));
    dst[4 * 72] = f2bf(wsr * bf2f(R.k.z & 0xffffu)); dst[5 * 72] = f2bf(wsr * bf2f(R.k.z >> 16)); dst[6 * 72] = f2bf(wsr * bf2f(R.k.w & 0xffffu)); dst[7 * 72] = f2bf(wsr * bf2f(R.k.w >> 16));
}

__device__ __forceinline__ void c_pass1(const MP& p, LAS unsigned char* lds, int item) {
    const int tid = otid(), lane = tid & 63, w = __builtin_amdgcn_readfirstlane(tid >> 6);
    const int dir = item & 1, sc = (item >> 1) & 15, h = (item >> 5) & 3, b = item >> 7;
    const CLds L = c_lds(lds);
    const int q4 = lane >> 4, c16 = lane & 15;
    const size_t brow = (size_t)b * SEQ; const int tls = sc * 256;
    CRegs R;
    c_issue<false>(R, p, brow + tls, h, tid);
    c_ones_rows(L, tid);
    if (w == 0) {
        const float bi = p.gate_b[dir * 4 + h], bf = p.gate_b[8 + dir * 4 + h];
        float lf[4], li[4];
#pragma unroll
        for (int k = 0; k < 4; ++k) { const float* gr = p.gates + (brow + tls + lane * 4 + k) * 16; li[k] = gr[dir * 4 + h] + bi; lf[k] = log_sigmoid(gr[8 + dir * 4 + h] + bf); }
        const float tot4 = (lf[0] + lf[1]) + (lf[2] + lf[3]);
        float incl = tot4;
        if (dir == 0) {
#pragma unroll
            for (int o = 1; o < 64; o <<= 1) { const float t = __shfl_down(incl, o); if (lane + o < 64) incl += t; }
        } else {
#pragma unroll
            for (int o = 1; o < 64; o <<= 1) { const float t = __shfl_up(incl, o); if (lane >= o) incl += t; }
        }
        const float after_lane = incl - tot4;
        float E[4];
        if (dir == 0) { E[3] = after_lane; E[2] = E[3] + lf[3]; E[1] = E[2] + lf[2]; E[0] = E[1] + lf[1]; }
        else { E[0] = after_lane; E[1] = E[0] + lf[0]; E[2] = E[1] + lf[1]; E[3] = E[2] + lf[2]; }
        float a[4], amax = -INFINITY;
#pragma unroll
        for (int k = 0; k < 4; ++k) { a[k] = E[k] + li[k]; amax = fmaxf(amax, a[k]); }
#pragma unroll
        for (int o = 32; o > 0; o >>= 1) amax = fmaxf(amax, __shfl_xor(amax, o));
        float Btot = tot4;
#pragma unroll
        for (int o = 32; o > 0; o >>= 1) Btot += __shfl_xor(Btot, o);
#pragma unroll
        for (int k = 0; k < 4; ++k) L.sc[192 + lane * 4 + k] = __expf(a[k] - amax);
        if (lane == 0) { L.sc[576 + 2] = amax; L.sc[576 + 3] = Btot; }
    }
    __syncthreads();
    f32x4 S[5];
#pragma unroll
    for (int j = 0; j < 5; ++j) S[j] = (f32x4){0.f, 0.f, 0.f, 0.f};
#pragma unroll 1
    for (int cc = 0; cc < 4; ++cc) {
        c_store<false>(R, L, L.sc[192 + cc * 64 + (tid & 63)], tid);
        if (cc < 3) c_issue<false>(R, p, brow + tls + (cc + 1) * 64, h, tid);
        __syncthreads();
        { bf16x8 bv[2]; ld_frags<64>(bv, L.Vt, 72, w * 16, lane);
#pragma unroll
          for (int j = 0; j < 4; ++j) mma_fb<64>(S[j], L.KhT, 72, j * 16, bv, lane); }
        if (w < 4) mma_nt<64>(S[4], L.KhT, 72, w * 16, L.Vt, 72, 128, lane);
        __syncthreads();
    }
    const size_t sidx = ((size_t)(dir * p.nb * 4 + b * 4 + h) * NSC + sc);
    bf16_t* dst = p.SC + sidx * SC_ELEMS;
#pragma unroll
    for (int j = 0; j < 4; ++j) *(u32x2*)(dst + (size_t)(w * 16 + c16) * 64 + j * 16 + 4 * q4) = (u32x2){pk2(S[j][0], S[j][1]), pk2(S[j][2], S[j][3])};
    if (w < 4) *(u32x2*)(dst + (size_t)(128 + c16) * 64 + w * 16 + 4 * q4) = (u32x2){pk2(S[4][0], S[4][1]), pk2(S[4][2], S[4][3])};
    if (tid == 0) { p.CS[sidx * 4 + 0] = L.sc[576 + 2]; p.CS[sidx * 4 + 1] = L.sc[576 + 3]; }
    __syncthreads();
}

__device__ __forceinline__ void c_scan_unit(const MP& p, int unit, bool dry = false) {
    const int e4 = unit % 2304, seq = unit / 2304;
    const int dir = seq / (p.nb * 4);
    u32x2 v[NSC]; float A[NSC], B[NSC];
#pragma unroll
    for (int i = 0; i < NSC; ++i) {
        const int sc = dir ? NSC - 1 - i : i; const size_t sidx = (size_t)seq * NSC + sc;
        v[i] = *(const u32x2*)(p.SC + sidx * SC_ELEMS + e4 * 4); A[i] = p.CS[sidx * 4 + 0]; B[i] = p.CS[sidx * 4 + 1]; }
    float S0 = 0.f, S1 = 0.f, S2 = 0.f, S3 = 0.f, M = 0.f;
#pragma unroll
    for (int i = 0; i < NSC; ++i) {
        const int sc = dir ? NSC - 1 - i : i; const size_t sidx = (size_t)seq * NSC + sc;
        if (!dry) *(u32x2*)(p.SC + sidx * SC_ELEMS + e4 * 4) = (u32x2){pk2(S0, S1), pk2(S2, S3)};
        if (e4 == 0 && !dry) p.CS[sidx * 4 + 2] = M;
        const float Mn = fmaxf(B[i] + M, A[i]);
        const float dc = __expf(B[i] + M - Mn), wn = __expf(A[i] - Mn);
        S0 = dc * S0 + wn * bf2f(v[i].x & 0xffffu); S1 = dc * S1 + wn * bf2f(v[i].x >> 16); S2 = dc * S2 + wn * bf2f(v[i].y & 0xffffu); S3 = dc * S3 + wn * bf2f(v[i].y >> 16);
        M = Mn;
    }
}

__device__ __forceinline__ void c_pass3(const MP& p, LAS unsigned char* lds, int item, bool dry = false) {
    const int tid = otid(), lane = tid & 63, w = __builtin_amdgcn_readfirstlane(tid >> 6);
    const int sc = item & 15, h = (item >> 4) & 3, b = item >> 6;
    const CLds L = c_lds(lds);
    const int q4 = lane >> 4, c16 = lane & 15, mb2 = w >> 1, nh = w & 1;
    const size_t brow = (size_t)b * SEQ; const int tls = sc * 256;
    f32x4 H[4][4];
#pragma unroll
    for (int a = 0; a < 4; ++a)
#pragma unroll
        for (int m = 0; m < 4; ++m) H[a][m] = (f32x4){0.f, 0.f, 0.f, 0.f};
    CRegs R; float gi_raw, gf_raw;
    c_issue<true>(R, p, brow + tls, h, tid);
    { const float* gr = p.gates + (brow + tls + lane) * 16; gi_raw = gr[h]; gf_raw = gr[8 + h]; }
    c_ones_rows(L, tid);
#pragma unroll 1
    for (int dir = 0; dir < 2; ++dir) {
        const size_t sidx = ((size_t)(dir * p.nb * 4 + b * 4 + h) * NSC + sc);
        const bf16_t* sg = p.SC + sidx * SC_ELEMS;
        { const int t2 = otid();
#pragma unroll
          for (int it = 0; it < 3; ++it) { const int c = t2 + it * 512; if (c >= 144 * 8) break; const int r = c >> 3, ch = c & 7; *(LAS u32x4*)(L.St + r * 72 + ch * 8) = *(const u32x4*)(sg + r * 64 + ch * 8); } }
        f32x4 S[5];
#pragma unroll
        for (int j = 0; j < 4; ++j) { const u32x2 v = *(const u32x2*)(sg + (size_t)(w * 16 + c16) * 64 + j * 16 + 4 * q4);
            S[j] = (f32x4){bf2f(v.x & 0xffffu), bf2f(v.x >> 16), bf2f(v.y & 0xffffu), bf2f(v.y >> 16)}; }
        S[4] = (f32x4){0.f, 0.f, 0.f, 0.f};
        if (w < 4) { const u32x2 v = *(const u32x2*)(sg + (size_t)(128 + c16) * 64 + w * 16 + 4 * q4);
            S[4] = (f32x4){bf2f(v.x & 0xffffu), bf2f(v.x >> 16), bf2f(v.y & 0xffffu), bf2f(v.y >> 16)}; }
        float M = p.CS[sidx * 4 + 2];
        const float bi = p.gate_b[dir * 4 + h], bfb = p.gate_b[8 + dir * 4 + h];
#pragma unroll 1
        for (int ci = 0; ci < 4; ++ci) {
            const int cc = dir ? 3 - ci : ci;
            const float li = gi_raw + bi, lf = log_sigmoid(gf_raw + bfb);
            float bc = lf;
            if (dir == 0) {
#pragma unroll
                for (int o = 1; o < 64; o <<= 1) { const float t = __shfl_up(bc, o); if (lane >= o) bc += t; }
            } else {
#pragma unroll
                for (int o = 1; o < 64; o <<= 1) { const float t = __shfl_down(bc, o); if (lane + o < 64) bc += t; }
            }
            const float cb = li - bc;
            float pm = cb;
            if (dir == 0) {
#pragma unroll
                for (int o = 1; o < 64; o <<= 1) { const float t = __shfl_up(pm, o); if (lane >= o) pm = fmaxf(pm, t); }
            } else {
#pragma unroll
                for (int o = 1; o < 64; o <<= 1) { const float t = __shfl_down(pm, o); if (lane + o < 64) pm = fmaxf(pm, t); }
            }
            const float mt = fmaxf(bc + pm, bc + M);
            const float blast = __shfl(bc, dir ? 0 : 63);
            const float av = blast - bc + li;
            float amax = av;
#pragma unroll
            for (int o = 32; o > 0; o >>= 1) amax = fmaxf(amax, __shfl_xor(amax, o));
            const float Mn = fmaxf(blast + M, amax);
            const float wsv = __expf(av - Mn), dcy = __expf(blast + M - Mn);
            if (w == 0) { L.sc[lane] = bc - mt; L.sc[64 + lane] = cb; L.sc[128 + lane] = __expf(bc + M - mt); L.sc[448 + lane] = mt; }
            M = Mn;
            c_store<true>(R, L, wsv, tid);
            {
                int ndir = dir, nci = ci + 1; if (nci == 4) { nci = 0; ndir = dir + 1; }
                if (ndir < 2) { const int ncc = ndir ? 3 - nci : nci; const size_t nrow = brow + tls + ncc * 64;
                    c_issue<true>(R, p, nrow, h, tid);
                    const float* gr = p.gates + (nrow + lane) * 16; gi_raw = gr[ndir * 4 + h]; gf_raw = gr[8 + ndir * 4 + h]; }
            }
            __syncthreads();
            { bf16x8 aq[2]; ld_frags<64>(aq, L.Qc, 72, mb2 * 16, lane);
#pragma unroll
              for (int n = 0; n < 2; ++n) { f32x4 a = (f32x4){0.f, 0.f, 0.f, 0.f}; const int nb16 = nh * 2 + n;
                mma_fa<64>(a, aq, L.Kc, 72, nb16 * 16, lane);
                const int ps = nb16 * 16 + c16, pt0 = mb2 * 16 + 4 * q4; const float cbs = L.sc[64 + ps];
#pragma unroll
                for (int i = 0; i < 4; ++i) { const int pt = pt0 + i; const bool keep = dir ? (ps >= pt) : (ps <= pt);
                    const float wv = keep ? a[i] * __expf(L.sc[pt] + cbs) : 0.f;
                    L.Pw[pt * 72 + ps] = f2bf(wv); } } }
            __syncthreads();
            if (w < 4) { f32x4 n2 = (f32x4){0.f, 0.f, 0.f, 0.f};
                mma_nt<64>(n2, L.Qc, 72, w * 16, L.St, 72, 128, lane);
                const f32x4 g = *(const LAS f32x4*)(L.sc + 128 + w * 16 + 4 * q4);
                n2 = n2 * g; mma_nt<64>(n2, L.Pw, 72, w * 16, L.Vt, 72, 128, lane);
                if (c16 == 0) *(LAS f32x4*)(L.sc + 512 + w * 16 + 4 * q4) = n2; }
            __syncthreads();
            bf16x8 bv[2], bs[2];
            ld_frags<64>(bv, L.Vt, 72, w * 16, lane); ld_frags<64>(bs, L.St, 72, w * 16, lane);
#pragma unroll
            for (int m = 0; m < 4; ++m) { f32x4 T = (f32x4){0.f, 0.f, 0.f, 0.f};
                mma_fb<64>(T, L.Qc, 72, m * 16, bs, lane);
                const f32x4 g = *(const LAS f32x4*)(L.sc + 128 + m * 16 + 4 * q4);
                T = T * g; mma_fb<64>(T, L.Pw, 72, m * 16, bv, lane);
                const f32x4 dn = *(const LAS f32x4*)(L.sc + 512 + m * 16 + 4 * q4), mr = *(const LAS f32x4*)(L.sc + 448 + m * 16 + 4 * q4);
#pragma unroll
                for (int i = 0; i < 4; ++i) T[i] *= __builtin_amdgcn_rcpf(fmaxf(fabsf(dn[i]), __expf(-mr[i])));
                if (cc == 0) H[0][m] += T; else if (cc == 1) H[1][m] += T; else if (cc == 2) H[2][m] += T; else H[3][m] += T; }
#pragma unroll
            for (int j = 0; j < 4; ++j) { S[j] = S[j] * dcy; mma_fb<64>(S[j], L.KhT, 72, j * 16, bv, lane);
                *(LAS u32x2*)(L.St + (w * 16 + c16) * 72 + j * 16 + 4 * q4) = (u32x2){pk2(S[j][0], S[j][1]), pk2(S[j][2], S[j][3])}; }
            if (w < 4) { S[4] = S[4] * dcy; mma_nt<64>(S[4], L.KhT, 72, w * 16, L.Vt, 72, 128, lane);
                *(LAS u32x2*)(L.St + (128 + c16) * 72 + w * 16 + 4 * q4) = (u32x2){pk2(S[4][0], S[4][1]), pk2(S[4][2], S[4][3])}; }
            __syncthreads();
        }
    }
    {
        const int t2 = otid();
        LAS bf16_t* Tt = (LAS bf16_t*)lds;
        LAS float* st1 = L.sc + 640; LAS float* st2 = st1 + 8 * 256; LAS float* mu = L.sc; LAS float* rsr = L.sc + 256;
        const size_t rowb = brow + tls;
        u32x4 og[8], zr[8];
#pragma unroll
        for (int it = 0; it < 8; ++it) { const int c = t2 + it * 512; const int r = c >> 4, ch = c & 15; og[it] = *(const u32x4*)UP(p, (unsigned)(rowb + r) * NU + UC_O + h * 128 + ch * 8); }
#pragma unroll
        for (int it = 0; it < 8; ++it) { const int c = t2 + it * 512; const int r = c >> 4, ch = c & 15; zr[it] = *(const u32x4*)UP(p, (unsigned)(rowb + r) * NU + UC_Z + h * 128 + ch * 8); }
#pragma unroll
        for (int it = 0; it < 8; ++it) { const int c = t2 + it * 512; const int r = c >> 4, ch = c & 15; *(LAS u32x4*)(Tt + r * 136 + ch * 8) = og[it]; }
        __syncthreads();
        int q4e = (t2 >> 4 & 3) * 4; asm volatile("" : "+v"(q4e));
#pragma unroll
        for (int a = 0; a < 4; ++a)
#pragma unroll
            for (int m = 0; m < 4; ++m) { f32x4 sm;
#pragma unroll
                for (int i = 0; i < 4; ++i) { const int tl = a * 64 + m * 16 + q4e + i;
                    const float v = H[a][m][i] * sigm(bf2f(Tt[tl * 136 + w * 16 + c16])); H[a][m][i] = v;
                    sm[i] = dpp_sum16(v); }
                if (c16 == 0) *(LAS f32x4*)(st1 + w * 256 + a * 64 + m * 16 + q4e) = sm; }
        __syncthreads();
        if (t2 < 256) { float ss = 0.f;
#pragma unroll
            for (int ww = 0; ww < 8; ++ww) ss += st1[ww * 256 + t2];
            mu[t2] = ss * (1.0f / 128.f); }
#pragma unroll
        for (int it = 0; it < 8; ++it) { const int c = t2 + it * 512; const int r = c >> 4, ch = c & 15; *(LAS u32x4*)(Tt + r * 136 + ch * 8) = zr[it]; }
        __syncthreads();
#pragma unroll
        for (int a = 0; a < 4; ++a)
#pragma unroll
            for (int m = 0; m < 4; ++m) { const f32x4 mu4 = *(const LAS f32x4*)(mu + a * 64 + m * 16 + q4e);
                f32x4 sq;
#pragma unroll
                for (int i = 0; i < 4; ++i) { const float dv = H[a][m][i] - mu4[i]; H[a][m][i] = dv; sq[i] = dpp_sum16(dv * dv); }
                if (c16 == 0) *(LAS f32x4*)(st2 + w * 256 + a * 64 + m * 16 + q4e) = sq; }
        __syncthreads();
        if (t2 < 256) { float ss = 0.f;
#pragma unroll
            for (int ww = 0; ww < 8; ++ww) ss += st2[ww * 256 + t2];
            rsr[t2] = frsqrt(ss * (1.0f / 128.f) + EPS); }
        __syncthreads();
        const float gn = p.mlstm_g[h * 128 + w * 16 + c16];
#pragma unroll
        for (int a = 0; a < 4; ++a)
#pragma unroll
            for (int m = 0; m < 4; ++m) { const f32x4 rs4 = *(const LAS f32x4*)(rsr + a * 64 + m * 16 + q4e);
#pragma unroll
                for (int i = 0; i < 4; ++i) { LAS bf16_t* zp = Tt + (a * 64 + m * 16 + q4e + i) * 136 + w * 16 + c16;
                    *zp = f2bf(H[a][m][i] * rs4[i] * gn * silu(bf2f(*zp))); } }
        __syncthreads();
        if (!dry) {
#pragma unroll
            for (int it = 0; it < 8; ++it) { const int c = t2 + it * 512; const int r = c >> 4, ch = c & 15;
                *(u32x4*)UP(p, (unsigned)(rowb + r) * NU + UC_V + h * 128 + ch * 8) = *(const LAS u32x4*)(Tt + r * 136 + ch * 8); }
        }
        __syncthreads();
    }
}

__device__ __forceinline__ void pre_load(const MP& p, LAS unsigned char* lds, int blk) {
    const int tid = otid();
    LAS bf16_t* raw = (LAS bf16_t*)lds;
    const int tl0 = (blk * 64) & (SEQ - 1); const size_t brow = (size_t)(blk * 64 - tl0);
#pragma unroll
    for (int it = 0; it < 9; ++it) { const int c = tid + it * 512; if (c >= 68 * 64) break; const int r = c >> 6, ch = c & 63; const int tl = tl0 - 2 + r;
        u32x4 v = (u32x4){0u, 0u, 0u, 0u};
        if (tl >= 0 && tl < SEQ) v = *(const u32x4*)UP(p, (unsigned)(brow + tl) * NU + UC_Q + ch * 8);
        *(LAS u32x4*)(raw + r * 520 + ch * 8) = v; }
    LAS bf16_t* vt = raw + 68 * 520;
#pragma unroll
    for (int it = 0; it < 2; ++it) { const int c = tid + it * 512; const int kvh = c >> 9, t = (c >> 3) & 63, ch = c & 7;
        *(LAS u32x4*)(vt + (kvh * 64 + t) * 72 + ch * 8) = *(const u32x4*)UP(p, (unsigned)(blk * 64 + t) * NU + UB_V + kvh * 64 + ch * 8); }
}
__device__ __forceinline__ void pre_write(const MP& p, LAS unsigned char* lds, int blk) {
    const int tid = otid();
    LAS bf16_t* raw = (LAS bf16_t*)lds;
    const size_t row0 = (size_t)blk * 64;
    __syncthreads();
    {
        const int ch = tid & 63;
        f32x4 w0[5], w1[5];
#pragma unroll
        for (int j = 0; j < 5; ++j) { w0[j] = *(const f32x4*)(p.conv_w + j * 512 + ch * 8); w1[j] = *(const f32x4*)(p.conv_w + j * 512 + ch * 8 + 4); }
        const float sc = (ch < 32) ? 0.125f : 1.0f;
#pragma unroll 2
        for (int it = 0; it < 8; ++it) { const int r = (tid >> 6) + 8 * it;
            float acc[8];
#pragma unroll
            for (int e = 0; e < 8; ++e) acc[e] = 0.f;
#pragma unroll
            for (int j = 0; j < 5; ++j) { const u32x4 x = *(const LAS u32x4*)(raw + (r + j) * 520 + ch * 8);
                acc[0] = fmaf(bf2f(x.x & 0xffffu), w0[j][0], acc[0]); acc[1] = fmaf(bf2f(x.x >> 16), w0[j][1], acc[1]); acc[2] = fmaf(bf2f(x.y & 0xffffu), w0[j][2], acc[2]); acc[3] = fmaf(bf2f(x.y >> 16), w0[j][3], acc[3]);
                acc[4] = fmaf(bf2f(x.z & 0xffffu), w1[j][0], acc[4]); acc[5] = fmaf(bf2f(x.z >> 16), w1[j][1], acc[5]); acc[6] = fmaf(bf2f(x.w & 0xffffu), w1[j][2], acc[6]); acc[7] = fmaf(bf2f(x.w >> 16), w1[j][3], acc[7]); }
#pragma unroll
            for (int e = 0; e < 8; ++e) acc[e] = silu(acc[e]) * sc;
            *(u32x4*)UP(p, (unsigned)(row0 + r) * NU + UC_Q + ch * 8) = (u32x4){pk2(acc[0], acc[1]), pk2(acc[2], acc[3]), pk2(acc[4], acc[5]), pk2(acc[6], acc[7])}; }
    }
    { LAS bf16_t* vt = raw + 68 * 520;
#pragma unroll 1
      for (int it = 0; it < 2; ++it) { const int c = tid + it * 512; const int kvh = c >> 9, d = (c >> 3) & 63, ch = c & 7;
          const LAS bf16_t* src = vt + (kvh * 64 + ch * 8) * 72 + d;
          const u32x4 o = (u32x4){(unsigned)src[0] | ((unsigned)src[72] << 16), (unsigned)src[2 * 72] | ((unsigned)src[3 * 72] << 16), (unsigned)src[4 * 72] | ((unsigned)src[5 * 72] << 16), (unsigned)src[6 * 72] | ((unsigned)src[7 * 72] << 16)};
          *(u32x4*)UP(p, (unsigned)(row0 + d) * NU + UB_V + kvh * 64 + ch * 8) = o; } }
#pragma unroll
    for (int it = 0; it < 2; ++it) { const int c = tid + it * 512; if (c >= 64 * 10) break; const int r = c / 10, hh = c % 10;
        bf16_t* ptr = UP(p, (unsigned)(row0 + r) * NU + (hh < 8 ? UB_Q + hh * 64 : UB_K + (hh - 8) * 64));
        const u32x4 a = *(const u32x4*)ptr, bb = *(const u32x4*)(ptr + 8);
        const f32x4 c0 = *(const f32x4*)(p.cs + (row0 + r) * 8), c1 = *(const f32x4*)(p.cs + (row0 + r) * 8 + 4), s0 = *(const f32x4*)(p.sn + (row0 + r) * 8), s1 = *(const f32x4*)(p.sn + (row0 + r) * 8 + 4);
        const float cs[8] = {c0[0], c0[1], c0[2], c0[3], c1[0], c1[1], c1[2], c1[3]}, sn[8] = {s0[0], s0[1], s0[2], s0[3], s1[0], s1[1], s1[2], s1[3]};
        const float x1[8] = {bf2f(a.x & 0xffffu), bf2f(a.x >> 16), bf2f(a.y & 0xffffu), bf2f(a.y >> 16), bf2f(a.z & 0xffffu), bf2f(a.z >> 16), bf2f(a.w & 0xffffu), bf2f(a.w >> 16)};
        const float x2[8] = {bf2f(bb.x & 0xffffu), bf2f(bb.x >> 16), bf2f(bb.y & 0xffffu), bf2f(bb.y >> 16), bf2f(bb.z & 0xffffu), bf2f(bb.z >> 16), bf2f(bb.w & 0xffffu), bf2f(bb.w >> 16)};
        float r1[8], r2[8];
#pragma unroll
        for (int e = 0; e < 8; ++e) { r1[e] = x1[e] * cs[e] - x2[e] * sn[e]; r2[e] = x2[e] * cs[e] + x1[e] * sn[e]; }
        *(u32x4*)ptr = (u32x4){pk2(r1[0], r1[1]), pk2(r1[2], r1[3]), pk2(r1[4], r1[5]), pk2(r1[6], r1[7])};
        *(u32x4*)(ptr + 8) = (u32x4){pk2(r2[0], r2[1]), pk2(r2[2], r2[3]), pk2(r2[4], r2[5]), pk2(r2[6], r2[7])}; }
    __syncthreads();
}
}
#include <hip/hip_cooperative_groups.h>
namespace cg = cooperative_groups;
namespace fr {
using namespace mk;
constexpr int M = 16384, DM = 1024, DIN = 6928, NB = 4;
constexpr size_t MiB = 1u << 20;
constexpr int LDS_BYTES = 147456;
#ifndef MK_MULTI
#define MK_MULTI 0
#endif
constexpr int NPHASE = 12;
constexpr size_t WS_CTL = 0, CTL_ZERO_BYTES = 256 * 1024;
constexpr size_t WS_BAR = 16 * 1024;
constexpr size_t WS_SS = 64 * 1024;
constexpr size_t WS_LB = 256 * 1024;
constexpr size_t WS_DA = WS_LB + 4096;
constexpr size_t WS_CS = WS_DA + 2 * 16 * 16 * 128 * 4;
constexpr size_t WS_U = 1 * MiB;
constexpr size_t WS_R2 = 217 * MiB;
constexpr size_t WS_WTIN = WS_R2;
constexpr size_t WS_SA = WS_R2;
constexpr size_t WS_SC = WS_R2 + 16 * MiB;
constexpr size_t WS_WTOUT = WS_R2 + 25 * MiB;
constexpr size_t WS_KV = WS_R2 + 33 * MiB;
constexpr size_t WS_GATES = WS_R2 + 37 * MiB;
constexpr size_t WS_CSN = WS_R2 + 38 * MiB;
static_assert(WS_CSN + 1 * MiB == 256 * MiB, "ws map");
static_assert(WS_U + (size_t)M * NU * 2 == WS_R2, "u fills [1, 217) MiB");
constexpr size_t DO_XB = 0;
constexpr size_t DO_LO = 32 * MiB;
constexpr size_t DO_WTKV = 32 * MiB;
constexpr size_t DO_MEMN = 36 * MiB;

#define XB_TMO      128
#define XB_XCNT(j)  (256  + 64 * (j))
#define XB_XSUB(j)  (1280 + 64 * (j))
#define XB_XGEN(j)  (2304 + 64 * (j))
#define XB_TOP      3328
#define XB_TOPGEN   3392
#define XCD_BAR_WORDS 3456
#define XB_SPIN_CAP (1u << 18)

__device__ __forceinline__ unsigned xb_ld(unsigned* p)              { return __hip_atomic_load(p, __ATOMIC_RELAXED, __HIP_MEMORY_SCOPE_AGENT); }
__device__ __forceinline__ unsigned xb_add(unsigned* p, unsigned v) { return __hip_atomic_fetch_add(p, v, __ATOMIC_RELAXED, __HIP_MEMORY_SCOPE_AGENT); }
__device__ __forceinline__ unsigned xb_xcc_id() { return (unsigned)__builtin_amdgcn_s_getreg((3 << 11) | 20) & 0xFu; }
#define XB_SPIN(cond, bar) do { unsigned _sp = 0; while (cond) { __builtin_amdgcn_s_sleep(1); \
    if ((++_sp & 255u) == 0u) { if (xb_ld(&(bar)[XB_TMO])) break; if (_sp > XB_SPIN_CAP) { atomicAdd(&(bar)[XB_TMO], 1u); break; } } } } while (0)

struct XcdBarrier {
    unsigned* bar; unsigned x;
    volatile LAS unsigned* st;
};

__device__ __forceinline__ XcdBarrier xcd_barrier_post(unsigned* bar, volatile LAS unsigned* st) {
    XcdBarrier b; b.bar = bar; b.x = xb_xcc_id(); b.st = st;
    if (threadIdx.x == 0) (void)xb_add(&bar[XB_XCNT(b.x)], 1u);
    return b;
}
__device__ __forceinline__ void xcd_barrier_complete(unsigned* bar, unsigned x, unsigned& nloc, unsigned& nx) {
    const unsigned G = gridDim.x * gridDim.y * gridDim.z;
    unsigned sum, cnt, mine, sp = 0u;
    for (;;) {
        sum = 0u; cnt = 0u; mine = 0u;
#pragma unroll 1
        for (unsigned j = 0; j < 16; ++j) { const unsigned c = xb_ld(&bar[XB_XCNT(j)]); sum += c; cnt += (c > 0u) ? 1u : 0u; mine = (j == x) ? c : mine; }
        if (sum == G) break;
        __builtin_amdgcn_s_sleep(1);
        if ((++sp & 255u) == 0u) { if (xb_ld(&bar[XB_TMO])) break; if (sp > XB_SPIN_CAP) { atomicAdd(&bar[XB_TMO], 1u); break; } }
    }
    nloc = mine > 0u ? mine : 1u; nx = cnt > 0u ? cnt : 1u;
}

__device__ __forceinline__ void xcd_barrier(const XcdBarrier& b) {
    asm volatile("s_waitcnt vmcnt(0)" ::: "memory");
    __syncthreads();
    if (threadIdx.x == 0) {
        unsigned* bar = b.bar;
        __builtin_amdgcn_s_waitcnt(0);
        unsigned nloc = b.st[0], nx = b.st[1];
        if (nloc == 0u) { xcd_barrier_complete(bar, b.x, nloc, nx); b.st[0] = nloc; b.st[1] = nx; }
        const unsigned old = xb_add(&bar[XB_XSUB(b.x)], 1u);
        const unsigned gen = old / nloc;
        if (old + 1u == (gen + 1u) * nloc) {
            __builtin_amdgcn_fence(__ATOMIC_RELEASE, "agent");
            asm volatile("s_waitcnt vmcnt(0)" ::: "memory");
            const unsigned og = xb_add(&bar[XB_TOP], 1u);
            const unsigned tg = og / nx;
            if (og + 1u == (tg + 1u) * nx) xb_add(&bar[XB_TOPGEN], 1u);
            else XB_SPIN(xb_ld(&bar[XB_TOPGEN]) == tg, bar);
            __builtin_amdgcn_fence(__ATOMIC_ACQUIRE, "agent");
            xb_add(&bar[XB_XGEN(b.x)], 1u);
            asm volatile("s_waitcnt vmcnt(0)" ::: "memory");
        } else {
            XB_SPIN(xb_ld(&bar[XB_XGEN(b.x)]) == gen, bar);
            __builtin_amdgcn_fence(__ATOMIC_ACQUIRE, "agent");
            asm volatile("s_waitcnt vmcnt(0)" ::: "memory");
        }
    }
    __syncthreads();
}


struct KP {
    const float* x; const float* mem; const int* pos; const float* norm_g; const float* w_in; const float* lb_logits; const float* hgrn_g; const float* sink;
    const float* conv_w; const float* gate_b; const float* mlstm_g; const float* mem_g; const float* w_kv; const float* w_out; const float* final_g;
    float* out; unsigned char* ws;
};

__device__ const double INVF[8] = {1.0, 0.19392274474868576, 0.03760603093086393, 0.007292664737217109, 0.001414213562373095, 0.0002742481756762073, 5.318295896944988e-05, 1.031338537721246e-05};

struct EpiFinal {
    static constexpr bool PERM = true, AFTER_DRAIN = true;
    const bf16_t* hi; const bf16_t* lo; float* ssn; const float* fg; float* out; XcdBarrier bar;
    __device__ __forceinline__ void fused(pg8::f32x4 (&acc)[2][2][4][2], const pg8::Unit& u, int wr, int wc, int fr, int fq, PG8_LAS unsigned char*, int, int) const {
        using pg8::f32x4;
        const int row0 = u.pm * 256 + wr * 64 + fr; const int col0 = u.pn * 256 + wc * 32 + 8 * fq;
#pragma unroll
        for (int ai = 0; ai < 2; ++ai)
#pragma unroll
            for (int m = 0; m < 4; ++m) { const int r = row0 + ai * 128 + m * 16; float part = 0.f;
#pragma unroll
                for (int bj = 0; bj < 2; ++bj) { const size_t e = (size_t)r * 1024 + col0 + bj * 128;
                    const u32x4 h = *(const u32x4*)(hi + e), l = *(const u32x4*)(lo + e);
                    const f32x4 xa = (f32x4){bf2f(h.x & 0xffffu) + bf2f(l.x & 0xffffu), bf2f(h.x >> 16) + bf2f(l.x >> 16), bf2f(h.y & 0xffffu) + bf2f(l.y & 0xffffu), bf2f(h.y >> 16) + bf2f(l.y >> 16)};
                    const f32x4 xb = (f32x4){bf2f(h.z & 0xffffu) + bf2f(l.z & 0xffffu), bf2f(h.z >> 16) + bf2f(l.z >> 16), bf2f(h.w & 0xffffu) + bf2f(l.w & 0xffffu), bf2f(h.w >> 16) + bf2f(l.w >> 16)};
                    const f32x4 va = xa + acc[ai][bj][m][0], vb = xb + acc[ai][bj][m][1]; acc[ai][bj][m][0] = va; acc[ai][bj][m][1] = vb;
                    part += ((va[0] * va[0] + va[1] * va[1]) + (va[2] * va[2] + va[3] * va[3])) + ((vb[0] * vb[0] + vb[1] * vb[1]) + (vb[2] * vb[2] + vb[3] * vb[3])); }
                part += __shfl_xor(part, 16); part += __shfl_xor(part, 32);
                if (fq == 0) atomicAdd(ssn + r, part); }
        xcd_barrier(bar);
#pragma unroll
        for (int ai = 0; ai < 2; ++ai)
#pragma unroll
            for (int m = 0; m < 4; ++m) { const int r = row0 + ai * 128 + m * 16;
                const float rs = 1.0f / sqrtf(__hip_atomic_load(ssn + r, __ATOMIC_RELAXED, __HIP_MEMORY_SCOPE_AGENT) * (1.0f / 1024.f) + 1e-6f);
#pragma unroll
                for (int bj = 0; bj < 2; ++bj) { const int c = col0 + bj * 128; const f32x4 ga = *(const f32x4*)(fg + c), gb = *(const f32x4*)(fg + c + 4);
                    *(f32x4*)(out + (size_t)r * 1024 + c) = acc[ai][bj][m][0] * rs * ga; *(f32x4*)(out + (size_t)r * 1024 + c + 4) = acc[ai][bj][m][1] * rs * gb; } }
    }
};
__device__ __forceinline__ float wave_sum(float v) {
#pragma unroll
    for (int o = 1; o < 64; o <<= 1) v += __shfl_xor(v, o);
    return v;
}
__device__ __forceinline__ int new_col_to_old(int c) {
    if (c < 512) return 0 + c;
    if (c < 1024) return 2560 + (c - 512);
    if (c < 1536) return 4352 + (c - 1024);
    if (c < 2048) return 5904 + (c - 1536);
    if (c < 2560) return 512 + (c - 2048);
    if (c < 3072) return 1024 + (c - 2560);
    if (c < 3584) return 1536 + (c - 3072);
    if (c < 4096) return 2048 + (c - 3584);
    if (c < 4224) return 3072 + (c - 4096);
    if (c < 4352) return 3200 + (c - 4224);
    if (c < 4864) return 3328 + (c - 4352);
    if (c < 5120) return 3840 + (c - 4864);
    if (c < 5376) return 4096 + (c - 5120);
    if (c < 5888) return 4864 + (c - 5376);
    if (c < 6400) return 5376 + (c - 5888);
    return 6416 + (c - 6400);
}
__device__ __forceinline__ void transpose_item(const float* W, int K, int N, bf16_t* WT, int k0, int src_col0, int dst_row0, const float* kscale, LAS float* scr, int lane) {
    float wv[32];
#pragma unroll
    for (int i = 0; i < 32; ++i) { const int kk = 2 * i + (lane >> 5); wv[i] = W[(size_t)(k0 + kk) * N + src_col0 + (lane & 31)]; }
    if (kscale) {
#pragma unroll
        for (int i = 0; i < 32; ++i) wv[i] *= kscale[k0 + 2 * i + (lane >> 5)]; }
#pragma unroll
    for (int i = 0; i < 32; ++i) { const int kk = 2 * i + (lane >> 5); scr[kk * 33 + (lane & 31)] = wv[i]; }
    asm volatile("s_waitcnt lgkmcnt(0)" ::: "memory");
    const int c = lane & 7;
#pragma unroll
    for (int j = 0; j < 4; ++j) { const int n = (lane >> 3) + 8 * j; const LAS float* s = scr + (8 * c) * 33 + n;
        u32x4 o; o.x = pk2(s[0 * 33], s[1 * 33]); o.y = pk2(s[2 * 33], s[3 * 33]); o.z = pk2(s[4 * 33], s[5 * 33]); o.w = pk2(s[6 * 33], s[7 * 33]);
        *(u32x4*)(WT + (size_t)(dst_row0 + n) * K + k0 + 8 * c) = o; }
    asm volatile("s_waitcnt lgkmcnt(0)" ::: "memory");
}
__device__ __forceinline__ void convert_wtin(const KP& a, int l, LAS unsigned char* lds, int gw, int ngw, int wave, int lane) {
    LAS float* scr = (LAS float*)(lds + wave * 8448);
    bf16_t* WT = (bf16_t*)(a.ws + WS_WTIN);
    for (int it = gw; it < 16 * 216; it += ngw) { const int kb = it / 216, nbk = it % 216;
        transpose_item(a.w_in + (size_t)l * DM * DIN, DM, DIN, WT, kb * 64, new_col_to_old(nbk * 32), nbk * 32, a.norm_g + l * DM, scr, lane); }
}
__device__ __forceinline__ void gates_block(const KP& a, int l, LAS unsigned char* lds, const bf16_t* xb, const float* ss, int blk) {
    const int tid = otid(), lane = tid & 63, w = __builtin_amdgcn_readfirstlane(tid >> 6);
    float* gates = (float*)(a.ws + WS_GATES);
    LAS bf16_t* A2 = (LAS bf16_t*)lds; LAS bf16_t* B2 = A2 + 64 * 520;
    f32x4 acc = (f32x4){0.f, 0.f, 0.f, 0.f};
    for (int kh = 0; kh < 2; ++kh) {
#pragma unroll
        for (int it = 0; it < 8; ++it) { const int c = tid + it * 512; const int r = c >> 6, ch = c & 63;
            *(LAS u32x4*)(A2 + r * 520 + ch * 8) = *(const u32x4*)(xb + (size_t)(blk * 64 + r) * DM + kh * 512 + ch * 8); }
#pragma unroll
        for (int it = 0; it < 16; ++it) { const int c = tid + it * 512; const int j = c & 15, k = c >> 4; const int kg = kh * 512 + k;
            B2[j * 520 + k] = f2bf(a.w_in[((size_t)l * DM + kg) * DIN + 5888 + j] * a.norm_g[l * DM + kg]); }
        __syncthreads();
        if (w < 4) mma_nt<512>(acc, A2, 520, w * 16, B2, 520, 0, lane);
        __syncthreads();
    }
    if (w < 4) {
#pragma unroll
        for (int i = 0; i < 4; ++i) { const int r = blk * 64 + w * 16 + 4 * (lane >> 4) + i; const float rs = 1.0f / sqrtf(ss[r] * (1.0f / 1024.f) + 1e-6f);
            gates[(size_t)r * 16 + (lane & 15)] = acc[i] * rs; }
    }
}

__device__ __forceinline__ void prologue(const KP& a, LAS unsigned char* lds) {
    const int tid = otid(), lane = tid & 63, wave = __builtin_amdgcn_readfirstlane(tid >> 6);
    const int G = gridDim.x, gw = blockIdx.x * 8 + wave, ngw = G * 8;
    LAS float* scr = (LAS float*)(lds + wave * 8448);
    float* ss0 = (float*)(a.ws + WS_SS);
    bf16_t* xb = (bf16_t*)((unsigned char*)a.out + DO_XB);
    for (int blk = blockIdx.x; blk < M / 64; blk += G) {
#pragma unroll 4
        for (int rr = wave; rr < 64; rr += 8) { const int r = blk * 64 + rr;
            const f32x4* xr = (const f32x4*)(a.x + (size_t)r * DM) + 2 * lane;
            f32x4 v[4]; float s = 0.f;
#pragma unroll
            for (int j = 0; j < 4; ++j) { v[j] = xr[128 * (j >> 1) + (j & 1)]; s += (v[j][0] * v[j][0] + v[j][1] * v[j][1]) + (v[j][2] * v[j][2] + v[j][3] * v[j][3]); }
            s = wave_sum(s);
            if (lane == 0) ss0[r] = s;
            u32x4* o16 = (u32x4*)(xb + (size_t)r * DM) + lane;
#pragma unroll
            for (int j = 0; j < 2; ++j) o16[64 * j] = (u32x4){pk2(v[2 * j][0], v[2 * j][1]), pk2(v[2 * j][2], v[2 * j][3]), pk2(v[2 * j + 1][0], v[2 * j + 1][1]), pk2(v[2 * j + 1][2], v[2 * j + 1][3])};
        }
    }
    convert_wtin(a, 0, lds, gw, ngw, wave, lane);
    for (int it = gw; it < 2 * 32 * 32; it += ngw) { const int l = it >> 10, r = it & 1023, kb = r >> 5, nbk = r & 31;
        transpose_item(a.w_out + (size_t)l * 2048 * DM, 2048, DM, (bf16_t*)(a.ws + WS_WTOUT) + (size_t)l * DM * 2048, kb * 64, nbk * 32, nbk * 32, nullptr, scr, lane); }
    for (int it = gw; it < 2 * 16 * 32; it += ngw) { const int l = it >> 9, r = it & 511, kb = r >> 5, nbk = r & 31;
        transpose_item(a.w_kv + (size_t)l * DM * 1024, DM, 1024, (bf16_t*)((unsigned char*)a.out + DO_WTKV) + (size_t)l * 1024 * DM, kb * 64, nbk * 32, nbk * 32, nullptr, scr, lane); }
    for (int it = gw; it < 2 * 1024; it += ngw) { const int l = it >> 10, r = it & 1023;
        const f32x4* xr = (const f32x4*)(a.mem + (size_t)r * DM) + lane; const f32x4* gr = (const f32x4*)(a.mem_g + l * DM) + lane;
        f32x4 v[4]; float s = 0.f;
#pragma unroll
        for (int j = 0; j < 4; ++j) { v[j] = xr[64 * j]; s += (v[j][0] * v[j][0] + v[j][1] * v[j][1]) + (v[j][2] * v[j][2] + v[j][3] * v[j][3]); }
        const float rs = 1.0f / sqrtf(wave_sum(s) * (1.0f / 1024.f) + 1e-6f);
        u32x2* o8 = (u32x2*)((bf16_t*)((unsigned char*)a.out + DO_MEMN) + ((size_t)l * 1024 + r) * DM) + lane;
#pragma unroll
        for (int j = 0; j < 4; ++j) { const f32x4 g = gr[64 * j]; o8[64 * j] = (u32x2){pk2(v[j][0] * rs * g[0], v[j][1] * rs * g[1]), pk2(v[j][2] * rs * g[2], v[j][3] * rs * g[3])}; }
    }
    {
        float* cs = (float*)(a.ws + WS_CSN); float* sn = cs + (size_t)M * 8;
        for (int i = blockIdx.x * 512 + tid; i < M * 8; i += G * 512) { const int t = i >> 3, j = i & 7;
            const double inv = INVF[j];
            const double ang = (double)a.pos[t] * inv;
            const double kq = rint(ang * 0.15915494309189535);
            const float r = (float)fma(-kq, 1.2246467991473532e-16 * 2.0, fma(-kq, 6.283185307179586, ang));
            cs[i] = cosf(r); sn[i] = sinf(r); }
        if (blockIdx.x == 0) { float* lb = (float*)(a.ws + WS_LB);
            const float l0 = a.lb_logits[tid], l1 = a.lb_logits[512 + tid]; const float m = fmaxf(l0, l1); const float e0 = __expf(l0 - m), e1 = __expf(l1 - m);
            lb[tid] = 0.f; lb[512 + tid] = e1 / (e0 + e1); }
    }
    __syncthreads();
}

__device__ __forceinline__ MP make_mp(const KP& a, int l) {
    MP p;
    p.u = (bf16_t*)(a.ws + WS_U); p.gates = (const float*)(a.ws + WS_GATES); p.kv = (const bf16_t*)(a.ws + WS_KV) + (size_t)l * 1024 * 1024;
    p.cs = (const float*)(a.ws + WS_CSN); p.sn = p.cs + (size_t)M * 8; p.lb = (const float*)(a.ws + WS_LB) + l * 512;
    p.hgrn_g = a.hgrn_g + l * 512; p.sink = a.sink + l * 8; p.conv_w = a.conv_w + (size_t)l * 5 * 512; p.gate_b = a.gate_b + l * 16; p.mlstm_g = a.mlstm_g + l * 512;
    p.SA = (bf16_t*)(a.ws + WS_SA); p.DA = (float*)(a.ws + WS_DA); p.SC = (bf16_t*)(a.ws + WS_SC); p.CS = (float*)(a.ws + WS_CS); p.nb = NB;
    return p;
}

#ifndef REP_STEP
#define REP_STEP 0
#endif
#ifndef REP_N
#define REP_N 3
#endif
#ifndef STEP_MASK
#define STEP_MASK 0xffff
#endif
#define ST_ON(i) ((STEP_MASK >> (i)) & 1)
#ifndef PROBE
#define PROBE 0
#endif
#ifndef PROBE_A
#define PROBE_A 1
#endif
#ifndef PROBE_B
#define PROBE_B 2
#endif
constexpr size_t WS_TS = 32 * 1024;

__device__ __forceinline__ int opq(int v) { asm volatile("" : "+s"(v)); return v; }
__device__ __forceinline__ void step_gates(const KP& a, int l, LAS unsigned char* lds) {
    const int G = gridDim.x;
    const bf16_t* xb = (const bf16_t*)((unsigned char*)a.out + DO_XB);
    const float* ss = (const float*)(a.ws + WS_SS) + (size_t)l * M;
    for (int blk = blockIdx.x; blk < M / 64; blk += G) gates_block(a, l, lds, xb, ss, blk);
    __syncthreads();
}
__device__ __forceinline__ void step_g1(const KP& a, int l, LAS unsigned char* lds) {
    const int G = gridDim.x;
    const bf16_t* xb = (const bf16_t*)((unsigned char*)a.out + DO_XB);
    const float* ss = (const float*)(a.ws + WS_SS) + (size_t)l * M;
    {
        pg8::Gemm g{xb, (const bf16_t*)(a.ws + WS_WTIN), M, NU, DM, DM};
        pg8::StaticOrder S; S.init(M, NU, G, (int)blockIdx.x);
        pg8::EpiIn E{(bf16_t*)(a.ws + WS_U), NU, ss};
        pg8::gemm_phase<pg8::EpiIn, pg8::StaticOrder, true, true>((PG8_LAS unsigned char*)lds, g, S, E);
    }
    if (l == 0) {
        __syncthreads();
        pg8::Gemm g{(const bf16_t*)((unsigned char*)a.out + DO_MEMN), (const bf16_t*)((unsigned char*)a.out + DO_WTKV), 2048, 2048, DM, DM};
        pg8::KvOrder S{(int)blockIdx.x, G - 64 > 0 ? G - 64 : 0};
        pg8::EpiKv E{(bf16_t*)(a.ws + WS_KV)};
        pg8::gemm_phase<pg8::EpiKv, pg8::KvOrder, false, true>((PG8_LAS unsigned char*)lds, g, S, E);
    }
}
__device__ __forceinline__ void step_g2(const KP& a, int l, LAS unsigned char* lds, const XcdBarrier& xb, int dry = 0) {
    const int G = gridDim.x;
    pg8::Gemm g{(const bf16_t*)(a.ws + WS_U), (const bf16_t*)(a.ws + WS_WTOUT) + (size_t)l * DM * 2048, M, DM, 2048, NU};
    pg8::StaticOrder S; S.init(M, DM, G, (int)blockIdx.x);
    bf16_t* hi = (bf16_t*)((unsigned char*)a.out + DO_XB); bf16_t* lo = (bf16_t*)((unsigned char*)a.out + DO_LO);
    float* ssn = (float*)(a.ws + WS_SS) + (size_t)(l + 1) * M;
    if (l == 0) { pg8::EpiOut<0> E{a.x, hi, lo, nullptr, 0, 0, ssn, dry}; pg8::gemm_phase<pg8::EpiOut<0>, pg8::StaticOrder, true, true>((PG8_LAS unsigned char*)lds, g, S, E); }
    else {
#if PROBE || (REP_STEP != 0)
        pg8::EpiOut<1> E{nullptr, hi, lo, (float*)(a.ws + WS_U), NU / 2, 1024, ssn, dry}; pg8::gemm_phase<pg8::EpiOut<1>, pg8::StaticOrder, true, true>((PG8_LAS unsigned char*)lds, g, S, E);
#else
        EpiFinal E{hi, lo, ssn, a.final_g, a.out, xb}; pg8::gemm_phase<EpiFinal, pg8::StaticOrder, false, true>((PG8_LAS unsigned char*)lds, g, S, E);
#endif
    }
}
__device__ __forceinline__ void step_final(const KP& a, float oscale = 1.0f) {
    const int tid = otid(), lane = tid & 63, wave = __builtin_amdgcn_readfirstlane(tid >> 6);
    const int gw = blockIdx.x * 8 + wave, ngw = gridDim.x * 8;
    const float* ss2 = (const float*)(a.ws + WS_SS) + (size_t)2 * M;
    const float* x2 = (const float*)(a.ws + WS_U);
    for (int r = gw; r < M; r += ngw) {
        const float rs = 1.0f / sqrtf(ss2[r] * (1.0f / 1024.f) + 1e-6f);
        const f32x4* xr = (const f32x4*)(x2 + (size_t)r * (NU / 2) + 1024) + lane; const f32x4* gr = (const f32x4*)a.final_g + lane;
        f32x4* orow = (f32x4*)(a.out + (size_t)r * DM) + lane;
#pragma unroll
        for (int j = 0; j < 4; ++j) { const f32x4 v = xr[64 * j], g = gr[64 * j]; orow[64 * j] = v * (rs * oscale) * g; }
    }
}

__global__ void __launch_bounds__(512, 2) mega_fwd(KP a) {
    extern __shared__ __attribute__((aligned(16))) unsigned char lds_raw[];
    LAS unsigned char* lds = (LAS unsigned char*)lds_raw;
    cg::grid_group grid = cg::this_grid();
    volatile LAS unsigned* xst = (volatile LAS unsigned*)(lds + LDS_BYTES - 16);
    if (threadIdx.x < 4) xst[threadIdx.x] = 0u;
    __syncthreads();
    XcdBarrier xbar = xcd_barrier_post((unsigned*)(a.ws + WS_BAR), xst);
    const int G = gridDim.x;
    const int vcu = (G % 8 == 0) ? (int)(blockIdx.x % 8) * (G / 8) + (int)(blockIdx.x / 8) : (int)blockIdx.x;
#if PROBE
    unsigned long long* ts = (unsigned long long*)(a.ws + WS_TS); int nst = 0;
#define STAMP() do { if (blockIdx.x == 0 && threadIdx.x == 0) ts[nst] = __builtin_amdgcn_s_memrealtime(); ++nst; } while (0)
#define PSEAM() do { xcd_barrier(xbar); STAMP(); } while (0)
    STAMP();
#else
#define STAMP() do {} while (0)
#define PSEAM() do {} while (0)
#endif
#define SEAM() do { xcd_barrier(xbar); STAMP(); } while (0)
    if (REP_STEP == 1) { for (int r = 0, rn = opq(REP_N - 1); r < rn; ++r) prologue(a, lds); }
    if (ST_ON(0)) prologue(a, lds);
    if (a.ws == nullptr) grid.sync();
    xcd_barrier(xbar); STAMP();
    if (REP_STEP == 13) { for (int r = 0, rn = opq(20); r < rn; ++r) xcd_barrier(xbar); }
    if (REP_STEP == 14) { for (int r = 0, rn = opq(4); r < rn; ++r) grid.sync(); }
#pragma unroll 1
    for (int l = 0; l < 2; ++l) {
        if (REP_STEP == 2 && l == 0) { for (int r = 0, rn = opq(REP_N - 1); r < rn; ++r) step_gates(a, l, lds); }
        if (ST_ON(1)) step_gates(a, l, lds); PSEAM();
        if (REP_STEP == 3 && l == 0) { for (int r = 0, rn = opq(REP_N - 1); r < rn; ++r) step_g1(a, l, lds); }
        if (ST_ON(2)) step_g1(a, l, lds); SEAM();
        {
            const MP p = make_mp(a, l);
            if (ST_ON(3)) for (int blk = blockIdx.x; blk < M / 64; blk += G) { pre_load(p, lds, blk); xcd_barrier(xbar); pre_write(p, lds, blk); }
            xcd_barrier(xbar);
#if PROBE
            if (blockIdx.x == 0 && threadIdx.x == 0) ts[50 + l] = __builtin_amdgcn_s_memrealtime();
#endif
            const int nB = NB * 128, nA = NB * 128, nC = NB * 128, nD = NB * 64;
#if PROBE
            for (int it = blockIdx.x; it < nB; it += G) b_item(p, lds, it);
            PSEAM();
            for (int it = blockIdx.x; it < nA; it += G) a_pass1(p, lds, it);
            PSEAM();
            for (int it = blockIdx.x; it < nC; it += G) c_pass1(p, lds, it);
            PSEAM();
            for (int it = blockIdx.x; it < nD; it += G) d_item(p, lds, it);
#else
            if (l == 0 && REP_STEP >= 4 && REP_STEP <= 7) { for (int r = 0, rn = opq(REP_N - 1); r < rn; ++r) { const bool dry = opq(1) != 0;
                if (REP_STEP == 4) for (int it = blockIdx.x; it < nB; it += G) b_item(p, lds, it, dry);
                if (REP_STEP == 5) for (int it = blockIdx.x; it < nA; it += G) a_pass1(p, lds, it);
                if (REP_STEP == 6) for (int it = blockIdx.x; it < nC; it += G) c_pass1(p, lds, it);
                if (REP_STEP == 7) for (int it = blockIdx.x; it < nD; it += G) d_item(p, lds, it, dry); } }
            for (int it = vcu; it < nB + nA + nC + nD; it += G) {
                if (it < nB) { if (ST_ON(4)) b_item(p, lds, it); }
                else if (it < nB + nA) { if (ST_ON(5)) a_pass1(p, lds, it - nB); }
                else if (it < nB + nA + nC) { if (ST_ON(6)) c_pass1(p, lds, it - nB - nA); }
                else { if (ST_ON(7)) d_item(p, lds, it - nB - nA - nC); }
            }
#endif
            SEAM();
            {
                const int nAu = NB * 8 * 4096, nCu = NB * 8 * 2304;
                if (l == 0 && REP_STEP == 8) { for (int r = 0, rn = opq(REP_N - 1); r < rn; ++r) { const bool dry = opq(1) != 0;
                    for (int uu = blockIdx.x * 512 + otid(); uu < nAu + nCu; uu += G * 512) { if (uu < nAu) a_scan_unit(p, uu, dry); else c_scan_unit(p, uu - nAu, dry); } } }
                for (int uu = blockIdx.x * 512 + otid(); uu < nAu + nCu; uu += G * 512) { if (uu < nAu) a_scan_unit(p, uu); else c_scan_unit(p, uu - nAu); }
            }
            SEAM();
#if PROBE
            for (int it = blockIdx.x; it < NB * 64; it += G) a_pass3(p, lds, it);
            PSEAM();
            for (int it = blockIdx.x; it < NB * 64; it += G) c_pass3(p, lds, it);
#else
            if (l == 0 && (REP_STEP == 9 || REP_STEP == 10)) { for (int r = 0, rn = opq(REP_N - 1); r < rn; ++r) { const bool dry = opq(1) != 0;
                if (REP_STEP == 9) for (int it = blockIdx.x; it < NB * 64; it += G) a_pass3(p, lds, it, dry);
                if (REP_STEP == 10) for (int it = blockIdx.x; it < NB * 64; it += G) c_pass3(p, lds, it, dry); } }
            for (int it = blockIdx.x; it < NB * 128; it += G) { if (it < NB * 64) { if (ST_ON(9)) a_pass3(p, lds, it); } else { if (ST_ON(10)) c_pass3(p, lds, it - NB * 64); } }
#endif
            SEAM();
        }
        if (l == 0) { const int tid = otid(); convert_wtin(a, 1, lds, blockIdx.x * 8 + (tid >> 6), G * 8, __builtin_amdgcn_readfirstlane(tid >> 6), tid & 63); __syncthreads(); PSEAM(); }
        if (REP_STEP == 12 && l == 0) { for (int r = 0, rn = opq(REP_N - 1); r < rn; ++r) { step_g2(a, l, lds, xbar, opq(1)); } }
#if PROBE || (REP_STEP != 0)
        step_g2(a, l, lds, xbar); SEAM();
#else
        step_g2(a, l, lds, xbar); if (l == 0) SEAM();
#endif
    }
#if PROBE == 2
    {
        xcd_barrier(xbar);
        const unsigned long long* tsx = (PROBE_A >= 100) ? (const unsigned long long*)((const float*)(a.ws + WS_CS) + 4096) - 100 : ts;
        const float d = (float)(tsx[PROBE_B] - tsx[PROBE_A]) * 0.01f;
        step_final(a, 1.0f + sqrtf(d * 2e-7f));
    }
#elif PROBE
    {
        const float dA = (float)(ts[PROBE_A] - ts[PROBE_A - 1]) * 0.01f, dB = (float)(ts[PROBE_B] - ts[PROBE_B - 1]) * 0.01f;
        const float c = sqrtf(dA * 0.1f);
        for (size_t i = (size_t)blockIdx.x * 512 + threadIdx.x; i < (size_t)M * DM; i += (size_t)G * 512) a.out[i] = (i == 0) ? (20.f + dB) : c;
    }
#elif (REP_STEP != 0)
    step_final(a);
#endif
}
}

extern "C" void kernel_launch(void* const* d_in, const int* in_sizes, int n_in,
                              void* d_out, int out_size, void* d_ws, size_t ws_size,
                              hipStream_t stream) {
    using namespace fr;
    static int grid_blocks = 0;
    if (!grid_blocks) {
        int dev = 0, cus = 0, per_cu = 0;
        (void)hipGetDevice(&dev);
        (void)hipDeviceGetAttribute(&cus, hipDeviceAttributeMultiprocessorCount, dev);
        (void)hipFuncSetAttribute((const void*)mega_fwd, hipFuncAttributeMaxDynamicSharedMemorySize, LDS_BYTES);
        (void)hipOccupancyMaxActiveBlocksPerMultiprocessor(&per_cu, (const void*)mega_fwd, 512, LDS_BYTES);
        if (per_cu < 1) per_cu = 1;
        grid_blocks = cus * (per_cu > 1 ? 1 : per_cu);
    }
    KP a{};
    a.x = (const float*)d_in[0]; a.mem = (const float*)d_in[1]; a.pos = (const int*)d_in[2]; a.norm_g = (const float*)d_in[3]; a.w_in = (const float*)d_in[4];
    a.lb_logits = (const float*)d_in[5]; a.hgrn_g = (const float*)d_in[6]; a.sink = (const float*)d_in[7]; a.conv_w = (const float*)d_in[8]; a.gate_b = (const float*)d_in[9];
    a.mlstm_g = (const float*)d_in[10]; a.mem_g = (const float*)d_in[11]; a.w_kv = (const float*)d_in[12]; a.w_out = (const float*)d_in[13]; a.final_g = (const float*)d_in[14];
    a.out = (float*)d_out; a.ws = (unsigned char*)d_ws;
    (void)hipMemsetAsync((char*)d_ws + WS_CTL, 0, CTL_ZERO_BYTES, stream);
    void* args[] = {&a};
    (void)hipLaunchCooperativeKernel((const void*)mega_fwd, dim3(grid_blocks), dim3(512), args, LDS_BYTES, stream);
}
```

```cpp
#include <hip/hip_runtime.h>
#include <math.h>
namespace pg8 {
#define PG8_LAS __attribute__((address_space(3)))
typedef unsigned short bf16_t;
typedef short bf16x8 __attribute__((ext_vector_type(8)));
typedef float f32x4 __attribute__((ext_vector_type(4)));
typedef unsigned u32x4 __attribute__((ext_vector_type(4)));
constexpr int BM = 256, BK = 64, HALF = 128, HTB = HALF * BK * 2  , STAGE_BYTES = 8 * HTB, NXCD = 8, WGM = 8;

__host__ __device__ __forceinline__ int lds_byte(int r, int c) { const int st = (r >> 4) * 2 + (c >> 5), rr = r & 15, cc = c & 31, ob = rr * 64 + cc * 2; return st * 1024 + (ob ^ (((ob >> 9) & 1) << 5)); }
__host__ __device__ __forceinline__ void stage_rc(int b, int& R, int& C) { const int st = b / 1024, sb = b % 1024, swz = sb ^ (((sb >> 9) & 1) << 5); R = (st >> 1) * 16 + swz / 64; C = (st & 1) * 32 + (swz % 64) / 2; }
__host__ __device__ __forceinline__ int perm32(int rho) { const int n = rho >> 4, i = rho & 15; return 8 * (i >> 2) + 4 * n + (i & 3); }

struct Unit { int pm, pn; };
struct Gemm { const bf16_t* A; const bf16_t* Bt; int M, N, K, lda; };

struct StaticOrder {
    int nM, nN, nwg, G, c;
    __host__ __device__ void init(int M, int N, int G_, int c_) { nM = M / BM; nN = N / BM; nwg = nM * nN; G = G_; c = c_; }
    __host__ __device__ bool next(int i, Unit& u) const {
        const long L = (long)i * G + c; if (L >= nwg) return false;
        int wgid = (int)L; { const int q = nwg / NXCD, r = nwg % NXCD, xcd = wgid % NXCD, off = wgid / NXCD; wgid = (xcd < r ? xcd * (q + 1) : r * (q + 1) + (xcd - r) * q) + off; }
        const int nig = WGM * nN, gid = wgid / nig, fm = gid * WGM, gsz = (nM - fm) < WGM ? (nM - fm) : WGM;
        u.pm = fm + ((wgid % nig) % gsz); u.pn = (wgid % nig) / gsz; return true;
    }
    __device__ __forceinline__ void a_ready(const Unit&) const {}
    __device__ __forceinline__ void done(const Unit&) const {}
};

__device__ __forceinline__ unsigned cvt_pk_bf16(float lo, float hi) { unsigned r; asm volatile("v_cvt_pk_bf16_f32 %0, %1, %2" : "=v"(r) : "v"(lo), "v"(hi)); return r; }

__device__ __forceinline__ float bf2f_(unsigned h16) { return __uint_as_float(h16 << 16); }
struct EpiIn {
    static constexpr bool PERM = true, AFTER_DRAIN = false;
    bf16_t* O; int ldc; const float* ss;
    __device__ __forceinline__ void operator()(const f32x4 (&acc)[2][2][4][2], const Unit& u, int wr, int wc, int fr, int fq) const {
        const int row0 = u.pm * BM + wr * 64 + fr; const int col0 = u.pn * BM + wc * 32 + 8 * fq;
#pragma unroll
        for (int ai = 0; ai < 2; ++ai)
#pragma unroll
            for (int m = 0; m < 4; ++m) { const int r = row0 + ai * HALF + m * 16; const float rs = 1.0f / sqrtf(ss[r] * (1.0f / 1024.f) + 1e-6f);
                bf16_t* rowp = O + (size_t)r * ldc + col0;
#pragma unroll
                for (int bj = 0; bj < 2; ++bj) { const f32x4 v0 = acc[ai][bj][m][0] * rs, v1 = acc[ai][bj][m][1] * rs;
                    u32x4 w; w.x = cvt_pk_bf16(v0[0], v0[1]); w.y = cvt_pk_bf16(v0[2], v0[3]); w.z = cvt_pk_bf16(v1[0], v1[1]); w.w = cvt_pk_bf16(v1[2], v1[3]);
                    *(u32x4*)(rowp + bj * HALF) = w; } }
    }
};
struct EpiKv {
    static constexpr bool PERM = true, AFTER_DRAIN = false;
    bf16_t* O;
    __device__ __forceinline__ void operator()(const f32x4 (&acc)[2][2][4][2], const Unit& u, int wr, int wc, int fr, int fq) const {
        const int l = u.pm >> 2, rl0 = (u.pm & 3) * BM + wr * 64 + fr; const int col0 = (u.pn & 3) * BM + wc * 32 + 8 * fq;
        bf16_t* Ol = O + (size_t)l * 1024 * 1024;
#pragma unroll
        for (int ai = 0; ai < 2; ++ai)
#pragma unroll
            for (int m = 0; m < 4; ++m) { const int r = rl0 + ai * HALF + m * 16;
#pragma unroll
                for (int bj = 0; bj < 2; ++bj) { const f32x4 v0 = acc[ai][bj][m][0], v1 = acc[ai][bj][m][1]; const int c = col0 + bj * HALF;
                    u32x4 w; w.x = cvt_pk_bf16(v0[0], v0[1]); w.y = cvt_pk_bf16(v0[2], v0[3]); w.z = cvt_pk_bf16(v1[0], v1[1]); w.w = cvt_pk_bf16(v1[2], v1[3]);
                    if (c < 512) *(u32x4*)(Ol + (size_t)r * 512 + c) = w;
                    else { bf16_t* vt = Ol + 512 * 1024 + ((size_t)(r >> 8) * 512 + (c - 512)) * 256 + (r & 255);
                        vt[0 * 256] = (bf16_t)(w.x & 0xffffu); vt[1 * 256] = (bf16_t)(w.x >> 16); vt[2 * 256] = (bf16_t)(w.y & 0xffffu); vt[3 * 256] = (bf16_t)(w.y >> 16);
                        vt[4 * 256] = (bf16_t)(w.z & 0xffffu); vt[5 * 256] = (bf16_t)(w.z >> 16); vt[6 * 256] = (bf16_t)(w.w & 0xffffu); vt[7 * 256] = (bf16_t)(w.w >> 16); } } }
    }
};
typedef unsigned u32x2e __attribute__((ext_vector_type(2)));
template <int LAYER> struct EpiOut {
    static constexpr bool PERM = true, AFTER_DRAIN = false;
    const float* x0; bf16_t* hi; bf16_t* lo; float* x2; int xs, xo; float* ssn; int dry;
    __device__ __forceinline__ void operator()(const f32x4 (&acc)[2][2][4][2], const Unit& u, int wr, int wc, int fr, int fq) const {
        const int row0 = u.pm * BM + wr * 64 + fr; const int col0 = u.pn * BM + wc * 32 + 8 * fq;
#pragma unroll
        for (int ai = 0; ai < 2; ++ai)
#pragma unroll
            for (int m = 0; m < 4; ++m) { const int r = row0 + ai * HALF + m * 16; float part = 0.f;
#pragma unroll
                for (int bj = 0; bj < 2; ++bj) { const int c = col0 + bj * HALF; const size_t e = (size_t)r * 1024 + c;
                    f32x4 xa, xb;
                    if (LAYER == 0) { xa = *(const f32x4*)(x0 + e); xb = *(const f32x4*)(x0 + e + 4); }
                    else { const u32x4 h = *(const u32x4*)(hi + e), l = *(const u32x4*)(lo + e);
                        xa = (f32x4){bf2f_(h.x & 0xffffu) + bf2f_(l.x & 0xffffu), bf2f_(h.x >> 16) + bf2f_(l.x >> 16), bf2f_(h.y & 0xffffu) + bf2f_(l.y & 0xffffu), bf2f_(h.y >> 16) + bf2f_(l.y >> 16)};
                        xb = (f32x4){bf2f_(h.z & 0xffffu) + bf2f_(l.z & 0xffffu), bf2f_(h.z >> 16) + bf2f_(l.z >> 16), bf2f_(h.w & 0xffffu) + bf2f_(l.w & 0xffffu), bf2f_(h.w >> 16) + bf2f_(l.w >> 16)}; }
                    const f32x4 va = xa + acc[ai][bj][m][0], vb = xb + acc[ai][bj][m][1];
                    part += ((va[0] * va[0] + va[1] * va[1]) + (va[2] * va[2] + va[3] * va[3])) + ((vb[0] * vb[0] + vb[1] * vb[1]) + (vb[2] * vb[2] + vb[3] * vb[3]));
                    if (LAYER == 0) {
                        u32x4 hw; hw.x = cvt_pk_bf16(va[0], va[1]); hw.y = cvt_pk_bf16(va[2], va[3]); hw.z = cvt_pk_bf16(vb[0], vb[1]); hw.w = cvt_pk_bf16(vb[2], vb[3]);
                        const f32x4 da = va - (f32x4){bf2f_(hw.x & 0xffffu), bf2f_(hw.x >> 16), bf2f_(hw.y & 0xffffu), bf2f_(hw.y >> 16)};
                        const f32x4 db = vb - (f32x4){bf2f_(hw.z & 0xffffu), bf2f_(hw.z >> 16), bf2f_(hw.w & 0xffffu), bf2f_(hw.w >> 16)};
                        u32x4 lw; lw.x = cvt_pk_bf16(da[0], da[1]); lw.y = cvt_pk_bf16(da[2], da[3]); lw.z = cvt_pk_bf16(db[0], db[1]); lw.w = cvt_pk_bf16(db[2], db[3]);
                        if (!dry) { *(u32x4*)(hi + e) = hw; *(u32x4*)(lo + e) = lw; }
                    } else { if (!dry) { *(f32x4*)(x2 + (size_t)r * xs + xo + c) = va; *(f32x4*)(x2 + (size_t)r * xs + xo + c + 4) = vb; } } }
                part += __shfl_xor(part, 16); part += __shfl_xor(part, 32);
                if (fq == 0 && !dry) atomicAdd(ssn + r, part); }
    }
};
struct KvOrder {
    int c, c0;
    __device__ bool next(int i, Unit& u) const { const int t = c - c0; if (i != 0 || t < 0 || t >= 32) return false; const int l = t >> 4; u.pm = l * 4 + ((t >> 2) & 3); u.pn = l * 4 + (t & 3); return true; }
    __device__ __forceinline__ void a_ready(const Unit&) const {}
    __device__ __forceinline__ void done(const Unit&) const {}
};

template <class Epi, class Sched, bool ALIGN_EPI = false, bool SP2 = false>
__device__ __forceinline__ void gemm_phase(PG8_LAS unsigned char* lds, const Gemm g, const Sched& S, const Epi& E) {
    int tid = threadIdx.x; asm volatile("" : "+v"(tid)); const int wid = __builtin_amdgcn_readfirstlane(tid >> 6), lane = tid & 63, wr = wid >> 2, wc = wid & 3, fr = lane & 15, fq = lane >> 4;
    const int K = g.K, nt = K / BK;
    unsigned voffA[2], voffB[2];
#pragma unroll
    for (int i = 0; i < 2; ++i) { int R, C; stage_rc(tid * 16 + i * 8192, R, C); const int Rb = Epi::PERM ? ((R & ~31) + perm32(R & 31)) : R;
        voffA[i] = (unsigned)(R * g.lda + C) * 2u; voffB[i] = (unsigned)(Rb * K + C) * 2u; }
    const size_t kstep = (size_t)(BK * 2);
    const size_t hstep = (size_t)HALF * K * 2, hstepA = (size_t)HALF * g.lda * 2;
    const size_t tstep = 2 * hstep, tstepA = 2 * hstepA;
    const unsigned ldsw = (unsigned)wid * 1024u;
    const int aoff = lds_byte(wr * 64 + fr, fq * 8), boff = lds_byte(wc * 32 + fr, fq * 8);
#define PG8_SA(b, h) (((b) * 2 + (h)) * HTB)
#define PG8_SB(b, h) ((4 + (b) * 2 + (h)) * HTB)
#define PG8_STAGE(bufoff, gbase, voff) do { _Pragma("unroll") for (int _i = 0; _i < 2; ++_i) \
        __builtin_amdgcn_global_load_lds((const unsigned*)((const char*)(gbase) + (voff)[_i]), (PG8_LAS unsigned*)(lds + (bufoff) + ldsw + _i * 8192), 16, 0, 0); } while (0)
#define PG8_LDA(dst, b, h) do { _Pragma("unroll") for (int m = 0; m < 4; ++m) _Pragma("unroll") for (int k = 0; k < 2; ++k) dst[m][k] = *(const PG8_LAS bf16x8*)(lds + PG8_SA(b, h) + aoff + m * 2048 + k * 1024); } while (0)
#define PG8_LDB(dst, b, h) do { _Pragma("unroll") for (int n = 0; n < 2; ++n) _Pragma("unroll") for (int k = 0; k < 2; ++k) dst[n][k] = *(const PG8_LAS bf16x8*)(lds + PG8_SB(b, h) + boff + n * 2048 + k * 1024); } while (0)
#define PG8_MMA(ai, bj, At, Bt) do { __builtin_amdgcn_s_setprio(1); _Pragma("unroll") for (int m = 0; m < 4; ++m) _Pragma("unroll") for (int n = 0; n < 2; ++n) _Pragma("unroll") for (int k = 0; k < 2; ++k) \
        acc[ai][bj][m][n] = __builtin_amdgcn_mfma_f32_16x16x32_bf16(Bt[n][k], At[m][k], acc[ai][bj][m][n], 0, 0, 0); __builtin_amdgcn_s_setprio(0); } while (0)
#define PG8_WAIT_V(n) asm volatile("s_waitcnt vmcnt(" #n ")" ::: "memory")
#define PG8_WAIT_L(n) asm volatile("s_waitcnt lgkmcnt(" #n ")" ::: "memory")
#define PG8_BAR __builtin_amdgcn_s_barrier()
#define PG8_SCHED __builtin_amdgcn_sched_barrier(0)
    Unit cur, nxt; int ui = 0;
    if (!S.next(0, cur)) return;
    f32x4 acc[2][2][4][2];
#pragma unroll
    for (int a = 0; a < 2; ++a)
#pragma unroll
        for (int b = 0; b < 2; ++b)
#pragma unroll
            for (int m = 0; m < 4; ++m)
#pragma unroll
                for (int n = 0; n < 2; ++n) acc[a][b][m][n] = (f32x4){0.f, 0.f, 0.f, 0.f};
    bf16x8 At[4][2], B0[2][2], B1[2][2];
    const char* cA = (const char*)g.A + (size_t)cur.pm * tstepA; const char* cB = (const char*)g.Bt + (size_t)cur.pn * tstep;
    S.a_ready(cur);
    if constexpr (SP2) {
        PG8_STAGE(PG8_SB(0, 0), cB, voffB); PG8_STAGE(PG8_SB(0, 1), cB + hstep, voffB); PG8_STAGE(PG8_SA(0, 0), cA, voffA); PG8_STAGE(PG8_SA(0, 1), cA + hstepA, voffA);
        if (wr == 1) PG8_BAR;
        PG8_WAIT_V(2); PG8_BAR;
        PG8_STAGE(PG8_SB(1, 0), cB + kstep, voffB); PG8_STAGE(PG8_SA(1, 0), cA + kstep, voffA); PG8_STAGE(PG8_SB(1, 1), cB + hstep + kstep, voffB);
        PG8_WAIT_V(6); PG8_BAR;
    } else {
        PG8_STAGE(PG8_SB(0, 0), cB, voffB); PG8_STAGE(PG8_SA(0, 0), cA, voffA); PG8_STAGE(PG8_SB(0, 1), cB + hstep, voffB); PG8_STAGE(PG8_SA(0, 1), cA + hstepA, voffA);
        if (wr == 1) PG8_BAR;
        PG8_WAIT_V(4); PG8_BAR;
        PG8_STAGE(PG8_SB(1, 0), cB + kstep, voffB); PG8_STAGE(PG8_SA(1, 0), cA + kstep, voffA); PG8_STAGE(PG8_SB(1, 1), cB + hstep + kstep, voffB);
        PG8_WAIT_V(6); PG8_BAR;
    }
    for (;;) {
        const bool has_next = S.next(ui + 1, nxt);
        const char* nA = has_next ? (const char*)g.A + (size_t)nxt.pm * tstepA : cA; const char* nB = has_next ? (const char*)g.Bt + (size_t)nxt.pn * tstep : cB;
        for (int t = 0; t < nt; t += 2) {
            const bool last = (t == nt - 2);
            const char* a1 = cA + (size_t)(t + 1) * kstep;
            const char* a2 = last ? nA : cA + (size_t)(t + 2) * kstep; const char* b2 = last ? nB : cB + (size_t)(t + 2) * kstep;
            const char* a3 = a2 + kstep; const char* b3 = b2 + kstep;
            if (last && has_next) S.a_ready(nxt);
            if constexpr (SP2) {
            PG8_LDB(B0, 0, 0); PG8_LDB(B1, 0, 1); PG8_SCHED; PG8_LDA(At, 0, 0); PG8_STAGE(PG8_SA(1, 1), a1 + hstepA, voffA);
            PG8_WAIT_V(8); PG8_WAIT_L(0); PG8_BAR; PG8_MMA(0, 0, At, B0); PG8_MMA(0, 1, At, B1); PG8_BAR; PG8_SCHED;
            PG8_LDA(At, 0, 1); PG8_STAGE(PG8_SB(0, 0), b2, voffB); PG8_STAGE(PG8_SB(0, 1), b2 + hstep, voffB); PG8_STAGE(PG8_SA(0, 0), a2, voffA);
            PG8_WAIT_V(8); PG8_WAIT_L(0); PG8_BAR; PG8_MMA(1, 0, At, B0); PG8_MMA(1, 1, At, B1); PG8_BAR; PG8_SCHED;
            PG8_LDB(B0, 1, 0); PG8_LDB(B1, 1, 1); PG8_SCHED; PG8_LDA(At, 1, 0); PG8_STAGE(PG8_SA(0, 1), a2 + hstepA, voffA);
            PG8_WAIT_V(8); PG8_WAIT_L(0); PG8_BAR; PG8_MMA(0, 0, At, B0); PG8_MMA(0, 1, At, B1); PG8_BAR; PG8_SCHED;
            PG8_LDA(At, 1, 1); PG8_STAGE(PG8_SB(1, 0), b3, voffB); PG8_STAGE(PG8_SB(1, 1), b3 + hstep, voffB); PG8_STAGE(PG8_SA(1, 0), a3, voffA);
            PG8_WAIT_V(8); PG8_WAIT_L(0); PG8_BAR; PG8_MMA(1, 0, At, B0); PG8_MMA(1, 1, At, B1); PG8_BAR; PG8_SCHED;
            } else {
            PG8_LDB(B0, 0, 0); PG8_SCHED; PG8_LDA(At, 0, 0); PG8_STAGE(PG8_SA(1, 1), a1 + hstepA, voffA);
            PG8_WAIT_L(8); PG8_BAR; PG8_WAIT_L(0); PG8_MMA(0, 0, At, B0); PG8_BAR; PG8_SCHED;
            PG8_LDB(B1, 0, 1); PG8_STAGE(PG8_SB(0, 0), b2, voffB);
            PG8_BAR; PG8_WAIT_L(0); PG8_MMA(0, 1, At, B1); PG8_BAR;
            PG8_LDA(At, 0, 1); PG8_STAGE(PG8_SA(0, 0), a2, voffA);
            PG8_BAR; PG8_WAIT_L(0); PG8_MMA(1, 0, At, B0); PG8_BAR; PG8_SCHED;
            PG8_STAGE(PG8_SB(0, 1), b2 + hstep, voffB);
            PG8_WAIT_V(6); PG8_BAR; PG8_MMA(1, 1, At, B1); PG8_BAR;
            PG8_LDB(B0, 1, 0); PG8_SCHED; PG8_LDA(At, 1, 0); PG8_STAGE(PG8_SA(0, 1), a2 + hstepA, voffA);
            PG8_WAIT_L(8); PG8_BAR; PG8_WAIT_L(0); PG8_MMA(0, 0, At, B0); PG8_BAR; PG8_SCHED;
            PG8_LDB(B1, 1, 1); PG8_STAGE(PG8_SB(1, 0), b3, voffB);
            PG8_BAR; PG8_WAIT_L(0); PG8_MMA(0, 1, At, B1); PG8_BAR;
            PG8_LDA(At, 1, 1); PG8_STAGE(PG8_SA(1, 0), a3, voffA);
            PG8_BAR; PG8_WAIT_L(0); PG8_MMA(1, 0, At, B0); PG8_BAR; PG8_SCHED;
            PG8_STAGE(PG8_SB(1, 1), b3 + hstep, voffB);
            PG8_WAIT_V(6); PG8_BAR; PG8_MMA(1, 1, At, B1); PG8_BAR;
            }
        }
        if constexpr (ALIGN_EPI) { if (wr == 0) PG8_BAR; }
        if constexpr (!Epi::AFTER_DRAIN) { E(acc, cur, wr, wc, fr, fq); S.done(cur); }
        if (!has_next) break;
#pragma unroll
        for (int a = 0; a < 2; ++a)
#pragma unroll
            for (int b = 0; b < 2; ++b)
#pragma unroll
                for (int m = 0; m < 4; ++m)
#pragma unroll
                    for (int n = 0; n < 2; ++n) acc[a][b][m][n] = (f32x4){0.f, 0.f, 0.f, 0.f};
        cur = nxt; cA = nA; cB = nB; ++ui;
        if constexpr (ALIGN_EPI) { if (wr == 1) PG8_BAR; }
    }
    PG8_WAIT_V(0);
    if constexpr (!ALIGN_EPI) { if (wr == 0) PG8_BAR; }
    PG8_BAR;
    if constexpr (Epi::AFTER_DRAIN) { E.fused(acc, cur, wr, wc, fr, fq, lds, wid, lane); S.done(cur); }
#undef PG8_SA
#undef PG8_SB
#undef PG8_STAGE
#undef PG8_LDA
#undef PG8_LDB
#undef PG8_MMA
#undef PG8_WAIT_V
#undef PG8_WAIT_L
#undef PG8_BAR
#undef PG8_SCHED
}
}
namespace mk {
#define LAS __attribute__((address_space(3)))
typedef unsigned short bf16_t;
typedef short bf16x8 __attribute__((ext_vector_type(8)));
typedef float f32x4 __attribute__((ext_vector_type(4)));
typedef unsigned u32x4 __attribute__((ext_vector_type(4)));
typedef unsigned u32x2 __attribute__((ext_vector_type(2)));

constexpr int SEQ = 4096, NU = 6912;
constexpr float EPS = 1e-6f;
constexpr int UA_Q = 0, UB_Q = 512, UC_V = 1024, UD_Q = 1536, UA_I = 2048, UA_FF = 2560, UA_FB = 3072, UA_Z = 3584;
constexpr int UB_K = 4096, UB_V = 4224, UB_Z = 4352, UC_Q = 4864, UC_K = 5120, UC_O = 5376, UC_Z = 5888, UD_Z = 6400;
constexpr int NSC = 16;
constexpr int SA_ELEMS = 128 * 128;
constexpr int SC_ROWS = 144, SC_ELEMS = SC_ROWS * 64;

struct MP {
    bf16_t* u;
    const float* gates;
    const bf16_t* kv;
    const float* cs; const float* sn;
    const float* lb;
    const float* hgrn_g; const float* sink; const float* conv_w; const float* gate_b; const float* mlstm_g;
    bf16_t* SA; float* DA;
    bf16_t* SC; float* CS;
    int nb;
};

__device__ __forceinline__ int otid() { int t = threadIdx.x; asm volatile("" : "+v"(t)); return t; }
#define UP(p, e) ((bf16_t*)((char*)(p).u + (size_t)(((unsigned)(e)) << 1)))
__device__ __forceinline__ float bf2f(unsigned short h) { return __uint_as_float((unsigned)h << 16); }
typedef float f32x2_t __attribute__((ext_vector_type(2))); typedef __bf16 bf16x2_t __attribute__((ext_vector_type(2)));
__device__ __forceinline__ unsigned pk2(float lo, float hi) { f32x2_t v = {lo, hi}; bf16x2_t b = __builtin_convertvector(v, bf16x2_t); return __builtin_bit_cast(unsigned, b); }
__device__ __forceinline__ unsigned short f2bf(float f) { return (unsigned short)(pk2(f, 0.f) & 0xffffu); }
__device__ __forceinline__ float sigm(float x) { return __builtin_amdgcn_rcpf(1.0f + __expf(-x)); }
__device__ __forceinline__ float silu(float x) { return x * __builtin_amdgcn_rcpf(1.0f + __expf(-x)); }
__device__ __forceinline__ float frsqrt(float x) { return __builtin_amdgcn_rsqf(x); }

template <int K>
__device__ __forceinline__ void mma_nt(f32x4& acc, const LAS bf16_t* A, int lda, int m0, const LAS bf16_t* Bt, int ldb, int n0, int lane) {
    const LAS bf16_t* ap = A + (m0 + (lane & 15)) * lda + 8 * (lane >> 4);
    const LAS bf16_t* bp = Bt + (n0 + (lane & 15)) * ldb + 8 * (lane >> 4);
#pragma unroll
    for (int k0 = 0; k0 < K; k0 += 32) {
        const bf16x8 a = *(const LAS bf16x8*)(ap + k0);
        const bf16x8 b = *(const LAS bf16x8*)(bp + k0);
        acc = __builtin_amdgcn_mfma_f32_16x16x32_bf16(a, b, acc, 0, 0, 0);
    }
}
template <int K>
__device__ __forceinline__ void ld_frags(bf16x8 (&f)[K / 32], const LAS bf16_t* T, int ld, int r0, int lane) {
    const LAS bf16_t* q = T + (r0 + (lane & 15)) * ld + 8 * (lane >> 4);
#pragma unroll
    for (int k = 0; k < K / 32; ++k) f[k] = *(const LAS bf16x8*)(q + 32 * k);
}
template <int K>
__device__ __forceinline__ void mma_fb(f32x4& acc, const LAS bf16_t* A, int lda, int m0, const bf16x8 (&b)[K / 32], int lane) {
    const LAS bf16_t* ap = A + (m0 + (lane & 15)) * lda + 8 * (lane >> 4);
#pragma unroll
    for (int k = 0; k < K / 32; ++k) { const bf16x8 a = *(const LAS bf16x8*)(ap + 32 * k); acc = __builtin_amdgcn_mfma_f32_16x16x32_bf16(a, b[k], acc, 0, 0, 0); }
}
template <int K>
__device__ __forceinline__ void mma_fa(f32x4& acc, const bf16x8 (&a)[K / 32], const LAS bf16_t* Bt, int ldb, int n0, int lane) {
    const LAS bf16_t* bp = Bt + (n0 + (lane & 15)) * ldb + 8 * (lane >> 4);
#pragma unroll
    for (int k = 0; k < K / 32; ++k) { const bf16x8 b = *(const LAS bf16x8*)(bp + 32 * k); acc = __builtin_amdgcn_mfma_f32_16x16x32_bf16(a[k], b, acc, 0, 0, 0); }
}
__device__ __forceinline__ float dpp_sum16(float v) {
    v += __builtin_bit_cast(float, __builtin_amdgcn_mov_dpp(__builtin_bit_cast(int, v), 0xB1, 0xF, 0xF, true));
    v += __builtin_bit_cast(float, __builtin_amdgcn_mov_dpp(__builtin_bit_cast(int, v), 0x4E, 0xF, 0xF, true));
    v += __builtin_bit_cast(float, __builtin_amdgcn_mov_dpp(__builtin_bit_cast(int, v), 0x141, 0xF, 0xF, true));
    v += __builtin_bit_cast(float, __builtin_amdgcn_mov_dpp(__builtin_bit_cast(int, v), 0x140, 0xF, 0xF, true));
    return v;
}
__device__ __forceinline__ float grp16_max(float v) { v = fmaxf(v, __shfl_xor(v, 1)); v = fmaxf(v, __shfl_xor(v, 2)); v = fmaxf(v, __shfl_xor(v, 4)); v = fmaxf(v, __shfl_xor(v, 8)); return v; }
__device__ __forceinline__ float grp16_sum(float v) { v += __shfl_xor(v, 1); v += __shfl_xor(v, 2); v += __shfl_xor(v, 4); v += __shfl_xor(v, 8); return v; }

__device__ __forceinline__ bf16x8 vt_frag(const LAS bf16_t* Vt, int ld, int dv, int s, int q4) {
    const u32x2 lo = *(const LAS u32x2*)(Vt + dv * ld + 32 * s + 4 * q4), hi = *(const LAS u32x2*)(Vt + dv * ld + 32 * s + 16 + 4 * q4);
    return __builtin_bit_cast(bf16x8, (u32x4){lo.x, lo.y, hi.x, hi.y});
}
__device__ __forceinline__ bf16x8 vt_frag2(const LAS bf16_t* Vt, int ld, int dv, int blk_lo, int blk_hi, int q4) {
    const u32x2 lo = *(const LAS u32x2*)(Vt + dv * ld + 16 * blk_lo + 4 * q4), hi = *(const LAS u32x2*)(Vt + dv * ld + 16 * blk_hi + 4 * q4);
    return __builtin_bit_cast(bf16x8, (u32x4){lo.x, lo.y, hi.x, hi.y});
}
__device__ __forceinline__ bf16x8 p_frag(const f32x4& a, const f32x4& b) {
    return __builtin_bit_cast(bf16x8, (u32x4){pk2(a[0], a[1]), pk2(a[2], a[3]), pk2(b[0], b[1]), pk2(b[2], b[3])});
}
__device__ __forceinline__ float quad_max(float v) { v = fmaxf(v, __shfl_xor(v, 16)); return fmaxf(v, __shfl_xor(v, 32)); }
__device__ __forceinline__ float quad_sum(float v) { v += __shfl_xor(v, 16); return v + __shfl_xor(v, 32); }
__device__ __forceinline__ u32x4 gate8(u32x4 y, u32x4 z) {
    float r[8];
    const unsigned yy[4] = {y.x, y.y, y.z, y.w}, zz[4] = {z.x, z.y, z.z, z.w};
#pragma unroll
    for (int e = 0; e < 4; ++e) { r[2 * e] = bf2f((unsigned short)(yy[e] & 0xffffu)) * silu(bf2f((unsigned short)(zz[e] & 0xffffu))); r[2 * e + 1] = bf2f((unsigned short)(yy[e] >> 16)) * silu(bf2f((unsigned short)(zz[e] >> 16))); }
    return (u32x4){pk2(r[0], r[1]), pk2(r[2], r[3]), pk2(r[4], r[5]), pk2(r[6], r[7])};
}

__device__ __forceinline__ void d_item(const MP& p, LAS unsigned char* lds, int item, bool dry = false) {
    const int tid = otid(), lane = tid & 63, w = __builtin_amdgcn_readfirstlane(tid >> 6);
    const int qt = item & 15, h = (item >> 4) & 3, b = item >> 6;
    const size_t row0 = (size_t)b * SEQ + qt * 256;
    LAS bf16_t* Qs = (LAS bf16_t*)lds;
    LAS bf16_t* KV = Qs + 256 * 136;
    const int q4 = lane >> 4, c16 = lane & 15;
#pragma unroll
    for (int it = 0; it < 8; ++it) { const int c = tid + it * 512; const int r = c >> 4, ch = c & 15;
        *(LAS u32x4*)(Qs + r * 136 + ch * 8) = *(const u32x4*)UP(p, (unsigned)(row0 + r) * NU + UD_Q + h * 128 + ch * 8); }
#pragma unroll
    for (int it = 0; it < 8; ++it) { const int c = tid + it * 512; const int r = c >> 4, ch = c & 15;
        *(LAS u32x4*)(KV + r * 136 + ch * 8) = *(const u32x4*)(p.kv + ((size_t)b * 256 + r) * 512 + h * 128 + ch * 8); }
    __syncthreads();
    bf16x8 pb[2][8]; float inv[2];
#pragma unroll
    for (int un = 0; un < 2; ++un) {
        bf16x8 qf[4]; ld_frags<128>(qf, Qs, 136, (w * 2 + un) * 16, lane);
        f32x4 S[16];
#pragma unroll
        for (int be = 0; be < 16; ++be) { S[be] = (f32x4){0.f, 0.f, 0.f, 0.f}; mma_fb<128>(S[be], KV, 136, be * 16, qf, lane); }
        const float c1 = 0.08838834764831845f * 1.4426950408889634f;
        float m = -INFINITY;
#pragma unroll
        for (int be = 0; be < 16; ++be)
#pragma unroll
            for (int i = 0; i < 4; ++i) m = fmaxf(m, S[be][i]);
        m = quad_max(m);
        const float m2 = m * c1;
        float sum = 0.f;
#pragma unroll
        for (int be = 0; be < 16; ++be)
#pragma unroll
            for (int i = 0; i < 4; ++i) { const float e = __builtin_amdgcn_exp2f(fmaf(S[be][i], c1, -m2)); S[be][i] = e; sum += e; }
        inv[un] = __builtin_amdgcn_rcpf(quad_sum(sum));
#pragma unroll
        for (int s8 = 0; s8 < 8; ++s8) pb[un][s8] = p_frag(S[2 * s8], S[2 * s8 + 1]);
        __builtin_amdgcn_sched_barrier(0);
    }
    u32x4 vr[8];
    { const int t3 = otid();
#pragma unroll
      for (int it = 0; it < 8; ++it) { const int c = t3 + it * 512; const int dvr = c >> 5, ch = c & 31; vr[it] = *(const u32x4*)(p.kv + 512 * 1024 + ((size_t)b * 512 + h * 128 + dvr) * 256 + ch * 8); } }
    __syncthreads();
#pragma unroll
    for (int it = 0; it < 8; ++it) { const int c = tid + it * 512; const int dvr = c >> 5, ch = c & 31; *(LAS u32x4*)(KV + dvr * 264 + ch * 8) = vr[it]; }
    u32x4 zr[8];
#pragma unroll
    for (int it = 0; it < 8; ++it) { const int c = tid + it * 512; const int r = c >> 4, ch = c & 15; zr[it] = *(const u32x4*)UP(p, (unsigned)(row0 + r) * NU + UD_Z + h * 128 + ch * 8); }
    __syncthreads();
#pragma unroll
    for (int dvb = 0; dvb < 8; ++dvb) { f32x4 o0 = (f32x4){0.f, 0.f, 0.f, 0.f}, o1 = o0;
#pragma unroll
        for (int s8 = 0; s8 < 8; ++s8) { const bf16x8 a = vt_frag(KV, 264, dvb * 16 + c16, s8, q4);
            o0 = __builtin_amdgcn_mfma_f32_16x16x32_bf16(a, pb[0][s8], o0, 0, 0, 0); o1 = __builtin_amdgcn_mfma_f32_16x16x32_bf16(a, pb[1][s8], o1, 0, 0, 0); }
        *(LAS u32x2*)(Qs + ((w * 2) * 16 + c16) * 136 + dvb * 16 + 4 * q4) = (u32x2){pk2(o0[0] * inv[0], o0[1] * inv[0]), pk2(o0[2] * inv[0], o0[3] * inv[0])};
        *(LAS u32x2*)(Qs + ((w * 2 + 1) * 16 + c16) * 136 + dvb * 16 + 4 * q4) = (u32x2){pk2(o1[0] * inv[1], o1[1] * inv[1]), pk2(o1[2] * inv[1], o1[3] * inv[1])}; }
    __syncthreads();
#pragma unroll
    for (int it = 0; it < 8; ++it) { const int c = tid + it * 512; const int r = c >> 4, ch = c & 15;
        const u32x4 yv = gate8(*(const LAS u32x4*)(Qs + r * 136 + ch * 8), zr[it]);
        if (!dry) *(u32x4*)UP(p, (unsigned)(row0 + r) * NU + UD_Q + h * 128 + ch * 8) = yv; }
    __syncthreads();
}

__device__ __forceinline__ void b_item(const MP& p, LAS unsigned char* lds, int item, bool dry = false) {
    const int tid = otid(), lane = tid & 63, w = __builtin_amdgcn_readfirstlane(tid >> 6);
    const int qt = item & 63, kvh = (item >> 6) & 1, b = item >> 7;
    const int t0 = qt * 64; const size_t brow = (size_t)b * SEQ;
    LAS bf16_t* Ks = (LAS bf16_t*)lds;
    LAS bf16_t* Vt = Ks + 320 * 72;
    LAS bf16_t* Qs = Vt + 64 * 328;
    const int k0 = t0 - 128;
    const int q4 = lane >> 4, c16 = lane & 15;
#pragma unroll
    for (int it = 0; it < 5; ++it) { const int kb = k0 + 64 * it; const int r = tid >> 3, ch = tid & 7;
        u32x4 v = (u32x4){0u, 0u, 0u, 0u};
        if (kb >= 0 && kb < SEQ) v = *(const u32x4*)UP(p, (unsigned)(brow + kb + r) * NU + UB_K + kvh * 64 + ch * 8);
        *(LAS u32x4*)(Ks + (it * 64 + r) * 72 + ch * 8) = v; }
#pragma unroll
    for (int it = 0; it < 5; ++it) { const int kb = k0 + 64 * it; const int d = tid >> 3, ch = tid & 7;
        u32x4 v = (u32x4){0u, 0u, 0u, 0u};
        if (kb >= 0 && kb < SEQ) v = *(const u32x4*)UP(p, (unsigned)(brow + kb + d) * NU + UB_V + kvh * 64 + ch * 8);
        *(LAS u32x4*)(Vt + d * 328 + it * 64 + ch * 8) = v; }
#pragma unroll
    for (int g = 0; g < 4; ++g) { const int r = tid >> 3, ch = tid & 7; const bf16_t* ur = UP(p, (unsigned)(brow + t0 + r) * NU + (kvh * 4 + g) * 64 + ch * 8);
        *(LAS u32x4*)(Qs + (g * 64 + r) * 72 + ch * 8) = *(const u32x4*)(ur + UB_Q); }
    __syncthreads();
#pragma unroll 1
    for (int uu = w; uu < 16; uu += 8) {
        const int g = uu >> 2, qb = uu & 3;
        const float sk = p.sink[kvh * 4 + g];
        bf16x8 qf[2]; ld_frags<64>(qf, Qs + g * 64 * 72, 72, qb * 16, lane);
        f32x4 S[18];
#pragma unroll
        for (int rb = 0; rb < 17; ++rb) { S[rb] = (f32x4){0.f, 0.f, 0.f, 0.f}; mma_fb<64>(S[rb], Ks, 72, (qb + rb) * 16, qf, lane); }
        S[17] = (f32x4){0.f, 0.f, 0.f, 0.f};
        const bool edge = (t0 < 128) || (t0 + 192 > SEQ);
        float mr = -INFINITY;
#pragma unroll
        for (int rb = 0; rb < 17; ++rb)
#pragma unroll
            for (int i = 0; i < 4; ++i) { const int kq = 4 * q4 + i;
                bool ok = (rb == 0) ? (kq >= c16) : (rb == 16) ? (kq <= c16) : true;
                if (edge) { const int kp = k0 + (qb + rb) * 16 + kq; ok = ok && (kp >= 0) && (kp < SEQ); }
                const float v = ok ? S[rb][i] : -INFINITY; S[rb][i] = v; mr = fmaxf(mr, v); }
        const float c1 = 0.125f * 1.4426950408889634f;
        const float m = fmaxf(quad_max(mr) * 0.125f, sk), m2 = m * 1.4426950408889634f;
        float sum = 0.f;
#pragma unroll
        for (int rb = 0; rb < 17; ++rb)
#pragma unroll
            for (int i = 0; i < 4; ++i) { const float e = __builtin_amdgcn_exp2f(fmaf(S[rb][i], c1, -m2)); S[rb][i] = e; sum += e; }
        const float inv = __builtin_amdgcn_rcpf(quad_sum(sum) + __expf(sk - m));
#pragma unroll
        for (int dvb = 0; dvb < 4; ++dvb) { f32x4 o = (f32x4){0.f, 0.f, 0.f, 0.f};
#pragma unroll
            for (int s9 = 0; s9 < 9; ++s9) o = __builtin_amdgcn_mfma_f32_16x16x32_bf16(vt_frag2(Vt, 328, dvb * 16 + c16, qb + 2 * s9, qb + (s9 < 8 ? 2 * s9 + 1 : 2 * s9), q4), p_frag(S[2 * s9], S[2 * s9 + 1]), o, 0, 0, 0);
            *(LAS u32x2*)(Qs + (g * 64 + qb * 16 + c16) * 72 + dvb * 16 + 4 * q4) = (u32x2){pk2(o[0] * inv, o[1] * inv), pk2(o[2] * inv, o[3] * inv)}; }
    }
    u32x4 zr[4];
    { const int t3 = otid();
#pragma unroll
      for (int g = 0; g < 4; ++g) zr[g] = *(const u32x4*)UP(p, (unsigned)(brow + t0 + (t3 >> 3)) * NU + UB_Z + (kvh * 4 + g) * 64 + (t3 & 7) * 8); }
    __syncthreads();
#pragma unroll
    for (int g = 0; g < 4; ++g) { const int r = tid >> 3, ch = tid & 7;
        const u32x4 yv = gate8(*(const LAS u32x4*)(Qs + (g * 64 + r) * 72 + ch * 8), zr[g]);
        if (!dry) *(u32x4*)UP(p, (unsigned)(brow + t0 + r) * NU + UB_Q + (kvh * 4 + g) * 64 + ch * 8) = yv; }
    __syncthreads();
}

struct ALds {
    LAS bf16_t *Qt, *Kt, *KhT, *Vt, *Pm, *St; LAS float *seg, *Dl, *Er, *stats;
};
__device__ __forceinline__ ALds a_lds(LAS unsigned char* lds) {
    ALds L; L.Qt = (LAS bf16_t*)lds; L.Kt = L.Qt + 64 * 136; L.KhT = L.Kt + 64 * 136; L.Vt = L.KhT + 128 * 72; L.Pm = L.Vt + 128 * 72;
    L.St = L.Pm + 64 * 72; L.seg = (LAS float*)(L.St + 128 * 136); L.Dl = L.seg + 512; L.Er = L.Dl + 128; L.stats = L.Er + 128; return L;
}
template <int MODE>
__device__ __forceinline__ float a_gates(const MP& p, const ALds& L, size_t tbase, int h, int dir, float carry) {
    const int tid = otid(), d = tid & 127, sg = tid >> 7;
    const float lbv = p.lb[h * 128 + d];
    unsigned off = (unsigned)((tbase + sg * 16) * NU + h * 128 + d) * 2u;
    const char* bz = (const char*)(p.u + (dir ? UA_FB : UA_FF)); const char* bvv = (const char*)(p.u + UA_I); const char* bq = (const char*)(p.u + UA_Q);
    float g[16], kk[16]; unsigned qp[8], vp[8], zp[8];
#pragma unroll
    for (int k = 0; k < 16; ++k) {
        asm volatile("" : "+v"(off));
        const unsigned zz = *(const unsigned short*)(bz + off);
        if (k & 1) zp[k >> 1] |= zz << 16; else zp[k >> 1] = zz;
        const unsigned vv = *(const unsigned short*)(bvv + off);
        if (k & 1) vp[k >> 1] |= vv << 16; else vp[k >> 1] = vv;
        if (MODE == 1) { const unsigned qq = *(const unsigned short*)(bq + off); if (k & 1) qp[k >> 1] |= qq << 16; else qp[k >> 1] = qq; }
        off += NU * 2; }
#pragma unroll
    for (int k = 0; k < 16; ++k) {
        const float z = bf2f((unsigned short)((k & 1) ? (zp[k >> 1] >> 16) : (zp[k >> 1] & 0xffffu)));
        const float f = lbv + (1.f - lbv) * sigm(z);
        g[k] = f; kk[k] = 1.f - f; }
    float segv;
    if (MODE == 1) {
        if (dir == 0) {
#pragma unroll
            for (int k = 1; k < 16; ++k) g[k] *= g[k - 1];
            segv = g[15];
        } else {
#pragma unroll
            for (int k = 14; k >= 0; --k) g[k] *= g[k + 1];
            segv = g[0];
        }
    } else {
        float x = 1.f;
        if (dir == 0) {
#pragma unroll
            for (int k = 15; k >= 0; --k) { const float fk = g[k]; g[k] = x; x *= fk; }
        } else {
#pragma unroll
            for (int k = 0; k < 16; ++k) { const float fk = g[k]; g[k] = x; x *= fk; }
        }
        segv = x;
    }
    L.seg[sg * 128 + d] = segv;
    __syncthreads();
    const float s0 = L.seg[d], s1 = L.seg[128 + d], s2 = L.seg[256 + d], s3 = L.seg[384 + d];
    const float tot = (s0 * s1) * (s2 * s3);
    const float plo = (sg > 0 ? s0 : 1.f) * (sg > 1 ? s1 : 1.f) * (sg > 2 ? s2 : 1.f);
    const float phi = (sg < 3 ? s3 : 1.f) * (sg < 2 ? s2 : 1.f) * (sg < 1 ? s1 : 1.f);
    const float ref = dir == 0 ? (s0 * s1) : (s2 * s3);
    const float rr = (MODE == 1) ? __builtin_amdgcn_rcpf(ref) : 0.f;
    const float c1 = (MODE == 1) ? (dir == 0 ? plo : phi) * rr : (dir == 0 ? phi : plo) * carry;
    const float c2 = tot * rr;
    unsigned khp[8];
#pragma unroll
    for (int k = 0; k < 16; k += 2) {
        float khv[2];
#pragma unroll
        for (int e = 0; e < 2; ++e) { const int kx = k + e;
            const int pp = sg * 16 + kx;
            if (MODE == 1) {
                const float e1 = g[kx] * c1, r1 = __builtin_amdgcn_rcpf(e1);
                const float qv = bf2f((unsigned short)(e ? (qp[k >> 1] >> 16) : (qp[k >> 1] & 0xffffu)));
                const float kt = kk[kx] * r1;
                L.Qt[pp * 136 + d] = f2bf(qv * e1);
                L.Kt[pp * 136 + d] = f2bf(kt);
                khv[e] = kt * c2;
            } else khv[e] = kk[kx] * (g[kx] * c1);
        }
        khp[k >> 1] = pk2(khv[0], khv[1]); }
    *(LAS u32x4*)(L.KhT + d * 72 + sg * 16) = (u32x4){khp[0], khp[1], khp[2], khp[3]};
    *(LAS u32x4*)(L.KhT + d * 72 + sg * 16 + 8) = (u32x4){khp[4], khp[5], khp[6], khp[7]};
    if (MODE == 1 && sg == 0) { L.Dl[d] = tot; L.Er[d] = ref; }
    *(LAS u32x4*)(L.Vt + d * 72 + sg * 16) = (u32x4){vp[0], vp[1], vp[2], vp[3]};
    *(LAS u32x4*)(L.Vt + d * 72 + sg * 16 + 8) = (u32x4){vp[4], vp[5], vp[6], vp[7]};
    return tot;
}

__device__ __forceinline__ void a_pass1(const MP& p, LAS unsigned char* lds, int item) {
    const int tid = otid(), lane = tid & 63, w = __builtin_amdgcn_readfirstlane(tid >> 6);
    const int dir = item & 1, sc = (item >> 1) & 15, h = (item >> 5) & 3, b = item >> 7;
    const ALds L = a_lds(lds);
    const int q4 = lane >> 4, c16 = lane & 15;
    f32x4 S[8];
#pragma unroll
    for (int j = 0; j < 8; ++j) S[j] = (f32x4){0.f, 0.f, 0.f, 0.f};
    float carry = 1.f;
    for (int ci = 0; ci < 4; ++ci) {
        const int cc = dir ? ci : 3 - ci;
        const size_t tbase = (size_t)b * SEQ + sc * 256 + cc * 64;
        const float tot = a_gates<0>(p, L, tbase, h, dir, carry);
        carry *= tot;
        __syncthreads();
        { bf16x8 bv[2]; ld_frags<64>(bv, L.Vt, 72, w * 16, lane);
#pragma unroll
          for (int j = 0; j < 8; ++j) mma_fb<64>(S[j], L.KhT, 72, j * 16, bv, lane); }
        __syncthreads();
    }
    const size_t sidx = ((size_t)(dir * p.nb * 4 + b * 4 + h) * NSC + sc);
    bf16_t* dst = p.SA + sidx * SA_ELEMS;
#pragma unroll
    for (int j = 0; j < 8; ++j) {
        *(u32x2*)(dst + (size_t)(w * 16 + c16) * 128 + j * 16 + 4 * q4) = (u32x2){pk2(S[j][0], S[j][1]), pk2(S[j][2], S[j][3])}; }
    if (tid < 128) p.DA[sidx * 128 + tid] = carry;
}

__device__ __forceinline__ void a_scan_unit(const MP& p, int unit, bool dry = false) {
    const int e4 = unit & 4095, seq = unit >> 12;
    const int dir = seq / (p.nb * 4);
    const int dk = (e4 * 4) & 127;
    u32x2 v[NSC]; f32x4 D[NSC];
#pragma unroll
    for (int i = 0; i < NSC; ++i) {
        const int sc = dir ? NSC - 1 - i : i;
        v[i] = *(const u32x2*)(p.SA + ((size_t)seq * NSC + sc) * SA_ELEMS + e4 * 4);
        D[i] = *(const f32x4*)(p.DA + ((size_t)seq * NSC + sc) * 128 + dk); }
    float S0 = 0.f, S1 = 0.f, S2 = 0.f, S3 = 0.f;
#pragma unroll
    for (int i = 0; i < NSC; ++i) {
        const int sc = dir ? NSC - 1 - i : i;
        if (!dry) *(u32x2*)(p.SA + ((size_t)seq * NSC + sc) * SA_ELEMS + e4 * 4) = (u32x2){pk2(S0, S1), pk2(S2, S3)};
        S0 = D[i][0] * S0 + bf2f(v[i].x & 0xffffu); S1 = D[i][1] * S1 + bf2f(v[i].x >> 16); S2 = D[i][2] * S2 + bf2f(v[i].y & 0xffffu); S3 = D[i][3] * S3 + bf2f(v[i].y >> 16);
    }
}

__device__ __forceinline__ void a_pass3(const MP& p, LAS unsigned char* lds, int item, bool dry = false) {
    const int tid = otid(), lane = tid & 63, w = __builtin_amdgcn_readfirstlane(tid >> 6);
    const int sc = item & 15, h = (item >> 4) & 3, b = item >> 6;
    const ALds L = a_lds(lds);
    const int q4 = lane >> 4, c16 = lane & 15, mb2 = w >> 1, nh = w & 1;
    f32x4 O[4][4];
#pragma unroll
    for (int a = 0; a < 4; ++a)
#pragma unroll
        for (int m = 0; m < 4; ++m) O[a][m] = (f32x4){0.f, 0.f, 0.f, 0.f};
#pragma unroll 1
    for (int dir = 0; dir < 2; ++dir) {
        const size_t sidx = ((size_t)(dir * p.nb * 4 + b * 4 + h) * NSC + sc);
        const bf16_t* sg = p.SA + sidx * SA_ELEMS;
        f32x4 S[8];
#pragma unroll
        for (int j = 0; j < 8; ++j) { const u32x2 v = *(const u32x2*)(sg + (size_t)(w * 16 + c16) * 128 + j * 16 + 4 * q4);
            S[j] = (f32x4){bf2f(v.x & 0xffffu), bf2f(v.x >> 16), bf2f(v.y & 0xffffu), bf2f(v.y >> 16)}; }
#pragma unroll 1
        for (int ci = 0; ci < 4; ++ci) {
            const int cc = dir ? 3 - ci : ci;
            const size_t tbase = (size_t)b * SEQ + sc * 256 + cc * 64;
            (void)a_gates<1>(p, L, tbase, h, dir, 0.f);
            __syncthreads();
            { bf16x8 aq[4]; ld_frags<128>(aq, L.Qt, 136, mb2 * 16, lane);
#pragma unroll
              for (int n = 0; n < 2; ++n) { f32x4 a = (f32x4){0.f, 0.f, 0.f, 0.f}; const int nb16 = nh * 2 + n;
                mma_fa<128>(a, aq, L.Kt, 136, nb16 * 16, lane);
                const int ps = nb16 * 16 + c16, pt0 = mb2 * 16 + 4 * q4;
#pragma unroll
                for (int i = 0; i < 4; ++i) { const int pt = pt0 + i; const bool keep = dir ? (ps >= pt) : (ps <= pt);
                    L.Pm[pt * 72 + ps] = f2bf(keep ? a[i] : 0.f); } } }
#pragma unroll
            for (int j = 0; j < 8; ++j) { const f32x4 E = *(const LAS f32x4*)(L.Er + j * 16 + 4 * q4);
                *(LAS u32x2*)(L.St + (w * 16 + c16) * 136 + j * 16 + 4 * q4) = (u32x2){pk2(S[j][0] * E[0], S[j][1] * E[1]), pk2(S[j][2] * E[2], S[j][3] * E[3])}; }
            __syncthreads();
            bf16x8 bv[2], bs[4];
            ld_frags<64>(bv, L.Vt, 72, w * 16, lane); ld_frags<128>(bs, L.St, 136, w * 16, lane);
            f32x4 T[4];
#pragma unroll
            for (int m = 0; m < 4; ++m) { T[m] = (f32x4){0.f, 0.f, 0.f, 0.f};
                mma_fb<64>(T[m], L.Pm, 72, m * 16, bv, lane);
                mma_fb<128>(T[m], L.Qt, 136, m * 16, bs, lane); }
            if (cc == 0) {
#pragma unroll
                for (int m = 0; m < 4; ++m) O[0][m] += T[m];
            } else if (cc == 1) {
#pragma unroll
                for (int m = 0; m < 4; ++m) O[1][m] += T[m];
            } else if (cc == 2) {
#pragma unroll
                for (int m = 0; m < 4; ++m) O[2][m] += T[m];
            } else {
#pragma unroll
                for (int m = 0; m < 4; ++m) O[3][m] += T[m];
            }
#pragma unroll
            for (int j = 0; j < 8; ++j) { const f32x4 D = *(const LAS f32x4*)(L.Dl + j * 16 + 4 * q4);
                S[j] = S[j] * D;
                mma_fb<64>(S[j], L.KhT, 72, j * 16, bv, lane); }
            __syncthreads();
        }
    }
    {
        const int t2 = otid();
        LAS bf16_t* Zt = (LAS bf16_t*)lds;
        LAS float* rsr = L.seg;
        const size_t rowb = (size_t)b * SEQ + sc * 256;
        u32x4 zr[8];
#pragma unroll
        for (int it = 0; it < 8; ++it) { const int c = t2 + it * 512; const int r = c >> 4, ch = c & 15; zr[it] = *(const u32x4*)UP(p, (unsigned)(rowb + r) * NU + UA_Z + h * 128 + ch * 8); }
        int q4e = (t2 >> 4 & 3) * 4; asm volatile("" : "+v"(q4e));
#pragma unroll
        for (int a = 0; a < 4; ++a)
#pragma unroll
            for (int m = 0; m < 4; ++m) { f32x4 sq;
#pragma unroll
                for (int i = 0; i < 4; ++i) { const float v = O[a][m][i]; sq[i] = dpp_sum16(v * v); }
                if (c16 == 0) *(LAS f32x4*)(L.stats + w * 256 + a * 64 + m * 16 + q4e) = sq; }
#pragma unroll
        for (int it = 0; it < 8; ++it) { const int c = t2 + it * 512; const int r = c >> 4, ch = c & 15; *(LAS u32x4*)(Zt + r * 136 + ch * 8) = zr[it]; }
        __syncthreads();
        if (t2 < 256) { float ss = 0.f;
#pragma unroll
            for (int ww = 0; ww < 8; ++ww) ss += L.stats[ww * 256 + t2];
            rsr[t2] = frsqrt(ss * (1.0f / 128.f) + EPS); }
        __syncthreads();
        const float gn = p.hgrn_g[h * 128 + w * 16 + c16];
#pragma unroll
        for (int a = 0; a < 4; ++a)
#pragma unroll
            for (int m = 0; m < 4; ++m) { const f32x4 rs4 = *(const LAS f32x4*)(rsr + a * 64 + m * 16 + q4e);
#pragma unroll
                for (int i = 0; i < 4; ++i) { LAS bf16_t* zp = Zt + (a * 64 + m * 16 + q4e + i) * 136 + w * 16 + c16;
                    *zp = f2bf(O[a][m][i] * rs4[i] * gn * silu(bf2f(*zp))); } }
        __syncthreads();
        if (!dry) {
#pragma unroll
            for (int it = 0; it < 8; ++it) { const int c = t2 + it * 512; const int r = c >> 4, ch = c & 15;
                *(u32x4*)UP(p, (unsigned)(rowb + r) * NU + UA_Q + h * 128 + ch * 8) = *(const LAS u32x4*)(Zt + r * 136 + ch * 8); }
        }
        __syncthreads();
    }
}

struct CLds {
    LAS bf16_t *Qc, *Kc, *KhT, *Vt, *Pw, *St; LAS float *sc;
};
__device__ __forceinline__ CLds c_lds(LAS unsigned char* lds) {
    CLds L; L.Qc = (LAS bf16_t*)lds; L.Kc = L.Qc + 64 * 72; L.KhT = L.Kc + 64 * 72; L.Vt = L.KhT + 64 * 72; L.Pw = L.Vt + 144 * 72; L.St = L.Pw + 64 * 72;
    L.sc = (LAS float*)(L.St + 144 * 72); return L;
}
__device__ __forceinline__ float log_sigmoid(float x) { return fminf(x, 0.f) - log1pf(__expf(-fabsf(x))); }
__device__ __forceinline__ void c_ones_rows(const CLds& L, int tid) {
    if (tid < 16 * 8) { const int r = 128 + (tid >> 3), ch = tid & 7; const unsigned one = (r == 128) ? 0x3f803f80u : 0u; *(LAS u32x4*)(L.Vt + r * 72 + ch * 8) = (u32x4){one, one, one, one}; }
}
struct CRegs { u32x4 q, k, v0, v1; };
template <bool WANT_Q>
__device__ __forceinline__ void c_issue(CRegs& R, const MP& p, size_t row0  , int h, int tid) {
    const int r = tid & 63, ch = tid >> 6;
    const bf16_t* ur = UP(p, (unsigned)(row0 + r) * NU + h * 64 + ch * 8);
    if (WANT_Q) R.q = *(const u32x4*)(ur + UC_Q);
    R.k = *(const u32x4*)(ur + UC_K);
    const bf16_t* vr = UP(p, (unsigned)(row0 + r) * NU + UC_V + h * 128 + ch * 16);
    R.v0 = *(const u32x4*)vr; R.v1 = *(const u32x4*)(vr + 8);
}
template <bool WANT_Q>
__device__ __forceinline__ void c_store(const CRegs& R, const CLds& L, float wsr, int tid) {
    const int r = tid & 63, ch = tid >> 6;
    if (WANT_Q) { *(LAS u32x4*)(L.Qc + r * 72 + ch * 8) = R.q; *(LAS u32x4*)(L.Kc + r * 72 + ch * 8) = R.k; }
    {
        LAS bf16_t* vd = L.Vt + (ch * 16) * 72 + r;
        vd[0 * 72] = (bf16_t)(R.v0.x & 0xffffu); vd[1 * 72] = (bf16_t)(R.v0.x >> 16); vd[2 * 72] = (bf16_t)(R.v0.y & 0xffffu); vd[3 * 72] = (bf16_t)(R.v0.y >> 16);
        vd[4 * 72] = (bf16_t)(R.v0.z & 0xffffu); vd[5 * 72] = (bf16_t)(R.v0.z >> 16); vd[6 * 72] = (bf16_t)(R.v0.w & 0xffffu); vd[7 * 72] = (bf16_t)(R.v0.w >> 16);
        vd[8 * 72] = (bf16_t)(R.v1.x & 0xffffu); vd[9 * 72] = (bf16_t)(R.v1.x >> 16); vd[10 * 72] = (bf16_t)(R.v1.y & 0xffffu); vd[11 * 72] = (bf16_t)(R.v1.y >> 16);
        vd[12 * 72] = (bf16_t)(R.v1.z & 0xffffu); vd[13 * 72] = (bf16_t)(R.v1.z >> 16); vd[14 * 72] = (bf16_t)(R.v1.w & 0xffffu); vd[15 * 72] = (bf16_t)(R.v1.w >> 16);
    }
    LAS bf16_t* dst = L.KhT + (ch * 8) * 72 + r;
    dst[0 * 72] = f2bf(wsr * bf2f(R.k.x & 0xffffu)); dst[1 * 72] = f2bf(wsr * bf2f(R.k.x >> 16)); dst[2 * 72] = f2bf(wsr * bf2f(R.k.y & 0xffffu)); dst[3 * 72] = f2bf(wsr * bf2f(R.k.y >> 16));
    dst[4 * 72] = f2bf(wsr * bf2f(R.k.z & 0xffffu)); dst[5 * 72] = f2bf(wsr * bf2f(R.k.z >> 16)); dst[6 * 72] = f2bf(wsr * bf2f(R.k.w & 0xffffu)); dst[7 * 72] = f2bf(wsr * bf2f(R.k.w >> 16));
}

__device__ __forceinline__ void c_pass1(const MP& p, LAS unsigned char* lds, int item) {
    const int tid = otid(), lane = tid & 63, w = __builtin_amdgcn_readfirstlane(tid >> 6);
    const int dir = item & 1, sc = (item >> 1) & 15, h = (item >> 5) & 3, b = item >> 7;
    const CLds L = c_lds(lds);
    const int q4 = lane >> 4, c16 = lane & 15;
    const size_t brow = (size_t)b * SEQ; const int tls = sc * 256;
    CRegs R;
    c_issue<false>(R, p, brow + tls, h, tid);
    c_ones_rows(L, tid);
    if (w == 0) {
        const float bi = p.gate_b[dir * 4 + h], bf = p.gate_b[8 + dir * 4 + h];
        float lf[4], li[4];
#pragma unroll
        for (int k = 0; k < 4; ++k) { const float* gr = p.gates + (brow + tls + lane * 4 + k) * 16; li[k] = gr[dir * 4 + h] + bi; lf[k] = log_sigmoid(gr[8 + dir * 4 + h] + bf); }
        const float tot4 = (lf[0] + lf[1]) + (lf[2] + lf[3]);
        float incl = tot4;
        if (dir == 0) {
#pragma unroll
            for (int o = 1; o < 64; o <<= 1) { const float t = __shfl_down(incl, o); if (lane + o < 64) incl += t; }
        } else {
#pragma unroll
            for (int o = 1; o < 64; o <<= 1) { const float t = __shfl_up(incl, o); if (lane >= o) incl += t; }
        }
        const float after_lane = incl - tot4;
        float E[4];
        if (dir == 0) { E[3] = after_lane; E[2] = E[3] + lf[3]; E[1] = E[2] + lf[2]; E[0] = E[1] + lf[1]; }
        else { E[0] = after_lane; E[1] = E[0] + lf[0]; E[2] = E[1] + lf[1]; E[3] = E[2] + lf[2]; }
        float a[4], amax = -INFINITY;
#pragma unroll
        for (int k = 0; k < 4; ++k) { a[k] = E[k] + li[k]; amax = fmaxf(amax, a[k]); }
#pragma unroll
        for (int o = 32; o > 0; o >>= 1) amax = fmaxf(amax, __shfl_xor(amax, o));
        float Btot = tot4;
#pragma unroll
        for (int o = 32; o > 0; o >>= 1) Btot += __shfl_xor(Btot, o);
#pragma unroll
        for (int k = 0; k < 4; ++k) L.sc[192 + lane * 4 + k] = __expf(a[k] - amax);
        if (lane == 0) { L.sc[576 + 2] = amax; L.sc[576 + 3] = Btot; }
    }
    __syncthreads();
    f32x4 S[5];
#pragma unroll
    for (int j = 0; j < 5; ++j) S[j] = (f32x4){0.f, 0.f, 0.f, 0.f};
#pragma unroll 1
    for (int cc = 0; cc < 4; ++cc) {
        c_store<false>(R, L, L.sc[192 + cc * 64 + (tid & 63)], tid);
        if (cc < 3) c_issue<false>(R, p, brow + tls + (cc + 1) * 64, h, tid);
        __syncthreads();
        { bf16x8 bv[2]; ld_frags<64>(bv, L.Vt, 72, w * 16, lane);
#pragma unroll
          for (int j = 0; j < 4; ++j) mma_fb<64>(S[j], L.KhT, 72, j * 16, bv, lane); }
        if (w < 4) mma_nt<64>(S[4], L.KhT, 72, w * 16, L.Vt, 72, 128, lane);
        __syncthreads();
    }
    const size_t sidx = ((size_t)(dir * p.nb * 4 + b * 4 + h) * NSC + sc);
    bf16_t* dst = p.SC + sidx * SC_ELEMS;
#pragma unroll
    for (int j = 0; j < 4; ++j) *(u32x2*)(dst + (size_t)(w * 16 + c16) * 64 + j * 16 + 4 * q4) = (u32x2){pk2(S[j][0], S[j][1]), pk2(S[j][2], S[j][3])};
    if (w < 4) *(u32x2*)(dst + (size_t)(128 + c16) * 64 + w * 16 + 4 * q4) = (u32x2){pk2(S[4][0], S[4][1]), pk2(S[4][2], S[4][3])};
    if (tid == 0) { p.CS[sidx * 4 + 0] = L.sc[576 + 2]; p.CS[sidx * 4 + 1] = L.sc[576 + 3]; }
    __syncthreads();
}

__device__ __forceinline__ void c_scan_unit(const MP& p, int unit, bool dry = false) {
    const int e4 = unit % 2304, seq = unit / 2304;
    const int dir = seq / (p.nb * 4);
    u32x2 v[NSC]; float A[NSC], B[NSC];
#pragma unroll
    for (int i = 0; i < NSC; ++i) {
        const int sc = dir ? NSC - 1 - i : i; const size_t sidx = (size_t)seq * NSC + sc;
        v[i] = *(const u32x2*)(p.SC + sidx * SC_ELEMS + e4 * 4); A[i] = p.CS[sidx * 4 + 0]; B[i] = p.CS[sidx * 4 + 1]; }
    float S0 = 0.f, S1 = 0.f, S2 = 0.f, S3 = 0.f, M = 0.f;
#pragma unroll
    for (int i = 0; i < NSC; ++i) {
        const int sc = dir ? NSC - 1 - i : i; const size_t sidx = (size_t)seq * NSC + sc;
        if (!dry) *(u32x2*)(p.SC + sidx * SC_ELEMS + e4 * 4) = (u32x2){pk2(S0, S1), pk2(S2, S3)};
        if (e4 == 0 && !dry) p.CS[sidx * 4 + 2] = M;
        const float Mn = fmaxf(B[i] + M, A[i]);
        const float dc = __expf(B[i] + M - Mn), wn = __expf(A[i] - Mn);
        S0 = dc * S0 + wn * bf2f(v[i].x & 0xffffu); S1 = dc * S1 + wn * bf2f(v[i].x >> 16); S2 = dc * S2 + wn * bf2f(v[i].y & 0xffffu); S3 = dc * S3 + wn * bf2f(v[i].y >> 16);
        M = Mn;
    }
}

__device__ __forceinline__ void c_pass3(const MP& p, LAS unsigned char* lds, int item, bool dry = false) {
    const int tid = otid(), lane = tid & 63, w = __builtin_amdgcn_readfirstlane(tid >> 6);
    const int sc = item & 15, h = (item >> 4) & 3, b = item >> 6;
    const CLds L = c_lds(lds);
    const int q4 = lane >> 4, c16 = lane & 15, mb2 = w >> 1, nh = w & 1;
    const size_t brow = (size_t)b * SEQ; const int tls = sc * 256;
    f32x4 H[4][4];
#pragma unroll
    for (int a = 0; a < 4; ++a)
#pragma unroll
        for (int m = 0; m < 4; ++m) H[a][m] = (f32x4){0.f, 0.f, 0.f, 0.f};
    CRegs R; float gi_raw, gf_raw;
    c_issue<true>(R, p, brow + tls, h, tid);
    { const float* gr = p.gates + (brow + tls + lane) * 16; gi_raw = gr[h]; gf_raw = gr[8 + h]; }
    c_ones_rows(L, tid);
#pragma unroll 1
    for (int dir = 0; dir < 2; ++dir) {
        const size_t sidx = ((size_t)(dir * p.nb * 4 + b * 4 + h) * NSC + sc);
        const bf16_t* sg = p.SC + sidx * SC_ELEMS;
        { const int t2 = otid();
#pragma unroll
          for (int it = 0; it < 3; ++it) { const int c = t2 + it * 512; if (c >= 144 * 8) break; const int r = c >> 3, ch = c & 7; *(LAS u32x4*)(L.St + r * 72 + ch * 8) = *(const u32x4*)(sg + r * 64 + ch * 8); } }
        f32x4 S[5];
#pragma unroll
        for (int j = 0; j < 4; ++j) { const u32x2 v = *(const u32x2*)(sg + (size_t)(w * 16 + c16) * 64 + j * 16 + 4 * q4);
            S[j] = (f32x4){bf2f(v.x & 0xffffu), bf2f(v.x >> 16), bf2f(v.y & 0xffffu), bf2f(v.y >> 16)}; }
        S[4] = (f32x4){0.f, 0.f, 0.f, 0.f};
        if (w < 4) { const u32x2 v = *(const u32x2*)(sg + (size_t)(128 + c16) * 64 + w * 16 + 4 * q4);
            S[4] = (f32x4){bf2f(v.x & 0xffffu), bf2f(v.x >> 16), bf2f(v.y & 0xffffu), bf2f(v.y >> 16)}; }
        float M = p.CS[sidx * 4 + 2];
        const float bi = p.gate_b[dir * 4 + h], bfb = p.gate_b[8 + dir * 4 + h];
#pragma unroll 1
        for (int ci = 0; ci < 4; ++ci) {
            const int cc = dir ? 3 - ci : ci;
            const float li = gi_raw + bi, lf = log_sigmoid(gf_raw + bfb);
            float bc = lf;
            if (dir == 0) {
#pragma unroll
                for (int o = 1; o < 64; o <<= 1) { const float t = __shfl_up(bc, o); if (lane >= o) bc += t; }
            } else {
#pragma unroll
                for (int o = 1; o < 64; o <<= 1) { const float t = __shfl_down(bc, o); if (lane + o < 64) bc += t; }
            }
            const float cb = li - bc;
            float pm = cb;
            if (dir == 0) {
#pragma unroll
                for (int o = 1; o < 64; o <<= 1) { const float t = __shfl_up(pm, o); if (lane >= o) pm = fmaxf(pm, t); }
            } else {
#pragma unroll
                for (int o = 1; o < 64; o <<= 1) { const float t = __shfl_down(pm, o); if (lane + o < 64) pm = fmaxf(pm, t); }
            }
            const float mt = fmaxf(bc + pm, bc + M);
            const float blast = __shfl(bc, dir ? 0 : 63);
            const float av = blast - bc + li;
            float amax = av;
#pragma unroll
            for (int o = 32; o > 0; o >>= 1) amax = fmaxf(amax, __shfl_xor(amax, o));
            const float Mn = fmaxf(blast + M, amax);
            const float wsv = __expf(av - Mn), dcy = __expf(blast + M - Mn);
            if (w == 0) { L.sc[lane] = bc - mt; L.sc[64 + lane] = cb; L.sc[128 + lane] = __expf(bc + M - mt); L.sc[448 + lane] = mt; }
            M = Mn;
            c_store<true>(R, L, wsv, tid);
            {
                int ndir = dir, nci = ci + 1; if (nci == 4) { nci = 0; ndir = dir + 1; }
                if (ndir < 2) { const int ncc = ndir ? 3 - nci : nci; const size_t nrow = brow + tls + ncc * 64;
                    c_issue<true>(R, p, nrow, h, tid);
                    const float* gr = p.gates + (nrow + lane) * 16; gi_raw = gr[ndir * 4 + h]; gf_raw = gr[8 + ndir * 4 + h]; }
            }
            __syncthreads();
            { bf16x8 aq[2]; ld_frags<64>(aq, L.Qc, 72, mb2 * 16, lane);
#pragma unroll
              for (int n = 0; n < 2; ++n) { f32x4 a = (f32x4){0.f, 0.f, 0.f, 0.f}; const int nb16 = nh * 2 + n;
                mma_fa<64>(a, aq, L.Kc, 72, nb16 * 16, lane);
                const int ps = nb16 * 16 + c16, pt0 = mb2 * 16 + 4 * q4; const float cbs = L.sc[64 + ps];
#pragma unroll
                for (int i = 0; i < 4; ++i) { const int pt = pt0 + i; const bool keep = dir ? (ps >= pt) : (ps <= pt);
                    const float wv = keep ? a[i] * __expf(L.sc[pt] + cbs) : 0.f;
                    L.Pw[pt * 72 + ps] = f2bf(wv); } } }
            __syncthreads();
            if (w < 4) { f32x4 n2 = (f32x4){0.f, 0.f, 0.f, 0.f};
                mma_nt<64>(n2, L.Qc, 72, w * 16, L.St, 72, 128, lane);
                const f32x4 g = *(const LAS f32x4*)(L.sc + 128 + w * 16 + 4 * q4);
                n2 = n2 * g; mma_nt<64>(n2, L.Pw, 72, w * 16, L.Vt, 72, 128, lane);
                if (c16 == 0) *(LAS f32x4*)(L.sc + 512 + w * 16 + 4 * q4) = n2; }
            __syncthreads();
            bf16x8 bv[2], bs[2];
            ld_frags<64>(bv, L.Vt, 72, w * 16, lane); ld_frags<64>(bs, L.St, 72, w * 16, lane);
#pragma unroll
            for (int m = 0; m < 4; ++m) { f32x4 T = (f32x4){0.f, 0.f, 0.f, 0.f};
                mma_fb<64>(T, L.Qc, 72, m * 16, bs, lane);
                const f32x4 g = *(const LAS f32x4*)(L.sc + 128 + m * 16 + 4 * q4);
                T = T * g; mma_fb<64>(T, L.Pw, 72, m * 16, bv, lane);
                const f32x4 dn = *(const LAS f32x4*)(L.sc + 512 + m * 16 + 4 * q4), mr = *(const LAS f32x4*)(L.sc + 448 + m * 16 + 4 * q4);
#pragma unroll
                for (int i = 0; i < 4; ++i) T[i] *= __builtin_amdgcn_rcpf(fmaxf(fabsf(dn[i]), __expf(-mr[i])));
                if (cc == 0) H[0][m] += T; else if (cc == 1) H[1][m] += T; else if (cc == 2) H[2][m] += T; else H[3][m] += T; }
#pragma unroll
            for (int j = 0; j < 4; ++j) { S[j] = S[j] * dcy; mma_fb<64>(S[j], L.KhT, 72, j * 16, bv, lane);
                *(LAS u32x2*)(L.St + (w * 16 + c16) * 72 + j * 16 + 4 * q4) = (u32x2){pk2(S[j][0], S[j][1]), pk2(S[j][2], S[j][3])}; }
            if (w < 4) { S[4] = S[4] * dcy; mma_nt<64>(S[4], L.KhT, 72, w * 16, L.Vt, 72, 128, lane);
                *(LAS u32x2*)(L.St + (128 + c16) * 72 + w * 16 + 4 * q4) = (u32x2){pk2(S[4][0], S[4][1]), pk2(S[4][2], S[4][3])}; }
            __syncthreads();
        }
    }
    {
        const int t2 = otid();
        LAS bf16_t* Tt = (LAS bf16_t*)lds;
        LAS float* st1 = L.sc + 640; LAS float* st2 = st1 + 8 * 256; LAS float* mu = L.sc; LAS float* rsr = L.sc + 256;
        const size_t rowb = brow + tls;
        u32x4 og[8], zr[8];
#pragma unroll
        for (int it = 0; it < 8; ++it) { const int c = t2 + it * 512; const int r = c >> 4, ch = c & 15; og[it] = *(const u32x4*)UP(p, (unsigned)(rowb + r) * NU + UC_O + h * 128 + ch * 8); }
#pragma unroll
        for (int it = 0; it < 8; ++it) { const int c = t2 + it * 512; const int r = c >> 4, ch = c & 15; zr[it] = *(const u32x4*)UP(p, (unsigned)(rowb + r) * NU + UC_Z + h * 128 + ch * 8); }
#pragma unroll
        for (int it = 0; it < 8; ++it) { const int c = t2 + it * 512; const int r = c >> 4, ch = c & 15; *(LAS u32x4*)(Tt + r * 136 + ch * 8) = og[it]; }
        __syncthreads();
        int q4e = (t2 >> 4 & 3) * 4; asm volatile("" : "+v"(q4e));
#pragma unroll
        for (int a = 0; a < 4; ++a)
#pragma unroll
            for (int m = 0; m < 4; ++m) { f32x4 sm;
#pragma unroll
                for (int i = 0; i < 4; ++i) { const int tl = a * 64 + m * 16 + q4e + i;
                    const float v = H[a][m][i] * sigm(bf2f(Tt[tl * 136 + w * 16 + c16])); H[a][m][i] = v;
                    sm[i] = dpp_sum16(v); }
                if (c16 == 0) *(LAS f32x4*)(st1 + w * 256 + a * 64 + m * 16 + q4e) = sm; }
        __syncthreads();
        if (t2 < 256) { float ss = 0.f;
#pragma unroll
            for (int ww = 0; ww < 8; ++ww) ss += st1[ww * 256 + t2];
            mu[t2] = ss * (1.0f / 128.f); }
#pragma unroll
        for (int it = 0; it < 8; ++it) { const int c = t2 + it * 512; const int r = c >> 4, ch = c & 15; *(LAS u32x4*)(Tt + r * 136 + ch * 8) = zr[it]; }
        __syncthreads();
#pragma unroll
        for (int a = 0; a < 4; ++a)
#pragma unroll
            for (int m = 0; m < 4; ++m) { const f32x4 mu4 = *(const LAS f32x4*)(mu + a * 64 + m * 16 + q4e);
                f32x4 sq;
#pragma unroll
                for (int i = 0; i < 4; ++i) { const float dv = H[a][m][i] - mu4[i]; H[a][m][i] = dv; sq[i] = dpp_sum16(dv * dv); }
                if (c16 == 0) *(LAS f32x4*)(st2 + w * 256 + a * 64 + m * 16 + q4e) = sq; }
        __syncthreads();
        if (t2 < 256) { float ss = 0.f;
#pragma unroll
            for (int ww = 0; ww < 8; ++ww) ss += st2[ww * 256 + t2];
            rsr[t2] = frsqrt(ss * (1.0f / 128.f) + EPS); }
        __syncthreads();
        const float gn = p.mlstm_g[h * 128 + w * 16 + c16];
#pragma unroll
        for (int a = 0; a < 4; ++a)
#pragma unroll
            for (int m = 0; m < 4; ++m) { const f32x4 rs4 = *(const LAS f32x4*)(rsr + a * 64 + m * 16 + q4e);
#pragma unroll
                for (int i = 0; i < 4; ++i) { LAS bf16_t* zp = Tt + (a * 64 + m * 16 + q4e + i) * 136 + w * 16 + c16;
                    *zp = f2bf(H[a][m][i] * rs4[i] * gn * silu(bf2f(*zp))); } }
        __syncthreads();
        if (!dry) {
#pragma unroll
            for (int it = 0; it < 8; ++it) { const int c = t2 + it * 512; const int r = c >> 4, ch = c & 15;
                *(u32x4*)UP(p, (unsigned)(rowb + r) * NU + UC_V + h * 128 + ch * 8) = *(const LAS u32x4*)(Tt + r * 136 + ch * 8); }
        }
        __syncthreads();
    }
}

__device__ __forceinline__ void pre_load(const MP& p, LAS unsigned char* lds, int blk) {
    const int tid = otid();
    LAS bf16_t* raw = (LAS bf16_t*)lds;
    const int tl0 = (blk * 64) & (SEQ - 1); const size_t brow = (size_t)(blk * 64 - tl0);
#pragma unroll
    for (int it = 0; it < 9; ++it) { const int c = tid + it * 512; if (c >= 68 * 64) break; const int r = c >> 6, ch = c & 63; const int tl = tl0 - 2 + r;
        u32x4 v = (u32x4){0u, 0u, 0u, 0u};
        if (tl >= 0 && tl < SEQ) v = *(const u32x4*)UP(p, (unsigned)(brow + tl) * NU + UC_Q + ch * 8);
        *(LAS u32x4*)(raw + r * 520 + ch * 8) = v; }
    LAS bf16_t* vt = raw + 68 * 520;
#pragma unroll
    for (int it = 0; it < 2; ++it) { const int c = tid + it * 512; const int kvh = c >> 9, t = (c >> 3) & 63, ch = c & 7;
        *(LAS u32x4*)(vt + (kvh * 64 + t) * 72 + ch * 8) = *(const u32x4*)UP(p, (unsigned)(blk * 64 + t) * NU + UB_V + kvh * 64 + ch * 8); }
}
__device__ __forceinline__ void pre_write(const MP& p, LAS unsigned char* lds, int blk) {
    const int tid = otid();
    LAS bf16_t* raw = (LAS bf16_t*)lds;
    const size_t row0 = (size_t)blk * 64;
    __syncthreads();
    {
        const int ch = tid & 63;
        f32x4 w0[5], w1[5];
#pragma unroll
        for (int j = 0; j < 5; ++j) { w0[j] = *(const f32x4*)(p.conv_w + j * 512 + ch * 8); w1[j] = *(const f32x4*)(p.conv_w + j * 512 + ch * 8 + 4); }
        const float sc = (ch < 32) ? 0.125f : 1.0f;
#pragma unroll 2
        for (int it = 0; it < 8; ++it) { const int r = (tid >> 6) + 8 * it;
            float acc[8];
#pragma unroll
            for (int e = 0; e < 8; ++e) acc[e] = 0.f;
#pragma unroll
            for (int j = 0; j < 5; ++j) { const u32x4 x = *(const LAS u32x4*)(raw + (r + j) * 520 + ch * 8);
                acc[0] = fmaf(bf2f(x.x & 0xffffu), w0[j][0], acc[0]); acc[1] = fmaf(bf2f(x.x >> 16), w0[j][1], acc[1]); acc[2] = fmaf(bf2f(x.y & 0xffffu), w0[j][2], acc[2]); acc[3] = fmaf(bf2f(x.y >> 16), w0[j][3], acc[3]);
                acc[4] = fmaf(bf2f(x.z & 0xffffu), w1[j][0], acc[4]); acc[5] = fmaf(bf2f(x.z >> 16), w1[j][1], acc[5]); acc[6] = fmaf(bf2f(x.w & 0xffffu), w1[j][2], acc[6]); acc[7] = fmaf(bf2f(x.w >> 16), w1[j][3], acc[7]); }
#pragma unroll
            for (int e = 0; e < 8; ++e) acc[e] = silu(acc[e]) * sc;
            *(u32x4*)UP(p, (unsigned)(row0 + r) * NU + UC_Q + ch * 8) = (u32x4){pk2(acc[0], acc[1]), pk2(acc[2], acc[3]), pk2(acc[4], acc[5]), pk2(acc[6], acc[7])}; }
    }
    { LAS bf16_t* vt = raw + 68 * 520;
#pragma unroll 1
      for (int it = 0; it < 2; ++it) { const int c = tid + it * 512; const int kvh = c >> 9, d = (c >> 3) & 63, ch = c & 7;
          const LAS bf16_t* src = vt + (kvh * 64 + ch * 8) * 72 + d;
          const u32x4 o = (u32x4){(unsigned)src[0] | ((unsigned)src[72] << 16), (unsigned)src[2 * 72] | ((unsigned)src[3 * 72] << 16), (unsigned)src[4 * 72] | ((unsigned)src[5 * 72] << 16), (unsigned)src[6 * 72] | ((unsigned)src[7 * 72] << 16)};
          *(u32x4*)UP(p, (unsigned)(row0 + d) * NU + UB_V + kvh * 64 + ch * 8) = o; } }
#pragma unroll
    for (int it = 0; it < 2; ++it) { const int c = tid + it * 512; if (c >= 64 * 10) break; const int r = c / 10, hh = c % 10;
        bf16_t* ptr = UP(p, (unsigned)(row0 + r) * NU + (hh < 8 ? UB_Q + hh * 64 : UB_K + (hh - 8) * 64));
        const u32x4 a = *(const u32x4*)ptr, bb = *(const u32x4*)(ptr + 8);
        const f32x4 c0 = *(const f32x4*)(p.cs + (row0 + r) * 8), c1 = *(const f32x4*)(p.cs + (row0 + r) * 8 + 4), s0 = *(const f32x4*)(p.sn + (row0 + r) * 8), s1 = *(const f32x4*)(p.sn + (row0 + r) * 8 + 4);
        const float cs[8] = {c0[0], c0[1], c0[2], c0[3], c1[0], c1[1], c1[2], c1[3]}, sn[8] = {s0[0], s0[1], s0[2], s0[3], s1[0], s1[1], s1[2], s1[3]};
        const float x1[8] = {bf2f(a.x & 0xffffu), bf2f(a.x >> 16), bf2f(a.y & 0xffffu), bf2f(a.y >> 16), bf2f(a.z & 0xffffu), bf2f(a.z >> 16), bf2f(a.w & 0xffffu), bf2f(a.w >> 16)};
        const float x2[8] = {bf2f(bb.x & 0xffffu), bf2f(bb.x >> 16), bf2f(bb.y & 0xffffu), bf2f(bb.y >> 16), bf2f(bb.z & 0xffffu), bf2f(bb.z >> 16), bf2f(bb.w & 0xffffu), bf2f(bb.w >> 16)};
        float r1[8], r2[8];
#pragma unroll
        for (int e = 0; e < 8; ++e) { r1[e] = x1[e] * cs[e] - x2[e] * sn[e]; r2[e] = x2[e] * cs[e] + x1[e] * sn[e]; }
        *(u32x4*)ptr = (u32x4){pk2(r1[0], r1[1]), pk2(r1[2], r1[3]), pk2(r1[4], r1[5]), pk2(r1[6], r1[7])};
        *(u32x4*)(ptr + 8) = (u32x4){pk2(r2[0], r2[1]), pk2(r2[2], r2[3]), pk2(r2[4], r2[5]), pk2(r2[6], r2[7])}; }
    __syncthreads();
}
}
#include <hip/hip_cooperative_groups.h>
namespace cg = cooperative_groups;
namespace fr {
using namespace mk;
constexpr int M = 16384, DM = 1024, DIN = 6928, NB = 4;
constexpr size_t MiB = 1u << 20;
constexpr int LDS_BYTES = 147456;
#ifndef MK_MULTI
#define MK_MULTI 0
#endif
constexpr int NPHASE = 12;
constexpr size_t WS_CTL = 0, CTL_ZERO_BYTES = 256 * 1024;
constexpr size_t WS_BAR = 16 * 1024;
constexpr size_t WS_SS = 64 * 1024;
constexpr size_t WS_LB = 256 * 1024;
constexpr size_t WS_DA = WS_LB + 4096;
constexpr size_t WS_CS = WS_DA + 2 * 16 * 16 * 128 * 4;
constexpr size_t WS_U = 1 * MiB;
constexpr size_t WS_R2 = 217 * MiB;
constexpr size_t WS_WTIN = WS_R2;
constexpr size_t WS_SA = WS_R2;
constexpr size_t WS_SC = WS_R2 + 16 * MiB;
constexpr size_t WS_WTOUT = WS_R2 + 25 * MiB;
constexpr size_t WS_KV = WS_R2 + 33 * MiB;
constexpr size_t WS_GATES = WS_R2 + 37 * MiB;
constexpr size_t WS_CSN = WS_R2 + 38 * MiB;
static_assert(WS_CSN + 1 * MiB == 256 * MiB, "ws map");
static_assert(WS_U + (size_t)M * NU * 2 == WS_R2, "u fills [1, 217) MiB");
constexpr size_t DO_XB = 0;
constexpr size_t DO_LO = 32 * MiB;
constexpr size_t DO_WTKV = 32 * MiB;
constexpr size_t DO_MEMN = 36 * MiB;

#define XB_TMO      128
#define XB_XCNT(j)  (256  + 64 * (j))
#define XB_XSUB(j)  (1280 + 64 * (j))
#define XB_XGEN(j)  (2304 + 64 * (j))
#define XB_TOP      3328
#define XB_TOPGEN   3392
#define XCD_BAR_WORDS 3456
#define XB_SPIN_CAP (1u << 18)

__device__ __forceinline__ unsigned xb_ld(unsigned* p)              { return __hip_atomic_load(p, __ATOMIC_RELAXED, __HIP_MEMORY_SCOPE_AGENT); }
__device__ __forceinline__ unsigned xb_add(unsigned* p, unsigned v) { return __hip_atomic_fetch_add(p, v, __ATOMIC_RELAXED, __HIP_MEMORY_SCOPE_AGENT); }
__device__ __forceinline__ unsigned xb_xcc_id() { return (unsigned)__builtin_amdgcn_s_getreg((3 << 11) | 20) & 0xFu; }
#define XB_SPIN(cond, bar) do { unsigned _sp = 0; while (cond) { __builtin_amdgcn_s_sleep(1); \
    if ((++_sp & 255u) == 0u) { if (xb_ld(&(bar)[XB_TMO])) break; if (_sp > XB_SPIN_CAP) { atomicAdd(&(bar)[XB_TMO], 1u); break; } } } } while (0)

struct XcdBarrier {
    unsigned* bar; unsigned x;
    volatile LAS unsigned* st;
};

__device__ __forceinline__ XcdBarrier xcd_barrier_post(unsigned* bar, volatile LAS unsigned* st) {
    XcdBarrier b; b.bar = bar; b.x = xb_xcc_id(); b.st = st;
    if (threadIdx.x == 0) (void)xb_add(&bar[XB_XCNT(b.x)], 1u);
    return b;
}
__device__ __forceinline__ void xcd_barrier_complete(unsigned* bar, unsigned x, unsigned& nloc, unsigned& nx) {
    const unsigned G = gridDim.x * gridDim.y * gridDim.z;
    unsigned sum, cnt, mine, sp = 0u;
    for (;;) {
        sum = 0u; cnt = 0u; mine = 0u;
#pragma unroll 1
        for (unsigned j = 0; j < 16; ++j) { const unsigned c = xb_ld(&bar[XB_XCNT(j)]); sum += c; cnt += (c > 0u) ? 1u : 0u; mine = (j == x) ? c : mine; }
        if (sum == G) break;
        __builtin_amdgcn_s_sleep(1);
        if ((++sp & 255u) == 0u) { if (xb_ld(&bar[XB_TMO])) break; if (sp > XB_SPIN_CAP) { atomicAdd(&bar[XB_TMO], 1u); break; } }
    }
    nloc = mine > 0u ? mine : 1u; nx = cnt > 0u ? cnt : 1u;
}

__device__ __forceinline__ void xcd_barrier(const XcdBarrier& b) {
    asm volatile("s_waitcnt vmcnt(0)" ::: "memory");
    __syncthreads();
    if (threadIdx.x == 0) {
        unsigned* bar = b.bar;
        __builtin_amdgcn_s_waitcnt(0);
        unsigned nloc = b.st[0], nx = b.st[1];
        if (nloc == 0u) { xcd_barrier_complete(bar, b.x, nloc, nx); b.st[0] = nloc; b.st[1] = nx; }
        const unsigned old = xb_add(&bar[XB_XSUB(b.x)], 1u);
        const unsigned gen = old / nloc;
        if (old + 1u == (gen + 1u) * nloc) {
            __builtin_amdgcn_fence(__ATOMIC_RELEASE, "agent");
            asm volatile("s_waitcnt vmcnt(0)" ::: "memory");
            const unsigned og = xb_add(&bar[XB_TOP], 1u);
            const unsigned tg = og / nx;
            if (og + 1u == (tg + 1u) * nx) xb_add(&bar[XB_TOPGEN], 1u);
            else XB_SPIN(xb_ld(&bar[XB_TOPGEN]) == tg, bar);
            __builtin_amdgcn_fence(__ATOMIC_ACQUIRE, "agent");
            xb_add(&bar[XB_XGEN(b.x)], 1u);
            asm volatile("s_waitcnt vmcnt(0)" ::: "memory");
        } else {
            XB_SPIN(xb_ld(&bar[XB_XGEN(b.x)]) == gen, bar);
            __builtin_amdgcn_fence(__ATOMIC_ACQUIRE, "agent");
            asm volatile("s_waitcnt vmcnt(0)" ::: "memory");
        }
    }
    __syncthreads();
}


struct KP {
    const float* x; const float* mem; const int* pos; const float* norm_g; const float* w_in; const float* lb_logits; const float* hgrn_g; const float* sink;
    const float* conv_w; const float* gate_b; const float* mlstm_g; const float* mem_g; const float* w_kv; const float* w_out; const float* final_g;
    float* out; unsigned char* ws;
};

__device__ const double INVF[8] = {1.0, 0.19392274474868576, 0.03760603093086393, 0.007292664737217109, 0.001414213562373095, 0.0002742481756762073, 5.318295896944988e-05, 1.031338537721246e-05};

struct EpiFinal {
    static constexpr bool PERM = true, AFTER_DRAIN = true;
    const bf16_t* hi; const bf16_t* lo; float* ssn; const float* fg; float* out; XcdBarrier bar;
    __device__ __forceinline__ void fused(pg8::f32x4 (&acc)[2][2][4][2], const pg8::Unit& u, int wr, int wc, int fr, int fq, PG8_LAS unsigned char*, int, int) const {
        using pg8::f32x4;
        const int row0 = u.pm * 256 + wr * 64 + fr; const int col0 = u.pn * 256 + wc * 32 + 8 * fq;
#pragma unroll
        for (int ai = 0; ai < 2; ++ai)
#pragma unroll
            for (int m = 0; m < 4; ++m) { const int r = row0 + ai * 128 + m * 16; float part = 0.f;
#pragma unroll
                for (int bj = 0; bj < 2; ++bj) { const size_t e = (size_t)r * 1024 + col0 + bj * 128;
                    const u32x4 h = *(const u32x4*)(hi + e), l = *(const u32x4*)(lo + e);
                    const f32x4 xa = (f32x4){bf2f(h.x & 0xffffu) + bf2f(l.x & 0xffffu), bf2f(h.x >> 16) + bf2f(l.x >> 16), bf2f(h.y & 0xffffu) + bf2f(l.y & 0xffffu), bf2f(h.y >> 16) + bf2f(l.y >> 16)};
                    const f32x4 xb = (f32x4){bf2f(h.z & 0xffffu) + bf2f(l.z & 0xffffu), bf2f(h.z >> 16) + bf2f(l.z >> 16), bf2f(h.w & 0xffffu) + bf2f(l.w & 0xffffu), bf2f(h.w >> 16) + bf2f(l.w >> 16)};
                    const f32x4 va = xa + acc[ai][bj][m][0], vb = xb + acc[ai][bj][m][1]; acc[ai][bj][m][0] = va; acc[ai][bj][m][1] = vb;
                    part += ((va[0] * va[0] + va[1] * va[1]) + (va[2] * va[2] + va[3] * va[3])) + ((vb[0] * vb[0] + vb[1] * vb[1]) + (vb[2] * vb[2] + vb[3] * vb[3])); }
                part += __shfl_xor(part, 16); part += __shfl_xor(part, 32);
                if (fq == 0) atomicAdd(ssn + r, part); }
        xcd_barrier(bar);
#pragma unroll
        for (int ai = 0; ai < 2; ++ai)
#pragma unroll
            for (int m = 0; m < 4; ++m) { const int r = row0 + ai * 128 + m * 16;
                const float rs = 1.0f / sqrtf(__hip_atomic_load(ssn + r, __ATOMIC_RELAXED, __HIP_MEMORY_SCOPE_AGENT) * (1.0f / 1024.f) + 1e-6f);
#pragma unroll
                for (int bj = 0; bj < 2; ++bj) { const int c = col0 + bj * 128; const f32x4 ga = *(const f32x4*)(fg + c), gb = *(const f32x4*)(fg + c + 4);
                    *(f32x4*)(out + (size_t)r * 1024 + c) = acc[ai][bj][m][0] * rs * ga; *(f32x4*)(out + (size_t)r * 1024 + c + 4) = acc[ai][bj][m][1] * rs * gb; } }
    }
};
__device__ __forceinline__ float wave_sum(float v) {
#pragma unroll
    for (int o = 1; o < 64; o <<= 1) v += __shfl_xor(v, o);
    return v;
}
__device__ __forceinline__ int new_col_to_old(int c) {
    if (c < 512) return 0 + c;
    if (c < 1024) return 2560 + (c - 512);
    if (c < 1536) return 4352 + (c - 1024);
    if (c < 2048) return 5904 + (c - 1536);
    if (c < 2560) return 512 + (c - 2048);
    if (c < 3072) return 1024 + (c - 2560);
    if (c < 3584) return 1536 + (c - 3072);
    if (c < 4096) return 2048 + (c - 3584);
    if (c < 4224) return 3072 + (c - 4096);
    if (c < 4352) return 3200 + (c - 4224);
    if (c < 4864) return 3328 + (c - 4352);
    if (c < 5120) return 3840 + (c - 4864);
    if (c < 5376) return 4096 + (c - 5120);
    if (c < 5888) return 4864 + (c - 5376);
    if (c < 6400) return 5376 + (c - 5888);
    return 6416 + (c - 6400);
}
__device__ __forceinline__ void transpose_item(const float* W, int K, int N, bf16_t* WT, int k0, int src_col0, int dst_row0, const float* kscale, LAS float* scr, int lane) {
    float wv[32];
#pragma unroll
    for (int i = 0; i < 32; ++i) { const int kk = 2 * i + (lane >> 5); wv[i] = W[(size_t)(k0 + kk) * N + src_col0 + (lane & 31)]; }
    if (kscale) {
#pragma unroll
        for (int i = 0; i < 32; ++i) wv[i] *= kscale[k0 + 2 * i + (lane >> 5)]; }
#pragma unroll
    for (int i = 0; i < 32; ++i) { const int kk = 2 * i + (lane >> 5); scr[kk * 33 + (lane & 31)] = wv[i]; }
    asm volatile("s_waitcnt lgkmcnt(0)" ::: "memory");
    const int c = lane & 7;
#pragma unroll
    for (int j = 0; j < 4; ++j) { const int n = (lane >> 3) + 8 * j; const LAS float* s = scr + (8 * c) * 33 + n;
        u32x4 o; o.x = pk2(s[0 * 33], s[1 * 33]); o.y = pk2(s[2 * 33], s[3 * 33]); o.z = pk2(s[4 * 33], s[5 * 33]); o.w = pk2(s[6 * 33], s[7 * 33]);
        *(u32x4*)(WT + (size_t)(dst_row0 + n) * K + k0 + 8 * c) = o; }
    asm volatile("s_waitcnt lgkmcnt(0)" ::: "memory");
}
__device__ __forceinline__ void convert_wtin(const KP& a, int l, LAS unsigned char* lds, int gw, int ngw, int wave, int lane) {
    LAS float* scr = (LAS float*)(lds + wave * 8448);
    bf16_t* WT = (bf16_t*)(a.ws + WS_WTIN);
    for (int it = gw; it < 16 * 216; it += ngw) { const int kb = it / 216, nbk = it % 216;
        transpose_item(a.w_in + (size_t)l * DM * DIN, DM, DIN, WT, kb * 64, new_col_to_old(nbk * 32), nbk * 32, a.norm_g + l * DM, scr, lane); }
}
__device__ __forceinline__ void gates_block(const KP& a, int l, LAS unsigned char* lds, const bf16_t* xb, const float* ss, int blk) {
    const int tid = otid(), lane = tid & 63, w = __builtin_amdgcn_readfirstlane(tid >> 6);
    float* gates = (float*)(a.ws + WS_GATES);
    LAS bf16_t* A2 = (LAS bf16_t*)lds; LAS bf16_t* B2 = A2 + 64 * 520;
    f32x4 acc = (f32x4){0.f, 0.f, 0.f, 0.f};
    for (int kh = 0; kh < 2; ++kh) {
#pragma unroll
        for (int it = 0; it < 8; ++it) { const int c = tid + it * 512; const int r = c >> 6, ch = c & 63;
            *(LAS u32x4*)(A2 + r * 520 + ch * 8) = *(const u32x4*)(xb + (size_t)(blk * 64 + r) * DM + kh * 512 + ch * 8); }
#pragma unroll
        for (int it = 0; it < 16; ++it) { const int c = tid + it * 512; const int j = c & 15, k = c >> 4; const int kg = kh * 512 + k;
            B2[j * 520 + k] = f2bf(a.w_in[((size_t)l * DM + kg) * DIN + 5888 + j] * a.norm_g[l * DM + kg]); }
        __syncthreads();
        if (w < 4) mma_nt<512>(acc, A2, 520, w * 16, B2, 520, 0, lane);
        __syncthreads();
    }
    if (w < 4) {
#pragma unroll
        for (int i = 0; i < 4; ++i) { const int r = blk * 64 + w * 16 + 4 * (lane >> 4) + i; const float rs = 1.0f / sqrtf(ss[r] * (1.0f / 1024.f) + 1e-6f);
            gates[(size_t)r * 16 + (lane & 15)] = acc[i] * rs; }
    }
}

__device__ __forceinline__ void prologue(const KP& a, LAS unsigned char* lds) {
    const int tid = otid(), lane = tid & 63, wave = __builtin_amdgcn_readfirstlane(tid >> 6);
    const int G = gridDim.x, gw = blockIdx.x * 8 + wave, ngw = G * 8;
    LAS float* scr = (LAS float*)(lds + wave * 8448);
    float* ss0 = (float*)(a.ws + WS_SS);
    bf16_t* xb = (bf16_t*)((unsigned char*)a.out + DO_XB);
    for (int blk = blockIdx.x; blk < M / 64; blk += G) {
#pragma unroll 4
        for (int rr = wave; rr < 64; rr += 8) { const int r = blk * 64 + rr;
            const f32x4* xr = (const f32x4*)(a.x + (size_t)r * DM) + 2 * lane;
            f32x4 v[4]; float s = 0.f;
#pragma unroll
            for (int j = 0; j < 4; ++j) { v[j] = xr[128 * (j >> 1) + (j & 1)]; s += (v[j][0] * v[j][0] + v[j][1] * v[j][1]) + (v[j][2] * v[j][2] + v[j][3] * v[j][3]); }
            s = wave_sum(s);
            if (lane == 0) ss0[r] = s;
            u32x4* o16 = (u32x4*)(xb + (size_t)r * DM) + lane;
#pragma unroll
            for (int j = 0; j < 2; ++j) o16[64 * j] = (u32x4){pk2(v[2 * j][0], v[2 * j][1]), pk2(v[2 * j][2], v[2 * j][3]), pk2(v[2 * j + 1][0], v[2 * j + 1][1]), pk2(v[2 * j + 1][2], v[2 * j + 1][3])};
        }
    }
    convert_wtin(a, 0, lds, gw, ngw, wave, lane);
    for (int it = gw; it < 2 * 32 * 32; it += ngw) { const int l = it >> 10, r = it & 1023, kb = r >> 5, nbk = r & 31;
        transpose_item(a.w_out + (size_t)l * 2048 * DM, 2048, DM, (bf16_t*)(a.ws + WS_WTOUT) + (size_t)l * DM * 2048, kb * 64, nbk * 32, nbk * 32, nullptr, scr, lane); }
    for (int it = gw; it < 2 * 16 * 32; it += ngw) { const int l = it >> 9, r = it & 511, kb = r >> 5, nbk = r & 31;
        transpose_item(a.w_kv + (size_t)l * DM * 1024, DM, 1024, (bf16_t*)((unsigned char*)a.out + DO_WTKV) + (size_t)l * 1024 * DM, kb * 64, nbk * 32, nbk * 32, nullptr, scr, lane); }
    for (int it = gw; it < 2 * 1024; it += ngw) { const int l = it >> 10, r = it & 1023;
        const f32x4* xr = (const f32x4*)(a.mem + (size_t)r * DM) + lane; const f32x4* gr = (const f32x4*)(a.mem_g + l * DM) + lane;
        f32x4 v[4]; float s = 0.f;
#pragma unroll
        for (int j = 0; j < 4; ++j) { v[j] = xr[64 * j]; s += (v[j][0] * v[j][0] + v[j][1] * v[j][1]) + (v[j][2] * v[j][2] + v[j][3] * v[j][3]); }
        const float rs = 1.0f / sqrtf(wave_sum(s) * (1.0f / 1024.f) + 1e-6f);
        u32x2* o8 = (u32x2*)((bf16_t*)((unsigned char*)a.out + DO_MEMN) + ((size_t)l * 1024 + r) * DM) + lane;
#pragma unroll
        for (int j = 0; j < 4; ++j) { const f32x4 g = gr[64 * j]; o8[64 * j] = (u32x2){pk2(v[j][0] * rs * g[0], v[j][1] * rs * g[1]), pk2(v[j][2] * rs * g[2], v[j][3] * rs * g[3])}; }
    }
    {
        float* cs = (float*)(a.ws + WS_CSN); float* sn = cs + (size_t)M * 8;
        for (int i = blockIdx.x * 512 + tid; i < M * 8; i += G * 512) { const int t = i >> 3, j = i & 7;
            const double inv = INVF[j];
            const double ang = (double)a.pos[t] * inv;
            const double kq = rint(ang * 0.15915494309189535);
            const float r = (float)fma(-kq, 1.2246467991473532e-16 * 2.0, fma(-kq, 6.283185307179586, ang));
            cs[i] = cosf(r); sn[i] = sinf(r); }
        if (blockIdx.x == 0) { float* lb = (float*)(a.ws + WS_LB);
            const float l0 = a.lb_logits[tid], l1 = a.lb_logits[512 + tid]; const float m = fmaxf(l0, l1); const float e0 = __expf(l0 - m), e1 = __expf(l1 - m);
            lb[tid] = 0.f; lb[512 + tid] = e1 / (e0 + e1); }
    }
    __syncthreads();
}

__device__ __forceinline__ MP make_mp(const KP& a, int l) {
    MP p;
    p.u = (bf16_t*)(a.ws + WS_U); p.gates = (const float*)(a.ws + WS_GATES); p.kv = (const bf16_t*)(a.ws + WS_KV) + (size_t)l * 1024 * 1024;
    p.cs = (const float*)(a.ws + WS_CSN); p.sn = p.cs + (size_t)M * 8; p.lb = (const float*)(a.ws + WS_LB) + l * 512;
    p.hgrn_g = a.hgrn_g + l * 512; p.sink = a.sink + l * 8; p.conv_w = a.conv_w + (size_t)l * 5 * 512; p.gate_b = a.gate_b + l * 16; p.mlstm_g = a.mlstm_g + l * 512;
    p.SA = (bf16_t*)(a.ws + WS_SA); p.DA = (float*)(a.ws + WS_DA); p.SC = (bf16_t*)(a.ws + WS_SC); p.CS = (float*)(a.ws + WS_CS); p.nb = NB;
    return p;
}

#ifndef REP_STEP
#define REP_STEP 0
#endif
#ifndef REP_N
#define REP_N 3
#endif
#ifndef STEP_MASK
#define STEP_MASK 0xffff
#endif
#define ST_ON(i) ((STEP_MASK >> (i)) & 1)
#ifndef PROBE
#define PROBE 0
#endif
#ifndef PROBE_GAIN
#define PROBE_GAIN 1
#endif
#ifndef PROBE_A
#define PROBE_A 1
#endif
#ifndef PROBE_B
#define PROBE_B 2
#endif
constexpr size_t WS_TS = 32 * 1024;

__device__ __forceinline__ int opq(int v) { asm volatile("" : "+s"(v)); return v; }
__device__ __forceinline__ void step_gates(const KP& a, int l, LAS unsigned char* lds) {
    const int G = gridDim.x;
    const bf16_t* xb = (const bf16_t*)((unsigned char*)a.out + DO_XB);
    const float* ss = (const float*)(a.ws + WS_SS) + (size_t)l * M;
    for (int blk = blockIdx.x; blk < M / 64; blk += G) gates_block(a, l, lds, xb, ss, blk);
    __syncthreads();
}
__device__ __forceinline__ void step_g1(const KP& a, int l, LAS unsigned char* lds) {
    const int G = gridDim.x;
    const bf16_t* xb = (const bf16_t*)((unsigned char*)a.out + DO_XB);
    const float* ss = (const float*)(a.ws + WS_SS) + (size_t)l * M;
    {
        pg8::Gemm g{xb, (const bf16_t*)(a.ws + WS_WTIN), M, NU, DM, DM};
        pg8::StaticOrder S; S.init(M, NU, G, (int)blockIdx.x);
        pg8::EpiIn E{(bf16_t*)(a.ws + WS_U), NU, ss};
        pg8::gemm_phase<pg8::EpiIn, pg8::StaticOrder, true, true>((PG8_LAS unsigned char*)lds, g, S, E);
    }
    if (l == 0) {
        __syncthreads();
        pg8::Gemm g{(const bf16_t*)((unsigned char*)a.out + DO_MEMN), (const bf16_t*)((unsigned char*)a.out + DO_WTKV), 2048, 2048, DM, DM};
        pg8::KvOrder S{(int)blockIdx.x, G - 64 > 0 ? G - 64 : 0};
        pg8::EpiKv E{(bf16_t*)(a.ws + WS_KV)};
        pg8::gemm_phase<pg8::EpiKv, pg8::KvOrder, false, true>((PG8_LAS unsigned char*)lds, g, S, E);
    }
}
__device__ __forceinline__ void step_g2(const KP& a, int l, LAS unsigned char* lds, const XcdBarrier& xb, int dry = 0) {
    const int G = gridDim.x;
    pg8::Gemm g{(const bf16_t*)(a.ws + WS_U), (const bf16_t*)(a.ws + WS_WTOUT) + (size_t)l * DM * 2048, M, DM, 2048, NU};
    pg8::StaticOrder S; S.init(M, DM, G, (int)blockIdx.x);
    bf16_t* hi = (bf16_t*)((unsigned char*)a.out + DO_XB); bf16_t* lo = (bf16_t*)((unsigned char*)a.out + DO_LO);
    float* ssn = (float*)(a.ws + WS_SS) + (size_t)(l + 1) * M;
    if (l == 0) { pg8::EpiOut<0> E{a.x, hi, lo, nullptr, 0, 0, ssn, dry}; pg8::gemm_phase<pg8::EpiOut<0>, pg8::StaticOrder, true, true>((PG8_LAS unsigned char*)lds, g, S, E); }
    else {
#if PROBE || (REP_STEP != 0)
        pg8::EpiOut<1> E{nullptr, hi, lo, (float*)(a.ws + WS_U), NU / 2, 1024, ssn, dry}; pg8::gemm_phase<pg8::EpiOut<1>, pg8::StaticOrder, true, true>((PG8_LAS unsigned char*)lds, g, S, E);
#else
        EpiFinal E{hi, lo, ssn, a.final_g, a.out, xb}; pg8::gemm_phase<EpiFinal, pg8::StaticOrder, false, true>((PG8_LAS unsigned char*)lds, g, S, E);
#endif
    }
}
__device__ __forceinline__ void step_final(const KP& a, float oscale = 1.0f) {
    const int tid = otid(), lane = tid & 63, wave = __builtin_amdgcn_readfirstlane(tid >> 6);
    const int gw = blockIdx.x * 8 + wave, ngw = gridDim.x * 8;
    const float* ss2 = (const float*)(a.ws + WS_SS) + (size_t)2 * M;
    const float* x2 = (const float*)(a.ws + WS_U);
    for (int r = gw; r < M; r += ngw) {
        const float rs = 1.0f / sqrtf(ss2[r] * (1.0f / 1024.f) + 1e-6f);
        const f32x4* xr = (const f32x4*)(x2 + (size_t)r * (NU / 2) + 1024) + lane; const f32x4* gr = (const f32x4*)a.final_g + lane;
        f32x4* orow = (f32x4*)(a.out + (size_t)r * DM) + lane;
#pragma unroll
        for (int j = 0; j < 4; ++j) { const f32x4 v = xr[64 * j], g = gr[64 * j]; orow[64 * j] = v * (rs * oscale) * g; }
    }
}

__global__ void __launch_bounds__(512, 2) mega_fwd(KP a) {
    extern __shared__ __attribute__((aligned(16))) unsigned char lds_raw[];
    LAS unsigned char* lds = (LAS unsigned char*)lds_raw;
    cg::grid_group grid = cg::this_grid();
    volatile LAS unsigned* xst = (volatile LAS unsigned*)(lds + LDS_BYTES - 16);
    if (threadIdx.x < 4) xst[threadIdx.x] = 0u;
    __syncthreads();
    XcdBarrier xbar = xcd_barrier_post((unsigned*)(a.ws + WS_BAR), xst);
    const int G = gridDim.x;
    const int vcu = (G % 8 == 0) ? (int)(blockIdx.x % 8) * (G / 8) + (int)(blockIdx.x / 8) : (int)blockIdx.x;
#if PROBE
    unsigned long long* ts = (unsigned long long*)(a.ws + WS_TS); int nst = 0;
#define STAMP() do { if (blockIdx.x == 0 && threadIdx.x == 0) ts[nst] = __builtin_amdgcn_s_memrealtime(); ++nst; } while (0)
#define PSEAM() do { xcd_barrier(xbar); STAMP(); } while (0)
    STAMP();
#else
#define STAMP() do {} while (0)
#define PSEAM() do {} while (0)
#endif
#define SEAM() do { xcd_barrier(xbar); STAMP(); } while (0)
    if (REP_STEP == 1) { for (int r = 0, rn = opq(REP_N - 1); r < rn; ++r) prologue(a, lds); }
    if (ST_ON(0)) prologue(a, lds);
    if (a.ws == nullptr) grid.sync();
    xcd_barrier(xbar); STAMP();
    if (REP_STEP == 13) { for (int r = 0, rn = opq(20); r < rn; ++r) xcd_barrier(xbar); }
    if (REP_STEP == 14) { for (int r = 0, rn = opq(4); r < rn; ++r) grid.sync(); }
#pragma unroll 1
    for (int l = 0; l < 2; ++l) {
        if (REP_STEP == 2 && l == 0) { for (int r = 0, rn = opq(REP_N - 1); r < rn; ++r) step_gates(a, l, lds); }
        if (ST_ON(1)) step_gates(a, l, lds); PSEAM();
        if (REP_STEP == 3 && l == 0) { for (int r = 0, rn = opq(REP_N - 1); r < rn; ++r) step_g1(a, l, lds); }
        if (ST_ON(2)) step_g1(a, l, lds); SEAM();
        {
            const MP p = make_mp(a, l);
            if (ST_ON(3)) for (int blk = blockIdx.x; blk < M / 64; blk += G) { pre_load(p, lds, blk); xcd_barrier(xbar); pre_write(p, lds, blk); }
            xcd_barrier(xbar);
#if PROBE
            if (blockIdx.x == 0 && threadIdx.x == 0) ts[50 + l] = __builtin_amdgcn_s_memrealtime();
#endif
            const int nB = NB * 128, nA = NB * 128, nC = NB * 128, nD = NB * 64;
#if PROBE
            for (int it = blockIdx.x; it < nB; it += G) b_item(p, lds, it);
            PSEAM();
            for (int it = blockIdx.x; it < nA; it += G) a_pass1(p, lds, it);
            PSEAM();
            for (int it = blockIdx.x; it < nC; it += G) c_pass1(p, lds, it);
            PSEAM();
            for (int it = blockIdx.x; it < nD; it += G) d_item(p, lds, it);
#else
            if (l == 0 && REP_STEP >= 4 && REP_STEP <= 7) { for (int r = 0, rn = opq(REP_N - 1); r < rn; ++r) { const bool dry = opq(1) != 0;
                if (REP_STEP == 4) for (int it = blockIdx.x; it < nB; it += G) b_item(p, lds, it, dry);
                if (REP_STEP == 5) for (int it = blockIdx.x; it < nA; it += G) a_pass1(p, lds, it);
                if (REP_STEP == 6) for (int it = blockIdx.x; it < nC; it += G) c_pass1(p, lds, it);
                if (REP_STEP == 7) for (int it = blockIdx.x; it < nD; it += G) d_item(p, lds, it, dry); } }
            for (int it = vcu; it < nB + nA + nC + nD; it += G) {
                if (it < nB) { if (ST_ON(4)) b_item(p, lds, it); }
                else if (it < nB + nA) { if (ST_ON(5)) a_pass1(p, lds, it - nB); }
                else if (it < nB + nA + nC) { if (ST_ON(6)) c_pass1(p, lds, it - nB - nA); }
                else { if (ST_ON(7)) d_item(p, lds, it - nB - nA - nC); }
            }
#endif
            SEAM();
            {
                const int nAu = NB * 8 * 4096, nCu = NB * 8 * 2304;
                if (l == 0 && REP_STEP == 8) { for (int r = 0, rn = opq(REP_N - 1); r < rn; ++r) { const bool dry = opq(1) != 0;
                    for (int uu = blockIdx.x * 512 + otid(); uu < nAu + nCu; uu += G * 512) { if (uu < nAu) a_scan_unit(p, uu, dry); else c_scan_unit(p, uu - nAu, dry); } } }
                for (int uu = blockIdx.x * 512 + otid(); uu < nAu + nCu; uu += G * 512) { if (uu < nAu) a_scan_unit(p, uu); else c_scan_unit(p, uu - nAu); }
            }
            SEAM();
#if PROBE
            for (int it = blockIdx.x; it < NB * 64; it += G) a_pass3(p, lds, it);
            PSEAM();
            for (int it = blockIdx.x; it < NB * 64; it += G) c_pass3(p, lds, it);
#else
            if (l == 0 && (REP_STEP == 9 || REP_STEP == 10)) { for (int r = 0, rn = opq(REP_N - 1); r < rn; ++r) { const bool dry = opq(1) != 0;
                if (REP_STEP == 9) for (int it = blockIdx.x; it < NB * 64; it += G) a_pass3(p, lds, it, dry);
                if (REP_STEP == 10) for (int it = blockIdx.x; it < NB * 64; it += G) c_pass3(p, lds, it, dry); } }
            for (int it = blockIdx.x; it < NB * 128; it += G) { if (it < NB * 64) { if (ST_ON(9)) a_pass3(p, lds, it); } else { if (ST_ON(10)) c_pass3(p, lds, it - NB * 64); } }
#endif
            SEAM();
        }
        if (l == 0) { const int tid = otid(); convert_wtin(a, 1, lds, blockIdx.x * 8 + (tid >> 6), G * 8, __builtin_amdgcn_readfirstlane(tid >> 6), tid & 63); __syncthreads(); PSEAM(); }
        if (REP_STEP == 12 && l == 0) { for (int r = 0, rn = opq(REP_N - 1); r < rn; ++r) { step_g2(a, l, lds, xbar, opq(1)); } }
#if PROBE || (REP_STEP != 0)
        step_g2(a, l, lds, xbar); SEAM();
#else
        step_g2(a, l, lds, xbar); if (l == 0) SEAM();
#endif
    }
#if PROBE == 2
    {
        xcd_barrier(xbar);
        const unsigned long long* tsx = (PROBE_A >= 100) ? (const unsigned long long*)((const float*)(a.ws + WS_CS) + 4096) - 100 : ts;
        const float d = (float)(tsx[PROBE_B] - tsx[PROBE_A]) * 0.01f;
        step_final(a, 1.0f + sqrtf(d * 2e-7f * (float)PROBE_GAIN));
    }
#elif PROBE
    {
        const float dA = (float)(ts[PROBE_A] - ts[PROBE_A - 1]) * 0.01f, dB = (float)(ts[PROBE_B] - ts[PROBE_B - 1]) * 0.01f;
        const float c = sqrtf(dA * 0.1f);
        for (size_t i = (size_t)blockIdx.x * 512 + threadIdx.x; i < (size_t)M * DM; i += (size_t)G * 512) a.out[i] = (i == 0) ? (20.f + dB) : c;
    }
#elif (REP_STEP != 0)
    step_final(a);
#endif
}
}

extern "C" void kernel_launch(void* const* d_in, const int* in_sizes, int n_in,
                              void* d_out, int out_size, void* d_ws, size_t ws_size,
                              hipStream_t stream) {
    using namespace fr;
    static int grid_blocks = 0;
    if (!grid_blocks) {
        int dev = 0, cus = 0, per_cu = 0;
        (void)hipGetDevice(&dev);
        (void)hipDeviceGetAttribute(&cus, hipDeviceAttributeMultiprocessorCount, dev);
        (void)hipFuncSetAttribute((const void*)mega_fwd, hipFuncAttributeMaxDynamicSharedMemorySize, LDS_BYTES);
        (void)hipOccupancyMaxActiveBlocksPerMultiprocessor(&per_cu, (const void*)mega_fwd, 512, LDS_BYTES);
        if (per_cu < 1) per_cu = 1;
        grid_blocks = cus * (per_cu > 1 ? 1 : per_cu);
    }
    KP a{};
    a.x = (const float*)d_in[0]; a.mem = (const float*)d_in[1]; a.pos = (const int*)d_in[2]; a.norm_g = (const float*)d_in[3]; a.w_in = (const float*)d_in[4];
    a.lb_logits = (const float*)d_in[5]; a.hgrn_g = (const float*)d_in[6]; a.sink = (const float*)d_in[7]; a.conv_w = (const float*)d_in[8]; a.gate_b = (const float*)d_in[9];
    a.mlstm_g = (const float*)d_in[10]; a.mem_g = (const float*)d_in[11]; a.w_kv = (const float*)d_in[12]; a.w_out = (const float*)d_in[13]; a.final_g = (const float*)d_in[14];
    a.out = (float*)d_out; a.ws = (unsigned char*)d_ws;
    (void)hipMemsetAsync((char*)d_ws + WS_CTL, 0, CTL_ZERO_BYTES, stream);
    void* args[] = {&a};
    (void)hipLaunchCooperativeKernel((const void*)mega_fwd, dim3(grid_blocks), dim3(512), args, LDS_BYTES, stream);
}
```

```cpp
#include <hip/hip_runtime.h>
#include <math.h>
namespace pg8 {
#define PG8_LAS __attribute__((address_space(3)))

#define PG8_WTAB_ADDR (147456 - 16 - 256)
__device__ __forceinline__ int tid_now() {
    const unsigned slot = (unsigned)__builtin_amdgcn_s_getreg(4 | (0 << 6) | (5 << 11));
    const int wv = __builtin_amdgcn_readfirstlane(*(const volatile PG8_LAS int*)(PG8_WTAB_ADDR + 4 * slot));
    const int lane = (int)__builtin_amdgcn_mbcnt_hi(~0u, __builtin_amdgcn_mbcnt_lo(~0u, 0u));
    return (wv << 6) | lane;
}
__device__ __forceinline__ void tid_table_init() {
    const unsigned slot = (unsigned)__builtin_amdgcn_s_getreg(4 | (0 << 6) | (5 << 11));
    if ((threadIdx.x & 63) == 0) *(volatile PG8_LAS int*)(PG8_WTAB_ADDR + 4 * slot) = (int)(threadIdx.x >> 6);
}

typedef unsigned short bf16_t;
typedef short bf16x8 __attribute__((ext_vector_type(8)));
typedef float f32x4 __attribute__((ext_vector_type(4)));
typedef unsigned u32x4 __attribute__((ext_vector_type(4)));
constexpr int BM = 256, BK = 64, HALF = 128, HTB = HALF * BK * 2  , STAGE_BYTES = 8 * HTB, NXCD = 8, WGM = 8;

__host__ __device__ __forceinline__ int lds_byte(int r, int c) { const int st = (r >> 4) * 2 + (c >> 5), rr = r & 15, cc = c & 31, ob = rr * 64 + cc * 2; return st * 1024 + (ob ^ (((ob >> 9) & 1) << 5)); }
__host__ __device__ __forceinline__ void stage_rc(int b, int& R, int& C) { const int st = b / 1024, sb = b % 1024, swz = sb ^ (((sb >> 9) & 1) << 5); R = (st >> 1) * 16 + swz / 64; C = (st & 1) * 32 + (swz % 64) / 2; }
__host__ __device__ __forceinline__ int perm32(int rho) { const int n = rho >> 4, i = rho & 15; return 8 * (i >> 2) + 4 * n + (i & 3); }

struct Unit { int pm, pn; };
struct Gemm { const bf16_t* A; const bf16_t* Bt; int M, N, K, lda; };

struct StaticOrder {
    int nM, nN, nwg, G, c, wgm;
    __host__ __device__ void init(int M, int N, int G_, int c_, int wgm_ = WGM) { nM = M / BM; nN = N / BM; nwg = nM * nN; G = G_; c = c_; wgm = wgm_; }
    __host__ __device__ bool next(int i, Unit& u) const {
        const long L = (long)i * G + c; if (L >= nwg) return false;
        int wgid = (int)L; { const int q = nwg / NXCD, r = nwg % NXCD, xcd = wgid % NXCD, off = wgid / NXCD; wgid = (xcd < r ? xcd * (q + 1) : r * (q + 1) + (xcd - r) * q) + off; }
        const int nig = wgm * nN, gid = wgid / nig, fm = gid * wgm, gsz = (nM - fm) < wgm ? (nM - fm) : wgm;
        u.pm = fm + ((wgid % nig) % gsz); u.pn = (wgid % nig) / gsz; return true;
    }
    __device__ __forceinline__ void a_ready(const Unit&) const {}
    __device__ __forceinline__ void done(const Unit&) const {}
};

__device__ __forceinline__ unsigned cvt_pk_bf16(float lo, float hi) { unsigned r; asm volatile("v_cvt_pk_bf16_f32 %0, %1, %2" : "=v"(r) : "v"(lo), "v"(hi)); return r; }

__device__ __forceinline__ float bf2f_(unsigned h16) { return __uint_as_float(h16 << 16); }
struct EpiIn {
    static constexpr bool PERM = true, AFTER_DRAIN = false;
    bf16_t* O; int ldc; const float* ss; bf16_t* halo;
    __device__ __forceinline__ void operator()(const f32x4 (&acc)[2][2][4][2], const Unit& u, int wr, int wc, int fr, int fq) const {
        asm volatile("" : "+v"(fr), "+v"(fq));
        const int row0 = u.pm * BM + wr * 64 + fr; const int col0 = u.pn * BM + wc * 32 + 8 * fq;
        const bool hal = (u.pn == 19) || (u.pn == 20);
        float rsv[2][4];
#pragma unroll
        for (int ai = 0; ai < 2; ++ai)
#pragma unroll
            for (int m = 0; m < 4; ++m) rsv[ai][m] = ss[row0 + ai * HALF + m * 16];
        __builtin_amdgcn_sched_barrier(0);
#pragma unroll
        for (int ai = 0; ai < 2; ++ai)
#pragma unroll
            for (int m = 0; m < 4; ++m) { const int r = row0 + ai * HALF + m * 16; const float rs = 1.0f / sqrtf(rsv[ai][m] * (1.0f / 1024.f) + 1e-6f);
                bf16_t* rowp = O + (size_t)r * ldc + col0;
#pragma unroll
                for (int bj = 0; bj < 2; ++bj) { const f32x4 v0 = acc[ai][bj][m][0] * rs, v1 = acc[ai][bj][m][1] * rs;
                    u32x4 w; w.x = cvt_pk_bf16(v0[0], v0[1]); w.y = cvt_pk_bf16(v0[2], v0[3]); w.z = cvt_pk_bf16(v1[0], v1[1]); w.w = cvt_pk_bf16(v1[2], v1[3]);
                    *(u32x4*)(rowp + bj * HALF) = w;
                    if ((m == 0 || m == 3) && hal && (m == 0 ? fr < 2 : fr >= 14))
                        *(u32x4*)(halo + ((size_t)(r >> 6) * 4 + (m == 0 ? fr : fr - 12)) * 512 + (u.pn - 19) * BM + wc * 32 + 8 * fq + bj * HALF) = w; } }
    }
};
struct EpiKv {
    static constexpr bool PERM = true, AFTER_DRAIN = false;
    bf16_t* O;
    __device__ __forceinline__ void operator()(const f32x4 (&acc)[2][2][4][2], const Unit& u, int wr, int wc, int fr, int fq) const {
        asm volatile("" : "+v"(fr), "+v"(fq));
        const int l = u.pm >> 2, rl0 = (u.pm & 3) * BM + wr * 64 + fr; const int col0 = (u.pn & 3) * BM + wc * 32 + 8 * fq;
        bf16_t* Ol = O + (size_t)l * 1024 * 1024;
#pragma unroll
        for (int ai = 0; ai < 2; ++ai)
#pragma unroll
            for (int m = 0; m < 4; ++m) { const int r = rl0 + ai * HALF + m * 16;
#pragma unroll
                for (int bj = 0; bj < 2; ++bj) { const f32x4 v0 = acc[ai][bj][m][0], v1 = acc[ai][bj][m][1]; const int c = col0 + bj * HALF;
                    u32x4 w; w.x = cvt_pk_bf16(v0[0], v0[1]); w.y = cvt_pk_bf16(v0[2], v0[3]); w.z = cvt_pk_bf16(v1[0], v1[1]); w.w = cvt_pk_bf16(v1[2], v1[3]);
                    if (c < 512) *(u32x4*)(Ol + (size_t)r * 512 + c) = w;
                    else { bf16_t* vt = Ol + 512 * 1024 + ((size_t)(r >> 8) * 512 + (c - 512)) * 256 + (r & 255);
                        vt[0 * 256] = (bf16_t)(w.x & 0xffffu); vt[1 * 256] = (bf16_t)(w.x >> 16); vt[2 * 256] = (bf16_t)(w.y & 0xffffu); vt[3 * 256] = (bf16_t)(w.y >> 16);
                        vt[4 * 256] = (bf16_t)(w.z & 0xffffu); vt[5 * 256] = (bf16_t)(w.z >> 16); vt[6 * 256] = (bf16_t)(w.w & 0xffffu); vt[7 * 256] = (bf16_t)(w.w >> 16); } } }
    }
};
typedef unsigned u32x2e __attribute__((ext_vector_type(2)));
template <int LAYER> struct EpiOut {
    static constexpr bool PERM = true, AFTER_DRAIN = false;
    const float* x0; bf16_t* hi; bf16_t* lo; float* x2; int xs, xo; float* ssn; int dry;
    __device__ __forceinline__ void ldhalf(u32x4& ra, u32x4& rb, int row0, int col0, int st) const {
        const size_t e = (size_t)(row0 + (st >> 3) * HALF + ((st >> 1) & 3) * 16) * 1024 + col0 + (st & 1) * HALF;
        if (LAYER == 0) { ra = *(const u32x4*)(x0 + e); rb = *(const u32x4*)(x0 + e + 4); }
        else { ra = *(const u32x4*)(hi + e); rb = *(const u32x4*)(lo + e); }
    }
    __device__ __forceinline__ void operator()(const f32x4 (&acc)[2][2][4][2], const Unit& u, int wr, int wc, int fr, int fq) const {
        asm volatile("" : "+v"(fr), "+v"(fq));
        const int row0 = u.pm * BM + wr * 64 + fr; const int col0 = u.pn * BM + wc * 32 + 8 * fq;
        u32x4 ra, rb;
        ldhalf(ra, rb, row0, col0, 0);
        float part = 0.f;
#pragma unroll
        for (int st = 0; st < 16; ++st) { const int ai = st >> 3, m = (st >> 1) & 3, bj = st & 1; const int r = row0 + ai * HALF + m * 16;
            u32x4 na, nb;
            if (st < 15) ldhalf(na, nb, row0, col0, st + 1);
            __builtin_amdgcn_sched_barrier(0);
            { const int c = col0 + bj * HALF; const size_t e = (size_t)r * 1024 + c;
                f32x4 xa, xb;
                if (LAYER == 0) { xa = __builtin_bit_cast(f32x4, ra); xb = __builtin_bit_cast(f32x4, rb); }
                else { const u32x4 h = ra, l = rb;
                    xa = (f32x4){bf2f_(h.x & 0xffffu) + bf2f_(l.x & 0xffffu), bf2f_(h.x >> 16) + bf2f_(l.x >> 16), bf2f_(h.y & 0xffffu) + bf2f_(l.y & 0xffffu), bf2f_(h.y >> 16) + bf2f_(l.y >> 16)};
                    xb = (f32x4){bf2f_(h.z & 0xffffu) + bf2f_(l.z & 0xffffu), bf2f_(h.z >> 16) + bf2f_(l.z >> 16), bf2f_(h.w & 0xffffu) + bf2f_(l.w & 0xffffu), bf2f_(h.w >> 16) + bf2f_(l.w >> 16)}; }
                const f32x4 va = xa + acc[ai][bj][m][0], vb = xb + acc[ai][bj][m][1];
                part += ((va[0] * va[0] + va[1] * va[1]) + (va[2] * va[2] + va[3] * va[3])) + ((vb[0] * vb[0] + vb[1] * vb[1]) + (vb[2] * vb[2] + vb[3] * vb[3]));
                if (LAYER == 0) {
                    u32x4 hw; hw.x = cvt_pk_bf16(va[0], va[1]); hw.y = cvt_pk_bf16(va[2], va[3]); hw.z = cvt_pk_bf16(vb[0], vb[1]); hw.w = cvt_pk_bf16(vb[2], vb[3]);
                    const f32x4 da = va - (f32x4){bf2f_(hw.x & 0xffffu), bf2f_(hw.x >> 16), bf2f_(hw.y & 0xffffu), bf2f_(hw.y >> 16)};
                    const f32x4 db = vb - (f32x4){bf2f_(hw.z & 0xffffu), bf2f_(hw.z >> 16), bf2f_(hw.w & 0xffffu), bf2f_(hw.w >> 16)};
                    u32x4 lw; lw.x = cvt_pk_bf16(da[0], da[1]); lw.y = cvt_pk_bf16(da[2], da[3]); lw.z = cvt_pk_bf16(db[0], db[1]); lw.w = cvt_pk_bf16(db[2], db[3]);
                    if (!dry) { *(u32x4*)(hi + e) = hw; *(u32x4*)(lo + e) = lw; }
                } else { if (!dry) { *(f32x4*)(x2 + (size_t)r * xs + xo + c) = va; *(f32x4*)(x2 + (size_t)r * xs + xo + c + 4) = vb; } } }
            if (bj == 1) { part += __shfl_xor(part, 16); part += __shfl_xor(part, 32);
                if (fq == 0 && !dry) atomicAdd(ssn + r, part);
                part = 0.f; }
            if (st < 15) { ra = na; rb = nb; }
        }
    }
};
struct KvOrder {
    int c, c0;
    __device__ bool next(int i, Unit& u) const { const int t = c - c0; if (i != 0 || t < 0 || t >= 32) return false; const int l = t >> 4; u.pm = l * 4 + ((t >> 2) & 3); u.pn = l * 4 + (t & 3); return true; }
    __device__ __forceinline__ void a_ready(const Unit&) const {}
    __device__ __forceinline__ void done(const Unit&) const {}
};

template <class Epi, class Sched, bool ALIGN_EPI = false, bool SP2 = false>
__device__ __forceinline__ void gemm_phase(PG8_LAS unsigned char* lds, const Gemm g, const Sched& S, const Epi& E) {
    int tid = tid_now(); asm volatile("" : "+v"(tid)); const int wid = __builtin_amdgcn_readfirstlane(tid >> 6), lane = tid & 63, wr = wid >> 2, wc = wid & 3, fr = lane & 15, fq = lane >> 4;
    const int K = g.K, nt = K / BK;
    unsigned voffA[2], voffB[2];
#pragma unroll
    for (int i = 0; i < 2; ++i) { int R, C; stage_rc(tid * 16 + i * 8192, R, C); const int Rb = Epi::PERM ? ((R & ~31) + perm32(R & 31)) : R;
        voffA[i] = (unsigned)(R * g.lda + C) * 2u; voffB[i] = (unsigned)(Rb * K + C) * 2u; }
    const size_t kstep = (size_t)(BK * 2);
    const size_t hstep = (size_t)HALF * K * 2, hstepA = (size_t)HALF * g.lda * 2;
    const size_t tstep = 2 * hstep, tstepA = 2 * hstepA;
    const unsigned ldsw = (unsigned)wid * 1024u;
    const int aoff = lds_byte(wr * 64 + fr, fq * 8), boff = lds_byte(wc * 32 + fr, fq * 8);
#define PG8_SA(b, h) (((b) * 2 + (h)) * HTB)
#define PG8_SB(b, h) ((4 + (b) * 2 + (h)) * HTB)
#define PG8_STAGE(bufoff, gbase, voff) do { _Pragma("unroll") for (int _i = 0; _i < 2; ++_i) \
        __builtin_amdgcn_global_load_lds((const unsigned*)((const char*)(gbase) + (voff)[_i]), (PG8_LAS unsigned*)(lds + (bufoff) + ldsw + _i * 8192), 16, 0, 0); } while (0)
#define PG8_LDA(dst, b, h) do { _Pragma("unroll") for (int m = 0; m < 4; ++m) _Pragma("unroll") for (int k = 0; k < 2; ++k) dst[m][k] = *(const PG8_LAS bf16x8*)(lds + PG8_SA(b, h) + aoff + m * 2048 + k * 1024); } while (0)
#define PG8_LDB(dst, b, h) do { _Pragma("unroll") for (int n = 0; n < 2; ++n) _Pragma("unroll") for (int k = 0; k < 2; ++k) dst[n][k] = *(const PG8_LAS bf16x8*)(lds + PG8_SB(b, h) + boff + n * 2048 + k * 1024); } while (0)
#define PG8_MMA(ai, bj, At, Bt) do { __builtin_amdgcn_s_setprio(1); _Pragma("unroll") for (int m = 0; m < 4; ++m) _Pragma("unroll") for (int n = 0; n < 2; ++n) _Pragma("unroll") for (int k = 0; k < 2; ++k) \
        acc[ai][bj][m][n] = __builtin_amdgcn_mfma_f32_16x16x32_bf16(Bt[n][k], At[m][k], acc[ai][bj][m][n], 0, 0, 0); __builtin_amdgcn_s_setprio(0); } while (0)
#define PG8_WAIT_V(n) asm volatile("s_waitcnt vmcnt(" #n ")" ::: "memory")
#define PG8_WAIT_L(n) asm volatile("s_waitcnt lgkmcnt(" #n ")" ::: "memory")
#define PG8_BAR __builtin_amdgcn_s_barrier()
#define PG8_SCHED __builtin_amdgcn_sched_barrier(0)
    Unit cur, nxt; int ui = 0;
    if (!S.next(0, cur)) return;
    f32x4 acc[2][2][4][2];
#pragma unroll
    for (int a = 0; a < 2; ++a)
#pragma unroll
        for (int b = 0; b < 2; ++b)
#pragma unroll
            for (int m = 0; m < 4; ++m)
#pragma unroll
                for (int n = 0; n < 2; ++n) acc[a][b][m][n] = (f32x4){0.f, 0.f, 0.f, 0.f};
    bf16x8 At[4][2], B0[2][2], B1[2][2];
    const char* cA = (const char*)g.A + (size_t)cur.pm * tstepA; const char* cB = (const char*)g.Bt + (size_t)cur.pn * tstep;
    S.a_ready(cur);
    if constexpr (SP2) {
        PG8_STAGE(PG8_SB(0, 0), cB, voffB); PG8_STAGE(PG8_SB(0, 1), cB + hstep, voffB); PG8_STAGE(PG8_SA(0, 0), cA, voffA); PG8_STAGE(PG8_SA(0, 1), cA + hstepA, voffA);
        if (wr == 1) PG8_BAR;
        PG8_WAIT_V(2); PG8_BAR;
        PG8_STAGE(PG8_SB(1, 0), cB + kstep, voffB); PG8_STAGE(PG8_SA(1, 0), cA + kstep, voffA); PG8_STAGE(PG8_SB(1, 1), cB + hstep + kstep, voffB);
        PG8_WAIT_V(6); PG8_BAR;
    } else {
        PG8_STAGE(PG8_SB(0, 0), cB, voffB); PG8_STAGE(PG8_SA(0, 0), cA, voffA); PG8_STAGE(PG8_SB(0, 1), cB + hstep, voffB); PG8_STAGE(PG8_SA(0, 1), cA + hstepA, voffA);
        if (wr == 1) PG8_BAR;
        PG8_WAIT_V(4); PG8_BAR;
        PG8_STAGE(PG8_SB(1, 0), cB + kstep, voffB); PG8_STAGE(PG8_SA(1, 0), cA + kstep, voffA); PG8_STAGE(PG8_SB(1, 1), cB + hstep + kstep, voffB);
        PG8_WAIT_V(6); PG8_BAR;
    }
    for (;;) {
        const bool has_next = S.next(ui + 1, nxt);
        const char* nA = has_next ? (const char*)g.A + (size_t)nxt.pm * tstepA : cA; const char* nB = has_next ? (const char*)g.Bt + (size_t)nxt.pn * tstep : cB;
        for (int t = 0; t < nt; t += 2) {
            const bool last = (t == nt - 2);
            const char* a1 = cA + (size_t)(t + 1) * kstep;
            const char* a2 = last ? nA : cA + (size_t)(t + 2) * kstep; const char* b2 = last ? nB : cB + (size_t)(t + 2) * kstep;
            const char* a3 = a2 + kstep; const char* b3 = b2 + kstep;
            if (last && has_next) S.a_ready(nxt);
            if constexpr (SP2) {
            PG8_LDB(B0, 0, 0); PG8_LDB(B1, 0, 1); PG8_SCHED; PG8_LDA(At, 0, 0); PG8_STAGE(PG8_SA(1, 1), a1 + hstepA, voffA);
            PG8_WAIT_V(8); PG8_WAIT_L(0); PG8_BAR; PG8_MMA(0, 0, At, B0); PG8_MMA(0, 1, At, B1); PG8_BAR; PG8_SCHED;
            PG8_LDA(At, 0, 1); PG8_STAGE(PG8_SB(0, 0), b2, voffB); PG8_STAGE(PG8_SB(0, 1), b2 + hstep, voffB); PG8_STAGE(PG8_SA(0, 0), a2, voffA);
            PG8_WAIT_V(8); PG8_WAIT_L(0); PG8_BAR; PG8_MMA(1, 0, At, B0); PG8_MMA(1, 1, At, B1); PG8_BAR; PG8_SCHED;
            PG8_LDB(B0, 1, 0); PG8_LDB(B1, 1, 1); PG8_SCHED; PG8_LDA(At, 1, 0); PG8_STAGE(PG8_SA(0, 1), a2 + hstepA, voffA);
            PG8_WAIT_V(8); PG8_WAIT_L(0); PG8_BAR; PG8_MMA(0, 0, At, B0); PG8_MMA(0, 1, At, B1); PG8_BAR; PG8_SCHED;
            PG8_LDA(At, 1, 1); PG8_STAGE(PG8_SB(1, 0), b3, voffB); PG8_STAGE(PG8_SB(1, 1), b3 + hstep, voffB); PG8_STAGE(PG8_SA(1, 0), a3, voffA);
            PG8_WAIT_V(8); PG8_WAIT_L(0); PG8_BAR; PG8_MMA(1, 0, At, B0); PG8_MMA(1, 1, At, B1); PG8_BAR; PG8_SCHED;
            } else {
            PG8_LDB(B0, 0, 0); PG8_SCHED; PG8_LDA(At, 0, 0); PG8_STAGE(PG8_SA(1, 1), a1 + hstepA, voffA);
            PG8_WAIT_L(8); PG8_BAR; PG8_WAIT_L(0); PG8_MMA(0, 0, At, B0); PG8_BAR; PG8_SCHED;
            PG8_LDB(B1, 0, 1); PG8_STAGE(PG8_SB(0, 0), b2, voffB);
            PG8_BAR; PG8_WAIT_L(0); PG8_MMA(0, 1, At, B1); PG8_BAR;
            PG8_LDA(At, 0, 1); PG8_STAGE(PG8_SA(0, 0), a2, voffA);
            PG8_BAR; PG8_WAIT_L(0); PG8_MMA(1, 0, At, B0); PG8_BAR; PG8_SCHED;
            PG8_STAGE(PG8_SB(0, 1), b2 + hstep, voffB);
            PG8_WAIT_V(6); PG8_BAR; PG8_MMA(1, 1, At, B1); PG8_BAR;
            PG8_LDB(B0, 1, 0); PG8_SCHED; PG8_LDA(At, 1, 0); PG8_STAGE(PG8_SA(0, 1), a2 + hstepA, voffA);
            PG8_WAIT_L(8); PG8_BAR; PG8_WAIT_L(0); PG8_MMA(0, 0, At, B0); PG8_BAR; PG8_SCHED;
            PG8_LDB(B1, 1, 1); PG8_STAGE(PG8_SB(1, 0), b3, voffB);
            PG8_BAR; PG8_WAIT_L(0); PG8_MMA(0, 1, At, B1); PG8_BAR;
            PG8_LDA(At, 1, 1); PG8_STAGE(PG8_SA(1, 0), a3, voffA);
            PG8_BAR; PG8_WAIT_L(0); PG8_MMA(1, 0, At, B0); PG8_BAR; PG8_SCHED;
            PG8_STAGE(PG8_SB(1, 1), b3 + hstep, voffB);
            PG8_WAIT_V(6); PG8_BAR; PG8_MMA(1, 1, At, B1); PG8_BAR;
            }
        }
        if constexpr (ALIGN_EPI) { if (wr == 0) PG8_BAR; }
        if constexpr (!Epi::AFTER_DRAIN) { E(acc, cur, wr, wc, fr, fq); S.done(cur); }
        if (!has_next) break;
#pragma unroll
        for (int a = 0; a < 2; ++a)
#pragma unroll
            for (int b = 0; b < 2; ++b)
#pragma unroll
                for (int m = 0; m < 4; ++m)
#pragma unroll
                    for (int n = 0; n < 2; ++n) acc[a][b][m][n] = (f32x4){0.f, 0.f, 0.f, 0.f};
        cur = nxt; cA = nA; cB = nB; ++ui;
        if constexpr (ALIGN_EPI) { if (wr == 1) PG8_BAR; }
    }
    PG8_WAIT_V(0);
    if constexpr (!ALIGN_EPI) { if (wr == 0) PG8_BAR; }
    PG8_BAR;
    if constexpr (Epi::AFTER_DRAIN) { E.fused(acc, cur, wr, wc, fr, fq, lds, wid, lane); S.done(cur); }
#undef PG8_SA
#undef PG8_SB
#undef PG8_STAGE
#undef PG8_LDA
#undef PG8_LDB
#undef PG8_MMA
#undef PG8_WAIT_V
#undef PG8_WAIT_L
#undef PG8_BAR
#undef PG8_SCHED
}
}
namespace mk {
#define LAS __attribute__((address_space(3)))
typedef unsigned short bf16_t;
typedef short bf16x8 __attribute__((ext_vector_type(8)));
typedef float f32x4 __attribute__((ext_vector_type(4)));
typedef unsigned u32x4 __attribute__((ext_vector_type(4)));
typedef unsigned u32x2 __attribute__((ext_vector_type(2)));

constexpr int SEQ = 4096, NU = 6912;
constexpr float EPS = 1e-6f;
constexpr int UA_Q = 0, UB_Q = 512, UC_V = 1024, UD_Q = 1536, UA_I = 2048, UA_FF = 2560, UA_FB = 3072, UA_Z = 3584;
constexpr int UB_K = 4096, UB_V = 4224, UB_Z = 4352, UC_Q = 4864, UC_K = 5120, UC_O = 5376, UC_Z = 5888, UD_Z = 6400;
constexpr int NSC = 16;
constexpr int SA_ELEMS = 128 * 128;
constexpr int SC_ROWS = 144, SC_ELEMS = SC_ROWS * 64;

struct MP {
    bf16_t* u;
    const bf16_t* halo;
    const float* gates;
    const bf16_t* kv;
    const float* cs; const float* sn;
    const float* lb;
    const float* hgrn_g; const float* sink; const float* conv_w; const float* gate_b; const float* mlstm_g;
    bf16_t* SA; float* DA;
    bf16_t* SC; float* CS;
    int nb;
};

__device__ __forceinline__ int otid() { int t = pg8::tid_now(); asm volatile("" : "+v"(t)); return t; }
#define UP(p, e) ((bf16_t*)((char*)(p).u + (size_t)(((unsigned)(e)) << 1)))
__device__ __forceinline__ float bf2f(unsigned short h) { return __uint_as_float((unsigned)h << 16); }
typedef float f32x2_t __attribute__((ext_vector_type(2))); typedef __bf16 bf16x2_t __attribute__((ext_vector_type(2)));
__device__ __forceinline__ unsigned pk2(float lo, float hi) { f32x2_t v = {lo, hi}; bf16x2_t b = __builtin_convertvector(v, bf16x2_t); return __builtin_bit_cast(unsigned, b); }
__device__ __forceinline__ unsigned short f2bf(float f) { return (unsigned short)(pk2(f, 0.f) & 0xffffu); }
__device__ __forceinline__ float sigm(float x) { return __builtin_amdgcn_rcpf(1.0f + __expf(-x)); }
__device__ __forceinline__ float silu(float x) { return x * __builtin_amdgcn_rcpf(1.0f + __expf(-x)); }
__device__ __forceinline__ float frsqrt(float x) { return __builtin_amdgcn_rsqf(x); }

template <int K>
__device__ __forceinline__ void mma_nt(f32x4& acc, const LAS bf16_t* A, int lda, int m0, const LAS bf16_t* Bt, int ldb, int n0, int lane) {
    const LAS bf16_t* ap = A + (m0 + (lane & 15)) * lda + 8 * (lane >> 4);
    const LAS bf16_t* bp = Bt + (n0 + (lane & 15)) * ldb + 8 * (lane >> 4);
#pragma unroll
    for (int k0 = 0; k0 < K; k0 += 32) {
        const bf16x8 a = *(const LAS bf16x8*)(ap + k0);
        const bf16x8 b = *(const LAS bf16x8*)(bp + k0);
        acc = __builtin_amdgcn_mfma_f32_16x16x32_bf16(a, b, acc, 0, 0, 0);
    }
}
template <int K>
__device__ __forceinline__ void ld_frags(bf16x8 (&f)[K / 32], const LAS bf16_t* T, int ld, int r0, int lane) {
    const LAS bf16_t* q = T + (r0 + (lane & 15)) * ld + 8 * (lane >> 4);
#pragma unroll
    for (int k = 0; k < K / 32; ++k) f[k] = *(const LAS bf16x8*)(q + 32 * k);
}
template <int K>
__device__ __forceinline__ void mma_fb(f32x4& acc, const LAS bf16_t* A, int lda, int m0, const bf16x8 (&b)[K / 32], int lane) {
    const LAS bf16_t* ap = A + (m0 + (lane & 15)) * lda + 8 * (lane >> 4);
#pragma unroll
    for (int k = 0; k < K / 32; ++k) { const bf16x8 a = *(const LAS bf16x8*)(ap + 32 * k); acc = __builtin_amdgcn_mfma_f32_16x16x32_bf16(a, b[k], acc, 0, 0, 0); }
}
template <int K>
__device__ __forceinline__ void mma_fa(f32x4& acc, const bf16x8 (&a)[K / 32], const LAS bf16_t* Bt, int ldb, int n0, int lane) {
    const LAS bf16_t* bp = Bt + (n0 + (lane & 15)) * ldb + 8 * (lane >> 4);
#pragma unroll
    for (int k = 0; k < K / 32; ++k) { const bf16x8 b = *(const LAS bf16x8*)(bp + 32 * k); acc = __builtin_amdgcn_mfma_f32_16x16x32_bf16(a[k], b, acc, 0, 0, 0); }
}
__device__ __forceinline__ float dpp_sum16(float v) {
    v += __builtin_bit_cast(float, __builtin_amdgcn_mov_dpp(__builtin_bit_cast(int, v), 0xB1, 0xF, 0xF, true));
    v += __builtin_bit_cast(float, __builtin_amdgcn_mov_dpp(__builtin_bit_cast(int, v), 0x4E, 0xF, 0xF, true));
    v += __builtin_bit_cast(float, __builtin_amdgcn_mov_dpp(__builtin_bit_cast(int, v), 0x141, 0xF, 0xF, true));
    v += __builtin_bit_cast(float, __builtin_amdgcn_mov_dpp(__builtin_bit_cast(int, v), 0x140, 0xF, 0xF, true));
    return v;
}
__device__ __forceinline__ float grp16_max(float v) { v = fmaxf(v, __shfl_xor(v, 1)); v = fmaxf(v, __shfl_xor(v, 2)); v = fmaxf(v, __shfl_xor(v, 4)); v = fmaxf(v, __shfl_xor(v, 8)); return v; }
__device__ __forceinline__ float grp16_sum(float v) { v += __shfl_xor(v, 1); v += __shfl_xor(v, 2); v += __shfl_xor(v, 4); v += __shfl_xor(v, 8); return v; }

__device__ __forceinline__ bf16x8 vt_frag(const LAS bf16_t* Vt, int ld, int dv, int s, int q4) {
    const u32x2 lo = *(const LAS u32x2*)(Vt + dv * ld + 32 * s + 4 * q4), hi = *(const LAS u32x2*)(Vt + dv * ld + 32 * s + 16 + 4 * q4);
    return __builtin_bit_cast(bf16x8, (u32x4){lo.x, lo.y, hi.x, hi.y});
}
__device__ __forceinline__ bf16x8 vt_frag2(const LAS bf16_t* Vt, int ld, int dv, int blk_lo, int blk_hi, int q4) {
    const u32x2 lo = *(const LAS u32x2*)(Vt + dv * ld + 16 * blk_lo + 4 * q4), hi = *(const LAS u32x2*)(Vt + dv * ld + 16 * blk_hi + 4 * q4);
    return __builtin_bit_cast(bf16x8, (u32x4){lo.x, lo.y, hi.x, hi.y});
}
__device__ __forceinline__ bf16x8 p_frag(const f32x4& a, const f32x4& b) {
    return __builtin_bit_cast(bf16x8, (u32x4){pk2(a[0], a[1]), pk2(a[2], a[3]), pk2(b[0], b[1]), pk2(b[2], b[3])});
}
__device__ __forceinline__ float quad_max(float v) { v = fmaxf(v, __shfl_xor(v, 16)); return fmaxf(v, __shfl_xor(v, 32)); }
__device__ __forceinline__ float quad_sum(float v) { v += __shfl_xor(v, 16); return v + __shfl_xor(v, 32); }
__device__ __forceinline__ u32x4 gate8(u32x4 y, u32x4 z) {
    float r[8];
    const unsigned yy[4] = {y.x, y.y, y.z, y.w}, zz[4] = {z.x, z.y, z.z, z.w};
#pragma unroll
    for (int e = 0; e < 4; ++e) { r[2 * e] = bf2f((unsigned short)(yy[e] & 0xffffu)) * silu(bf2f((unsigned short)(zz[e] & 0xffffu))); r[2 * e + 1] = bf2f((unsigned short)(yy[e] >> 16)) * silu(bf2f((unsigned short)(zz[e] >> 16))); }
    return (u32x4){pk2(r[0], r[1]), pk2(r[2], r[3]), pk2(r[4], r[5]), pk2(r[6], r[7])};
}

__device__ __forceinline__ void d_item(const MP& p, LAS unsigned char* lds, int item, bool dry = false) {
    const int tid = otid(), lane = tid & 63, w = __builtin_amdgcn_readfirstlane(tid >> 6);
    const int qt = item & 15, h = (item >> 4) & 3, b = item >> 6;
    const size_t row0 = (size_t)b * SEQ + qt * 256;
    LAS bf16_t* Qs = (LAS bf16_t*)lds;
    LAS bf16_t* KV = Qs + 256 * 136;
    const int q4 = lane >> 4, c16 = lane & 15;
#pragma unroll
    for (int it = 0; it < 8; ++it) { const int c = tid + it * 512; const int r = c >> 4, ch = c & 15;
        *(LAS u32x4*)(Qs + r * 136 + ch * 8) = *(const u32x4*)UP(p, (unsigned)(row0 + r) * NU + UD_Q + h * 128 + ch * 8); }
#pragma unroll
    for (int it = 0; it < 8; ++it) { const int c = tid + it * 512; const int r = c >> 4, ch = c & 15;
        *(LAS u32x4*)(KV + r * 136 + ch * 8) = *(const u32x4*)(p.kv + ((size_t)b * 256 + r) * 512 + h * 128 + ch * 8); }
    __syncthreads();
    u32x4 vr[8];
    { const int t3 = otid();
#pragma unroll
      for (int it = 0; it < 8; ++it) { const int c = t3 + it * 512; const int dvr = c >> 5, ch = c & 31; vr[it] = *(const u32x4*)(p.kv + 512 * 1024 + ((size_t)b * 512 + h * 128 + dvr) * 256 + ch * 8); } }
    bf16x8 pb[2][8]; float inv[2];
#pragma unroll
    for (int un = 0; un < 2; ++un) {
        bf16x8 qf[4]; ld_frags<128>(qf, Qs, 136, (w * 2 + un) * 16, lane);
        f32x4 S[16];
#pragma unroll
        for (int be = 0; be < 16; ++be) { S[be] = (f32x4){0.f, 0.f, 0.f, 0.f}; mma_fb<128>(S[be], KV, 136, be * 16, qf, lane); }
        const float c1 = 0.08838834764831845f * 1.4426950408889634f;
        float m = -INFINITY;
#pragma unroll
        for (int be = 0; be < 16; ++be)
#pragma unroll
            for (int i = 0; i < 4; ++i) m = fmaxf(m, S[be][i]);
        m = quad_max(m);
        const float m2 = m * c1;
        float sum = 0.f;
#pragma unroll
        for (int be = 0; be < 16; ++be)
#pragma unroll
            for (int i = 0; i < 4; ++i) { const float e = __builtin_amdgcn_exp2f(fmaf(S[be][i], c1, -m2)); S[be][i] = e; sum += e; }
        inv[un] = __builtin_amdgcn_rcpf(quad_sum(sum));
#pragma unroll
        for (int s8 = 0; s8 < 8; ++s8) pb[un][s8] = p_frag(S[2 * s8], S[2 * s8 + 1]);
        __builtin_amdgcn_sched_barrier(0);
    }
    __syncthreads();
#pragma unroll
    for (int it = 0; it < 8; ++it) { const int c = tid + it * 512; const int dvr = c >> 5, ch = c & 31; *(LAS u32x4*)(KV + dvr * 264 + ch * 8) = vr[it]; }
    u32x4 zr[8];
#pragma unroll
    for (int it = 0; it < 8; ++it) { const int c = tid + it * 512; const int r = c >> 4, ch = c & 15; zr[it] = *(const u32x4*)UP(p, (unsigned)(row0 + r) * NU + UD_Z + h * 128 + ch * 8); }
    __syncthreads();
#pragma unroll
    for (int dvb = 0; dvb < 8; ++dvb) { f32x4 o0 = (f32x4){0.f, 0.f, 0.f, 0.f}, o1 = o0;
#pragma unroll
        for (int s8 = 0; s8 < 8; ++s8) { const bf16x8 a = vt_frag(KV, 264, dvb * 16 + c16, s8, q4);
            o0 = __builtin_amdgcn_mfma_f32_16x16x32_bf16(a, pb[0][s8], o0, 0, 0, 0); o1 = __builtin_amdgcn_mfma_f32_16x16x32_bf16(a, pb[1][s8], o1, 0, 0, 0); }
        *(LAS u32x2*)(Qs + ((w * 2) * 16 + c16) * 136 + dvb * 16 + 4 * q4) = (u32x2){pk2(o0[0] * inv[0], o0[1] * inv[0]), pk2(o0[2] * inv[0], o0[3] * inv[0])};
        *(LAS u32x2*)(Qs + ((w * 2 + 1) * 16 + c16) * 136 + dvb * 16 + 4 * q4) = (u32x2){pk2(o1[0] * inv[1], o1[1] * inv[1]), pk2(o1[2] * inv[1], o1[3] * inv[1])}; }
    __syncthreads();
#pragma unroll
    for (int it = 0; it < 8; ++it) { const int c = tid + it * 512; const int r = c >> 4, ch = c & 15;
        const u32x4 yv = gate8(*(const LAS u32x4*)(Qs + r * 136 + ch * 8), zr[it]);
        if (!dry) *(u32x4*)UP(p, (unsigned)(row0 + r) * NU + UD_Q + h * 128 + ch * 8) = yv; }
    __syncthreads();
}

__device__ __forceinline__ void b_item(const MP& p, LAS unsigned char* lds, int item, bool dry = false) {
    const int tid = otid(), lane = tid & 63, w = __builtin_amdgcn_readfirstlane(tid >> 6);
    const int qt = item & 63, kvh = (item >> 6) & 1, b = item >> 7;
    const int t0 = qt * 64; const size_t brow = (size_t)b * SEQ;
    LAS bf16_t* Ks = (LAS bf16_t*)lds;
    LAS bf16_t* Vt = Ks + 320 * 72;
    LAS bf16_t* Qs = Vt + 64 * 328;
    const int k0 = t0 - 128;
    const int q4 = lane >> 4, c16 = lane & 15;
    {   const int r = tid >> 3, ch = tid & 7;
        u32x4 qr[4];
#pragma unroll
        for (int g = 0; g < 4; ++g) qr[g] = *(const u32x4*)UP(p, (unsigned)(brow + t0 + r) * NU + UB_Q + (kvh * 4 + g) * 64 + ch * 8);
        u32x4 kr[5];
#pragma unroll
        for (int it = 0; it < 5; ++it) { const int kb = k0 + 64 * it; kr[it] = (u32x4){0u, 0u, 0u, 0u};
            if (kb >= 0 && kb < SEQ) kr[it] = *(const u32x4*)UP(p, (unsigned)(brow + kb + r) * NU + UB_K + kvh * 64 + ch * 8); }
        __builtin_amdgcn_sched_barrier(0);
#pragma unroll
        for (int g = 0; g < 4; ++g) *(LAS u32x4*)(Qs + (g * 64 + r) * 72 + ch * 8) = qr[g];
        u32x4 vr[5];
#pragma unroll
        for (int it = 0; it < 5; ++it) { const int kb = k0 + 64 * it; vr[it] = (u32x4){0u, 0u, 0u, 0u};
            if (kb >= 0 && kb < SEQ) vr[it] = *(const u32x4*)UP(p, (unsigned)(brow + kb + r) * NU + UB_V + kvh * 64 + ch * 8); }
        __builtin_amdgcn_sched_barrier(0);
#pragma unroll
        for (int it = 0; it < 5; ++it) *(LAS u32x4*)(Ks + (it * 64 + r) * 72 + ch * 8) = kr[it];
        __builtin_amdgcn_sched_barrier(0);
#pragma unroll
        for (int it = 0; it < 5; ++it) *(LAS u32x4*)(Vt + r * 328 + it * 64 + ch * 8) = vr[it];
    }
    __syncthreads();
#pragma unroll 1
    for (int uu = w; uu < 16; uu += 8) {
        const int g = uu >> 2, qb = uu & 3;
        const float sk = p.sink[kvh * 4 + g];
        bf16x8 qf[2]; ld_frags<64>(qf, Qs + g * 64 * 72, 72, qb * 16, lane);
        f32x4 S[18];
#pragma unroll
        for (int rb = 0; rb < 17; ++rb) { S[rb] = (f32x4){0.f, 0.f, 0.f, 0.f}; mma_fb<64>(S[rb], Ks, 72, (qb + rb) * 16, qf, lane); }
        S[17] = (f32x4){0.f, 0.f, 0.f, 0.f};
        const bool edge = (t0 < 128) || (t0 + 192 > SEQ);
        float mr = -INFINITY;
        if (edge) {
#pragma unroll
            for (int rb = 0; rb < 17; ++rb)
#pragma unroll
                for (int i = 0; i < 4; ++i) { const int kp = k0 + (qb + rb) * 16 + 4 * q4 + i; if (kp < 0 || kp >= SEQ) S[rb][i] = -INFINITY; }
        }
#pragma unroll
        for (int rb = 0; rb < 17; ++rb)
#pragma unroll
            for (int i = 0; i < 4; ++i) { const int kq = 4 * q4 + i;
                if (rb == 0) { if (kq < c16) S[rb][i] = -INFINITY; }
                if (rb == 16) { if (kq > c16) S[rb][i] = -INFINITY; }
                mr = fmaxf(mr, S[rb][i]); }
        const float c1 = 0.125f * 1.4426950408889634f;
        const float m = fmaxf(quad_max(mr) * 0.125f, sk), m2 = m * 1.4426950408889634f;
        float sum = 0.f;
#pragma unroll
        for (int rb = 0; rb < 17; ++rb)
#pragma unroll
            for (int i = 0; i < 4; ++i) { const float e = __builtin_amdgcn_exp2f(fmaf(S[rb][i], c1, -m2)); S[rb][i] = e; sum += e; }
        const float inv = __builtin_amdgcn_rcpf(quad_sum(sum) + __expf(sk - m));
#pragma unroll
        for (int dvb = 0; dvb < 4; ++dvb) { f32x4 o = (f32x4){0.f, 0.f, 0.f, 0.f};
#pragma unroll
            for (int s9 = 0; s9 < 9; ++s9) o = __builtin_amdgcn_mfma_f32_16x16x32_bf16(vt_frag2(Vt, 328, dvb * 16 + c16, qb + 2 * s9, qb + (s9 < 8 ? 2 * s9 + 1 : 2 * s9), q4), p_frag(S[2 * s9], S[2 * s9 + 1]), o, 0, 0, 0);
            *(LAS u32x2*)(Qs + (g * 64 + qb * 16 + c16) * 72 + dvb * 16 + 4 * q4) = (u32x2){pk2(o[0] * inv, o[1] * inv), pk2(o[2] * inv, o[3] * inv)}; }
    }
    u32x4 zr[4];
    { const int t3 = otid();
#pragma unroll
      for (int g = 0; g < 4; ++g) zr[g] = *(const u32x4*)UP(p, (unsigned)(brow + t0 + (t3 >> 3)) * NU + UB_Z + (kvh * 4 + g) * 64 + (t3 & 7) * 8); }
    __syncthreads();
#pragma unroll
    for (int g = 0; g < 4; ++g) { const int r = tid >> 3, ch = tid & 7;
        const u32x4 yv = gate8(*(const LAS u32x4*)(Qs + (g * 64 + r) * 72 + ch * 8), zr[g]);
        if (!dry) *(u32x4*)UP(p, (unsigned)(brow + t0 + r) * NU + UB_Q + (kvh * 4 + g) * 64 + ch * 8) = yv; }
    __syncthreads();
}

constexpr int HT_LD = 132;
__device__ __forceinline__ void acc_to_lds(LAS float* Ht, const f32x4 (&O)[4][4], int w, int lane) {
    LAS float* base = Ht + (4 * (lane >> 4)) * HT_LD + w * 16 + (lane & 15);
#pragma unroll
    for (int a = 0; a < 4; ++a)
#pragma unroll
        for (int m = 0; m < 4; ++m)
#pragma unroll
            for (int i = 0; i < 4; ++i) base[(a * 64 + m * 16 + i) * HT_LD] = O[a][m][i];
}
__device__ __forceinline__ void unpack8(float (&f)[8], u32x4 v) {
    const unsigned vv[4] = {v.x, v.y, v.z, v.w};
#pragma unroll
    for (int e = 0; e < 4; ++e) { f[2 * e] = __builtin_bit_cast(float, vv[e] << 16); f[2 * e + 1] = __builtin_bit_cast(float, vv[e] & 0xffff0000u); }
}

#define DPPF(old, src, ctrl, rmask) __builtin_bit_cast(float, __builtin_amdgcn_update_dpp(__builtin_bit_cast(int, (float)(old)), __builtin_bit_cast(int, (float)(src)), (ctrl), (rmask), 0xF, false))
__device__ __forceinline__ float wave_prefix_sum(float v) {
    v += DPPF(0.f, v, 0x111, 0xF); v += DPPF(0.f, v, 0x112, 0xF); v += DPPF(0.f, v, 0x114, 0xF); v += DPPF(0.f, v, 0x118, 0xF);
    v += DPPF(0.f, v, 0x142, 0xA); v += DPPF(0.f, v, 0x143, 0xC);
    return v;
}
__device__ __forceinline__ float wave_prefix_max(float v) {
    v = fmaxf(v, DPPF(-INFINITY, v, 0x111, 0xF)); v = fmaxf(v, DPPF(-INFINITY, v, 0x112, 0xF)); v = fmaxf(v, DPPF(-INFINITY, v, 0x114, 0xF)); v = fmaxf(v, DPPF(-INFINITY, v, 0x118, 0xF));
    v = fmaxf(v, DPPF(-INFINITY, v, 0x142, 0xA)); v = fmaxf(v, DPPF(-INFINITY, v, 0x143, 0xC));
    return v;
}
__device__ __forceinline__ float lane_bcast(float v, int l) { return __builtin_bit_cast(float, __builtin_amdgcn_readlane(__builtin_bit_cast(int, v), l)); }

struct ALds {
    LAS bf16_t *Qt, *Kt, *KhT, *Vt, *Pm, *St; LAS float *seg, *Dl, *Er, *stats;
};
__device__ __forceinline__ ALds a_lds(LAS unsigned char* lds) {
    ALds L; L.Qt = (LAS bf16_t*)lds; L.Kt = L.Qt + 64 * 136; L.KhT = L.Kt + 64 * 136; L.Vt = L.KhT + 128 * 72; L.Pm = L.Vt + 128 * 72;
    L.St = L.Pm + 64 * 72; L.seg = (LAS float*)(L.St + 128 * 136); L.Dl = L.seg + 512; L.Er = L.Dl + 128; L.stats = L.Er + 128; return L;
}
struct ARaw { unsigned z[16], v[16], q[16]; float lbv; };
template <int MODE>
__device__ __forceinline__ void a_ld(ARaw& R, const MP& p, size_t tbase, int h, int dir) {
    const int tid = otid(), d = tid & 127, sg = tid >> 7;
    R.lbv = p.lb[h * 128 + d];
    unsigned off = (unsigned)((tbase + sg * 16) * NU + h * 128 + d) * 2u;
    const char* bz = (const char*)(p.u + (dir ? UA_FB : UA_FF)); const char* bvv = (const char*)(p.u + UA_I); const char* bq = (const char*)(p.u + UA_Q);
#pragma unroll
    for (int k = 0; k < 16; ++k) {
        asm volatile("" : "+v"(off));
        R.z[k] = *(const unsigned short*)(bz + off);
        R.v[k] = *(const unsigned short*)(bvv + off);
        if (MODE == 1) R.q[k] = *(const unsigned short*)(bq + off);
        off += NU * 2; }
}
template <int MODE>
__device__ __forceinline__ void a_c1(const ARaw& R, const ALds& L, int dir, float (&g)[16], float (&kk)[16], unsigned (&qp)[8], unsigned (&vp)[8]) {
    const int tid = otid(), d = tid & 127, sg = tid >> 7;
    const float lbv = R.lbv;
    unsigned zp[8];
#pragma unroll
    for (int k = 0; k < 16; ++k) {
        if (k & 1) zp[k >> 1] |= R.z[k] << 16; else zp[k >> 1] = R.z[k];
        if (k & 1) vp[k >> 1] |= R.v[k] << 16; else vp[k >> 1] = R.v[k];
        if (MODE == 1) { if (k & 1) qp[k >> 1] |= R.q[k] << 16; else qp[k >> 1] = R.q[k]; } }
#pragma unroll
    for (int k = 0; k < 16; ++k) {
        const float z = bf2f((unsigned short)((k & 1) ? (zp[k >> 1] >> 16) : (zp[k >> 1] & 0xffffu)));
        const float f = lbv + (1.f - lbv) * sigm(z);
        g[k] = f; kk[k] = 1.f - f; }
    float segv;
    if (MODE == 1) {
        if (dir == 0) {
#pragma unroll
            for (int k = 1; k < 16; ++k) g[k] *= g[k - 1];
            segv = g[15];
        } else {
#pragma unroll
            for (int k = 14; k >= 0; --k) g[k] *= g[k + 1];
            segv = g[0];
        }
    } else {
        float x = 1.f;
        if (dir == 0) {
#pragma unroll
            for (int k = 15; k >= 0; --k) { const float fk = g[k]; g[k] = x; x *= fk; }
        } else {
#pragma unroll
            for (int k = 0; k < 16; ++k) { const float fk = g[k]; g[k] = x; x *= fk; }
        }
        segv = x;
    }
    L.seg[sg * 128 + d] = segv;
}
template <int MODE>
__device__ __forceinline__ float a_c2(const ALds& L, int dir, float carry, const float (&g)[16], const float (&kk)[16], const unsigned (&qp)[8], const unsigned (&vp)[8]) {
    const int tid = otid(), d = tid & 127, sg = tid >> 7;
    const float s0 = L.seg[d], s1 = L.seg[128 + d], s2 = L.seg[256 + d], s3 = L.seg[384 + d];
    const float tot = (s0 * s1) * (s2 * s3);
    const float plo = (sg > 0 ? s0 : 1.f) * (sg > 1 ? s1 : 1.f) * (sg > 2 ? s2 : 1.f);
    const float phi = (sg < 3 ? s3 : 1.f) * (sg < 2 ? s2 : 1.f) * (sg < 1 ? s1 : 1.f);
    const float ref = dir == 0 ? (s0 * s1) : (s2 * s3);
    const float rr = (MODE == 1) ? __builtin_amdgcn_rcpf(ref) : 0.f;
    const float c1 = (MODE == 1) ? (dir == 0 ? plo : phi) * rr : (dir == 0 ? phi : plo) * carry;
    const float c2 = tot * rr;
    unsigned khp[8];
#pragma unroll
    for (int k = 0; k < 16; k += 2) {
        float khv[2];
#pragma unroll
        for (int e = 0; e < 2; ++e) { const int kx = k + e;
            const int pp = sg * 16 + kx;
            if (MODE == 1) {
                const float e1 = g[kx] * c1, r1 = __builtin_amdgcn_rcpf(e1);
                const float qv = bf2f((unsigned short)(e ? (qp[k >> 1] >> 16) : (qp[k >> 1] & 0xffffu)));
                const float kt = kk[kx] * r1;
                L.Qt[pp * 136 + d] = f2bf(qv * e1);
                L.Kt[pp * 136 + d] = f2bf(kt);
                khv[e] = kt * c2;
            } else khv[e] = kk[kx] * (g[kx] * c1);
        }
        khp[k >> 1] = pk2(khv[0], khv[1]); }
    *(LAS u32x4*)(L.KhT + d * 72 + sg * 16) = (u32x4){khp[0], khp[1], khp[2], khp[3]};
    *(LAS u32x4*)(L.KhT + d * 72 + sg * 16 + 8) = (u32x4){khp[4], khp[5], khp[6], khp[7]};
    if (MODE == 1 && sg == 0) { L.Dl[d] = tot; L.Er[d] = ref; }
    *(LAS u32x4*)(L.Vt + d * 72 + sg * 16) = (u32x4){vp[0], vp[1], vp[2], vp[3]};
    *(LAS u32x4*)(L.Vt + d * 72 + sg * 16 + 8) = (u32x4){vp[4], vp[5], vp[6], vp[7]};
    return tot;
}

template <int MODE>
__device__ __forceinline__ float a_cmp(const ARaw& R, const ALds& L, int dir, float carry) {
    float g[16], kk[16]; unsigned qp[8], vp[8];
    a_c1<MODE>(R, L, dir, g, kk, qp, vp);
    __syncthreads();
    return a_c2<MODE>(L, dir, carry, g, kk, qp, vp);
}
template <int MODE>
__device__ __forceinline__ float a_gates(const MP& p, const ALds& L, size_t tbase, int h, int dir, float carry) {
    ARaw R; a_ld<MODE>(R, p, tbase, h, dir); return a_cmp<MODE>(R, L, dir, carry);
}

__device__ __forceinline__ void a_pass1(const MP& p, LAS unsigned char* lds, int item, ARaw& R, bool have, int next) {
    const int tid = otid(), lane = tid & 63, w = __builtin_amdgcn_readfirstlane(tid >> 6);
    const int dir = item & 1, sc = (item >> 1) & 15, h = (item >> 5) & 3, b = item >> 7;
    const ALds L = a_lds(lds);
    const int q4 = lane >> 4, c16 = lane & 15;
    f32x4 S[8];
#pragma unroll
    for (int j = 0; j < 8; ++j) S[j] = (f32x4){0.f, 0.f, 0.f, 0.f};
    float carry = 1.f;
    const size_t tb0 = (size_t)b * SEQ + sc * 256;
    if (!have) a_ld<0>(R, p, tb0 + (dir ? 0 : 3) * 64, h, dir);
    float g[16], kk[16]; unsigned qp[8], vp[8];
    a_c1<0>(R, L, dir, g, kk, qp, vp);
#pragma unroll 1
    for (int ci = 0; ci < 3; ++ci) {
        __syncthreads();
        a_ld<0>(R, p, tb0 + (dir ? ci + 1 : 2 - ci) * 64, h, dir);
        const float tot = a_c2<0>(L, dir, carry, g, kk, qp, vp);
        carry *= tot;
        __syncthreads();
        {
            bf16x8 bv[2]; ld_frags<64>(bv, L.Vt, 72, w * 16, lane);
#pragma unroll
            for (int j = 0; j < 8; ++j) mma_fb<64>(S[j], L.KhT, 72, j * 16, bv, lane);
            a_c1<0>(R, L, dir, g, kk, qp, vp);
#pragma unroll
            for (int i = 0; i < 16; ++i) {
                __builtin_amdgcn_sched_group_barrier(0x100, 1, 0);
                __builtin_amdgcn_sched_group_barrier(0x008, 1, 0);
                __builtin_amdgcn_sched_group_barrier(0x002, 8, 0);
                __builtin_amdgcn_sched_group_barrier(0x400, 2, 0);
            }
        }
    }
    {   __syncthreads();
        const float tot = a_c2<0>(L, dir, carry, g, kk, qp, vp);
        carry *= tot;
        __syncthreads();
        bf16x8 bv[2]; ld_frags<64>(bv, L.Vt, 72, w * 16, lane);
#pragma unroll
        for (int j = 0; j < 8; ++j) mma_fb<64>(S[j], L.KhT, 72, j * 16, bv, lane);
    }
    __syncthreads();
    if (next >= 0) { const int nd = next & 1, nsc = (next >> 1) & 15, nh = (next >> 5) & 3, nb_ = next >> 7;
        a_ld<0>(R, p, (size_t)nb_ * SEQ + nsc * 256 + (nd ? 0 : 3) * 64, nh, nd); }
    __builtin_amdgcn_sched_barrier(0);
    const size_t sidx = ((size_t)(dir * p.nb * 4 + b * 4 + h) * NSC + sc);
    bf16_t* dst = p.SA + sidx * SA_ELEMS;
#pragma unroll
    for (int j = 0; j < 8; ++j) {
        *(u32x2*)(dst + (size_t)(w * 16 + c16) * 128 + j * 16 + 4 * q4) = (u32x2){pk2(S[j][0], S[j][1]), pk2(S[j][2], S[j][3])}; }
    if (tid < 128) p.DA[sidx * 128 + tid] = carry;
}

__device__ __forceinline__ void a_scan_unit(const MP& p, int unit, bool dry = false) {
    const int e4 = unit & 4095, seq = unit >> 12;
    const int dir = seq / (p.nb * 4);
    const int dk = (e4 * 4) & 127;
    u32x2 v[NSC]; f32x4 D[NSC];
#pragma unroll
    for (int i = 0; i < NSC; ++i) {
        const int sc = dir ? NSC - 1 - i : i;
        v[i] = *(const u32x2*)(p.SA + ((size_t)seq * NSC + sc) * SA_ELEMS + e4 * 4);
        D[i] = *(const f32x4*)(p.DA + ((size_t)seq * NSC + sc) * 128 + dk); }
    float S0 = 0.f, S1 = 0.f, S2 = 0.f, S3 = 0.f;
#pragma unroll
    for (int i = 0; i < NSC; ++i) {
        const int sc = dir ? NSC - 1 - i : i;
        if (!dry) *(u32x2*)(p.SA + ((size_t)seq * NSC + sc) * SA_ELEMS + e4 * 4) = (u32x2){pk2(S0, S1), pk2(S2, S3)};
        S0 = D[i][0] * S0 + bf2f(v[i].x & 0xffffu); S1 = D[i][1] * S1 + bf2f(v[i].x >> 16); S2 = D[i][2] * S2 + bf2f(v[i].y & 0xffffu); S3 = D[i][3] * S3 + bf2f(v[i].y >> 16);
    }
}

struct C3Pre;
__device__ __forceinline__ void c3_issue(C3Pre& P, const MP& p, int item);
__device__ __forceinline__ void a_pass3(const MP& p, LAS unsigned char* lds, int item, C3Pre& PC, int next_c, bool dry = false) {
    const int tid = otid(), lane = tid & 63, w = __builtin_amdgcn_readfirstlane(tid >> 6);
    const int sc = item & 15, h = (item >> 4) & 3, b = item >> 6;
    const ALds L = a_lds(lds);
    const int q4 = lane >> 4, c16 = lane & 15, mb2 = w >> 1, nh = w & 1;
    f32x4 O[4][4];
#pragma unroll
    for (int a = 0; a < 4; ++a)
#pragma unroll
        for (int m = 0; m < 4; ++m) O[a][m] = (f32x4){0.f, 0.f, 0.f, 0.f};
    ARaw RA; a_ld<1>(RA, p, (size_t)b * SEQ + sc * 256, h, 0);
#pragma unroll 1
    for (int dir = 0; dir < 2; ++dir) {
        const size_t sidx = ((size_t)(dir * p.nb * 4 + b * 4 + h) * NSC + sc);
        const bf16_t* sg = p.SA + sidx * SA_ELEMS;
        f32x4 S[8];
#pragma unroll
        for (int j = 0; j < 8; ++j) { const u32x2 v = *(const u32x2*)(sg + (size_t)(w * 16 + c16) * 128 + j * 16 + 4 * q4);
            S[j] = (f32x4){bf2f(v.x & 0xffffu), bf2f(v.x >> 16), bf2f(v.y & 0xffffu), bf2f(v.y >> 16)}; }
#pragma unroll 1
        for (int ci = 0; ci < 4; ++ci) {
            const int cc = dir ? 3 - ci : ci;
            (void)a_cmp<1>(RA, L, dir, 0.f);
            __syncthreads();
            { bf16x8 aq[4]; ld_frags<128>(aq, L.Qt, 136, mb2 * 16, lane);
#pragma unroll
              for (int n = 0; n < 2; ++n) { f32x4 a = (f32x4){0.f, 0.f, 0.f, 0.f}; const int nb16 = nh * 2 + n;
                mma_fa<128>(a, aq, L.Kt, 136, nb16 * 16, lane);
                const int ps = nb16 * 16 + c16, pt0 = mb2 * 16 + 4 * q4;
#pragma unroll
                for (int i = 0; i < 4; ++i) { const int pt = pt0 + i; const bool keep = dir ? (ps >= pt) : (ps <= pt);
                    L.Pm[pt * 72 + ps] = f2bf(keep ? a[i] : 0.f); } } }
#pragma unroll
            for (int j = 0; j < 8; ++j) { const f32x4 E = *(const LAS f32x4*)(L.Er + j * 16 + 4 * q4);
                *(LAS u32x2*)(L.St + (w * 16 + c16) * 136 + j * 16 + 4 * q4) = (u32x2){pk2(S[j][0] * E[0], S[j][1] * E[1]), pk2(S[j][2] * E[2], S[j][3] * E[3])}; }
            __syncthreads();
            {
                int ndir = dir, nci = ci + 1; if (nci == 4) { nci = 0; ndir = dir + 1; }
                if (ndir < 2) a_ld<1>(RA, p, (size_t)b * SEQ + sc * 256 + (ndir ? 3 - nci : nci) * 64, h, ndir);
            }
            bf16x8 bv[2], bs[4];
            ld_frags<64>(bv, L.Vt, 72, w * 16, lane); ld_frags<128>(bs, L.St, 136, w * 16, lane);
            f32x4 T[4];
#pragma unroll
            for (int m = 0; m < 4; ++m) { T[m] = (f32x4){0.f, 0.f, 0.f, 0.f};
                mma_fb<64>(T[m], L.Pm, 72, m * 16, bv, lane);
                mma_fb<128>(T[m], L.Qt, 136, m * 16, bs, lane); }
            if (cc == 0) {
#pragma unroll
                for (int m = 0; m < 4; ++m) O[0][m] += T[m];
            } else if (cc == 1) {
#pragma unroll
                for (int m = 0; m < 4; ++m) O[1][m] += T[m];
            } else if (cc == 2) {
#pragma unroll
                for (int m = 0; m < 4; ++m) O[2][m] += T[m];
            } else {
#pragma unroll
                for (int m = 0; m < 4; ++m) O[3][m] += T[m];
            }
#pragma unroll
            for (int j = 0; j < 8; ++j) { const f32x4 D = *(const LAS f32x4*)(L.Dl + j * 16 + 4 * q4);
                S[j] = S[j] * D;
                mma_fb<64>(S[j], L.KhT, 72, j * 16, bv, lane); }
            __syncthreads();
        }
    }
    {
        const int t2 = otid(); const int ch = t2 & 15, r0 = t2 >> 4;
        LAS float* Ht = (LAS float*)lds;
        const size_t rowb = (size_t)b * SEQ + sc * 256;
        u32x4 zr[8];
#pragma unroll
        for (int it = 0; it < 8; ++it) zr[it] = *(const u32x4*)UP(p, (unsigned)(rowb + r0 + 32 * it) * NU + UA_Z + h * 128 + ch * 8);
        acc_to_lds(Ht, O, w, t2 & 63);
        __syncthreads();
        if (next_c >= 0) c3_issue(PC, p, next_c);
        const f32x4 g0 = *(const f32x4*)(p.hgrn_g + h * 128 + ch * 8), g1 = *(const f32x4*)(p.hgrn_g + h * 128 + ch * 8 + 4);
        const float gg[8] = {g0[0], g0[1], g0[2], g0[3], g1[0], g1[1], g1[2], g1[3]};
#pragma unroll
        for (int it = 0; it < 8; ++it) { const int r = r0 + 32 * it;
            const f32x4 h0 = *(const LAS f32x4*)(Ht + r * HT_LD + ch * 8), h1 = *(const LAS f32x4*)(Ht + r * HT_LD + ch * 8 + 4);
            const float hv[8] = {h0[0], h0[1], h0[2], h0[3], h1[0], h1[1], h1[2], h1[3]};
            float ss = 0.f;
#pragma unroll
            for (int e = 0; e < 8; ++e) ss = fmaf(hv[e], hv[e], ss);
            const float rs = frsqrt(dpp_sum16(ss) * (1.0f / 128.f) + EPS);
            float zf[8], y[8]; unpack8(zf, zr[it]);
#pragma unroll
            for (int e = 0; e < 8; ++e) y[e] = hv[e] * rs * gg[e] * silu(zf[e]);
            if (!dry) *(u32x4*)UP(p, (unsigned)(rowb + r) * NU + UA_Q + h * 128 + ch * 8) = (u32x4){pk2(y[0], y[1]), pk2(y[2], y[3]), pk2(y[4], y[5]), pk2(y[6], y[7])}; }
        __syncthreads();
    }
}

typedef short s16x4 __attribute__((ext_vector_type(4)));
__device__ __forceinline__ unsigned off_b(unsigned row, unsigned ch) { return 256u * row + 16u * (ch ^ (((row & 3u) << 2) | ((row >> 2) & 3u))); }
__device__ __forceinline__ bf16x8 tr_frag(const LAS unsigned char* img, int c, int ks, int lane) {
    const unsigned g = (unsigned)lane >> 4, q = ((unsigned)lane & 15u) >> 2, p = (unsigned)lane & 3u;
    const unsigned r0 = 32u * ks + 8u * g + q, chn = 2u * c + (p >> 1), sub = 8u * (p & 1u);
    const s16x4 lo = __builtin_amdgcn_ds_read_tr16_b64_v4i16((LAS s16x4*)(img + off_b(r0, chn) + sub));
    const s16x4 hi = __builtin_amdgcn_ds_read_tr16_b64_v4i16((LAS s16x4*)(img + off_b(r0 + 4u, chn) + sub));
    typedef short s16x8 __attribute__((ext_vector_type(8)));
    const s16x8 v = (s16x8){lo[0], lo[1], lo[2], lo[3], hi[0], hi[1], hi[2], hi[3]};
    return __builtin_bit_cast(bf16x8, v);
}
__device__ __forceinline__ bf16x8 ones_col0(int lane) { const unsigned o = (lane & 15) == 0 ? 0x3f803f80u : 0u; return __builtin_bit_cast(bf16x8, (u32x4){o, o, o, o}); }

struct CLds {
    LAS bf16_t *Qc, *Kc, *Pw, *St; LAS unsigned char *Kw, *Vr; LAS float *sc;
};
__device__ __forceinline__ CLds c_lds(LAS unsigned char* lds) {
    CLds L; L.Qc = (LAS bf16_t*)lds; L.Kc = L.Qc + 64 * 72; L.Kw = (LAS unsigned char*)(L.Kc + 64 * 72); L.Vr = L.Kw + 64 * 256; L.Pw = (LAS bf16_t*)(L.Vr + 64 * 256); L.St = L.Pw + 64 * 72;
    L.sc = (LAS float*)(L.St + 144 * 72); return L;
}
__device__ __forceinline__ float log_sigmoid(float x) { return fminf(x, 0.f) - log1pf(__expf(-fabsf(x))); }
__device__ __forceinline__ void c_ones_rows(const CLds&, int) {}
struct CRegs { u32x4 q, k, v0, v1; };
template <bool WANT_Q>
__device__ __forceinline__ void c_issue(CRegs& R, const MP& p, size_t row0  , int h, int tid) {
    const int r = tid & 63, ch = tid >> 6;
    const bf16_t* ur = UP(p, (unsigned)(row0 + r) * NU + h * 64 + ch * 8);
    if (WANT_Q) R.q = *(const u32x4*)(ur + UC_Q);
    R.k = *(const u32x4*)(ur + UC_K);
    const bf16_t* vr = UP(p, (unsigned)(row0 + r) * NU + UC_V + h * 128 + ch * 16);
    R.v0 = *(const u32x4*)vr; R.v1 = *(const u32x4*)(vr + 8);
}
template <bool WANT_Q>
__device__ __forceinline__ void c_store(const CRegs& R, const CLds& L, float wsr, int tid) {
    const int r = tid & 63, ch = tid >> 6;
    if (WANT_Q) { *(LAS u32x4*)(L.Qc + r * 72 + ch * 8) = R.q; *(LAS u32x4*)(L.Kc + r * 72 + ch * 8) = R.k; }
    *(LAS u32x4*)(L.Vr + off_b(r, 2 * ch)) = R.v0; *(LAS u32x4*)(L.Vr + off_b(r, 2 * ch + 1)) = R.v1;
    *(LAS u32x4*)(L.Kw + off_b(r, ch)) = (u32x4){pk2(wsr * bf2f(R.k.x & 0xffffu), wsr * bf2f(R.k.x >> 16)), pk2(wsr * bf2f(R.k.y & 0xffffu), wsr * bf2f(R.k.y >> 16)),
                                                 pk2(wsr * bf2f(R.k.z & 0xffffu), wsr * bf2f(R.k.z >> 16)), pk2(wsr * bf2f(R.k.w & 0xffffu), wsr * bf2f(R.k.w >> 16))};
}

struct C3Pre { CRegs R; float gi, gf; u32x2 sr[5]; float M, bi, bfb; };
template <bool WITH_SV>
__device__ __forceinline__ void c3_state_loads(u32x4 (&sv)[3], u32x2 (&sr)[5], float& M, float& bi, float& bfb, const MP& p, int sc, int h, int b, int dir) {
    const int t2 = otid(); const int lane = t2 & 63, w = __builtin_amdgcn_readfirstlane(t2 >> 6); const int q4 = lane >> 4, c16 = lane & 15;
    const size_t sidx = ((size_t)(dir * p.nb * 4 + b * 4 + h) * NSC + sc);
    const bf16_t* sg = p.SC + sidx * SC_ELEMS;
#pragma unroll
    for (int it = 0; it < 3; ++it) { const int c = t2 + it * 512; const int r = c >> 3, ch = c & 7; sv[it] = (u32x4){0u, 0u, 0u, 0u}; if (WITH_SV && c < 144 * 8) sv[it] = *(const u32x4*)(sg + r * 64 + ch * 8); }
#pragma unroll
    for (int j = 0; j < 4; ++j) sr[j] = *(const u32x2*)(sg + (size_t)(w * 16 + c16) * 64 + j * 16 + 4 * q4);
    sr[4] = (u32x2){0u, 0u};
    if (w < 4) sr[4] = *(const u32x2*)(sg + (size_t)(128 + c16) * 64 + w * 16 + 4 * q4);
    M = p.CS[sidx * 4 + 2];
    bi = p.gate_b[dir * 4 + h]; bfb = p.gate_b[8 + dir * 4 + h];
}
__device__ __forceinline__ void c3_issue(C3Pre& P, const MP& p, int item) {
    const int tid = otid(), lane = tid & 63;
    const int sc = item & 15, h = (item >> 4) & 3, b = item >> 6;
    const size_t brow = (size_t)b * SEQ; const int tls = sc * 256;
    c_issue<true>(P.R, p, brow + tls, h, tid);
    { const float* gr = p.gates + (brow + tls + lane) * 16; P.gi = gr[h]; P.gf = gr[8 + h]; }
    { u32x4 svd[3]; c3_state_loads<false>(svd, P.sr, P.M, P.bi, P.bfb, p, sc, h, b, 0); }
}
struct C1Pre { CRegs R; float li[4], lf[4]; };
__device__ __forceinline__ void c1_issue(C1Pre& P, const MP& p, int item) {
    const int tid = otid(), lane = tid & 63, w = __builtin_amdgcn_readfirstlane(tid >> 6);
    const int dir = item & 1, sc = (item >> 1) & 15, h = (item >> 5) & 3, b = item >> 7;
    const size_t brow = (size_t)b * SEQ; const int tls = sc * 256;
    c_issue<false>(P.R, p, brow + tls, h, tid);
#pragma unroll
    for (int k = 0; k < 4; ++k) { P.li[k] = 0.f; P.lf[k] = 0.f; }
    if (w == 0) {
#pragma unroll
        for (int k = 0; k < 4; ++k) { const float* gr = p.gates + (brow + tls + lane * 4 + k) * 16; P.li[k] = gr[dir * 4 + h]; P.lf[k] = gr[8 + dir * 4 + h]; } }
}
__device__ __forceinline__ void c_pass1(const MP& p, LAS unsigned char* lds, int item, C1Pre& P, bool have, int next) {
    const int tid = otid(), lane = tid & 63, w = __builtin_amdgcn_readfirstlane(tid >> 6);
    const int dir = item & 1, sc = (item >> 1) & 15, h = (item >> 5) & 3, b = item >> 7;
    const CLds L = c_lds(lds);
    const int q4 = lane >> 4, c16 = lane & 15;
    const size_t brow = (size_t)b * SEQ; const int tls = sc * 256;
    if (!have) c1_issue(P, p, item);
    CRegs R = P.R;
    c_ones_rows(L, tid);
    if (w == 0) {
        const float bi = p.gate_b[dir * 4 + h], bf = p.gate_b[8 + dir * 4 + h];
        float lf[4], li[4];
#pragma unroll
        for (int k = 0; k < 4; ++k) { li[k] = P.li[k] + bi; lf[k] = log_sigmoid(P.lf[k] + bf); }
        const float tot4 = (lf[0] + lf[1]) + (lf[2] + lf[3]);
        const float psum = wave_prefix_sum(tot4), Btot = lane_bcast(psum, 63);
        const float incl = dir ? psum : (Btot - psum + tot4);
        const float after_lane = incl - tot4;
        float E[4];
        if (dir == 0) { E[3] = after_lane; E[2] = E[3] + lf[3]; E[1] = E[2] + lf[2]; E[0] = E[1] + lf[1]; }
        else { E[0] = after_lane; E[1] = E[0] + lf[0]; E[2] = E[1] + lf[1]; E[3] = E[2] + lf[2]; }
        float a[4], amax = -INFINITY;
#pragma unroll
        for (int k = 0; k < 4; ++k) { a[k] = E[k] + li[k]; amax = fmaxf(amax, a[k]); }
        amax = lane_bcast(wave_prefix_max(amax), 63);
#pragma unroll
        for (int k = 0; k < 4; ++k) L.sc[192 + lane * 4 + k] = __expf(a[k] - amax);
        if (lane == 0) { L.sc[576 + 2] = amax; L.sc[576 + 3] = Btot; }
    }
    __syncthreads();
    f32x4 S[5];
#pragma unroll
    for (int j = 0; j < 5; ++j) S[j] = (f32x4){0.f, 0.f, 0.f, 0.f};
#pragma unroll 1
    for (int cc = 0; cc < 4; ++cc) {
        c_store<false>(R, L, L.sc[192 + cc * 64 + (tid & 63)], tid);
        if (cc < 3) c_issue<false>(R, p, brow + tls + (cc + 1) * 64, h, tid);
        __syncthreads();
        { const bf16x8 bv0 = tr_frag(L.Vr, w, 0, lane), bv1 = tr_frag(L.Vr, w, 1, lane);
#pragma unroll
          for (int j = 0; j < 4; ++j) { S[j] = __builtin_amdgcn_mfma_f32_16x16x32_bf16(tr_frag(L.Kw, j, 0, lane), bv0, S[j], 0, 0, 0); S[j] = __builtin_amdgcn_mfma_f32_16x16x32_bf16(tr_frag(L.Kw, j, 1, lane), bv1, S[j], 0, 0, 0); } }
        if (w < 4) { const bf16x8 on = ones_col0(lane);
            S[4] = __builtin_amdgcn_mfma_f32_16x16x32_bf16(tr_frag(L.Kw, w, 0, lane), on, S[4], 0, 0, 0); S[4] = __builtin_amdgcn_mfma_f32_16x16x32_bf16(tr_frag(L.Kw, w, 1, lane), on, S[4], 0, 0, 0); }
        __syncthreads();
    }
    if (next >= 0) c1_issue(P, p, next);
    __builtin_amdgcn_sched_barrier(0);
    const size_t sidx = ((size_t)(dir * p.nb * 4 + b * 4 + h) * NSC + sc);
    bf16_t* dst = p.SC + sidx * SC_ELEMS;
#pragma unroll
    for (int j = 0; j < 4; ++j) *(u32x2*)(dst + (size_t)(w * 16 + c16) * 64 + j * 16 + 4 * q4) = (u32x2){pk2(S[j][0], S[j][1]), pk2(S[j][2], S[j][3])};
    if (w < 4) *(u32x2*)(dst + (size_t)(128 + c16) * 64 + w * 16 + 4 * q4) = (u32x2){pk2(S[4][0], S[4][1]), pk2(S[4][2], S[4][3])};
    if (tid == 0) { p.CS[sidx * 4 + 0] = L.sc[576 + 2]; p.CS[sidx * 4 + 1] = L.sc[576 + 3]; }
    __syncthreads();
}

struct CScan { u32x2 v[NSC]; float A[NSC], B[NSC]; };
__device__ __forceinline__ void c_scan_load(CScan& X, const MP& p, int unit) {
    const int e4 = unit % 2304, seq = unit / 2304;
    const int dir = seq / (p.nb * 4);
#pragma unroll
    for (int i = 0; i < NSC; ++i) {
        const int sc = dir ? NSC - 1 - i : i; const size_t sidx = (size_t)seq * NSC + sc;
        X.v[i] = *(const u32x2*)(p.SC + sidx * SC_ELEMS + e4 * 4); X.A[i] = p.CS[sidx * 4 + 0]; X.B[i] = p.CS[sidx * 4 + 1]; }
}
__device__ __forceinline__ void c_scan_run(const CScan& X, const MP& p, int unit, bool dry = false) {
    const int e4 = unit % 2304, seq = unit / 2304;
    const int dir = seq / (p.nb * 4);
    float S0 = 0.f, S1 = 0.f, S2 = 0.f, S3 = 0.f, M = 0.f;
#pragma unroll
    for (int i = 0; i < NSC; ++i) {
        const int sc = dir ? NSC - 1 - i : i; const size_t sidx = (size_t)seq * NSC + sc;
        if (!dry) *(u32x2*)(p.SC + sidx * SC_ELEMS + e4 * 4) = (u32x2){pk2(S0, S1), pk2(S2, S3)};
        if (e4 == 0 && !dry) p.CS[sidx * 4 + 2] = M;
        const float Mn = fmaxf(X.B[i] + M, X.A[i]);
        const float dc = __expf(X.B[i] + M - Mn), wn = __expf(X.A[i] - Mn);
        S0 = dc * S0 + wn * bf2f(X.v[i].x & 0xffffu); S1 = dc * S1 + wn * bf2f(X.v[i].x >> 16); S2 = dc * S2 + wn * bf2f(X.v[i].y & 0xffffu); S3 = dc * S3 + wn * bf2f(X.v[i].y >> 16);
        M = Mn;
    }
}
__device__ __forceinline__ void c_scan_unit(const MP& p, int unit, bool dry = false) { CScan X; c_scan_load(X, p, unit); c_scan_run(X, p, unit, dry); }

__device__ __forceinline__ void c_pass3(const MP& p, LAS unsigned char* lds, int item, C3Pre& P, bool have, bool dry = false) {
    const int tid = otid(), lane = tid & 63, w = __builtin_amdgcn_readfirstlane(tid >> 6);
    const int sc = item & 15, h = (item >> 4) & 3, b = item >> 6;
    const CLds L = c_lds(lds);
    const int q4 = lane >> 4, c16 = lane & 15, mb2 = w >> 1, nh = w & 1;
    const size_t brow = (size_t)b * SEQ; const int tls = sc * 256;
    f32x4 H[4][4];
#pragma unroll
    for (int a = 0; a < 4; ++a)
#pragma unroll
        for (int m = 0; m < 4; ++m) H[a][m] = (f32x4){0.f, 0.f, 0.f, 0.f};
    if (!have) c3_issue(P, p, item);
    CRegs R = P.R; float gi_raw = P.gi, gf_raw = P.gf;
    u32x4 sv[3]; u32x2 sr[5]; float M = P.M, bi = P.bi, bfb = P.bfb;
#pragma unroll
    for (int j = 0; j < 5; ++j) sr[j] = P.sr[j];
    c_ones_rows(L, tid);
#pragma unroll 1
    for (int dir = 0; dir < 2; ++dir) {
        const size_t sidx = ((size_t)(dir * p.nb * 4 + b * 4 + h) * NSC + sc);
        const bf16_t* sg = p.SC + sidx * SC_ELEMS;
        const int t2 = otid();
        if (dir == 1) c3_state_loads<false>(sv, sr, M, bi, bfb, p, sc, h, b, 1);
        __builtin_amdgcn_sched_barrier(0);
#pragma unroll
        for (int j = 0; j < 4; ++j) *(LAS u32x2*)(L.St + (w * 16 + c16) * 72 + j * 16 + 4 * q4) = sr[j];
        if (w < 4) *(LAS u32x2*)(L.St + (128 + c16) * 72 + w * 16 + 4 * q4) = sr[4];
        (void)t2;
        f32x4 S[5];
#pragma unroll
        for (int j = 0; j < 5; ++j) S[j] = (f32x4){bf2f(sr[j].x & 0xffffu), bf2f(sr[j].x >> 16), bf2f(sr[j].y & 0xffffu), bf2f(sr[j].y >> 16)};
#pragma unroll 1
        for (int ci = 0; ci < 4; ++ci) {
            const int cc = dir ? 3 - ci : ci;
            const float li = gi_raw + bi, lf = log_sigmoid(gf_raw + bfb);
            const float psum = wave_prefix_sum(lf), blast = lane_bcast(psum, 63);
            const float bc = dir ? (blast - psum + lf) : psum;
            const float cb = li - bc;
            float pm;
            if (dir == 0) pm = wave_prefix_max(cb);
            else pm = __shfl(wave_prefix_max(__shfl(cb, 63 - lane)), 63 - lane);
            const float mt = fmaxf(bc + pm, bc + M);
            const float av = blast - bc + li;
            const float amax = lane_bcast(wave_prefix_max(av), 63);
            const float Mn = fmaxf(blast + M, amax);
            const float wsv = __expf(av - Mn), dcy = __expf(blast + M - Mn);
            if (w == 0) { L.sc[lane] = bc - mt; L.sc[64 + lane] = cb; L.sc[128 + lane] = __expf(bc + M - mt); L.sc[448 + lane] = mt; }
            M = Mn;
            c_store<true>(R, L, wsv, tid);
            {
                int ndir = dir, nci = ci + 1; if (nci == 4) { nci = 0; ndir = dir + 1; }
                if (ndir < 2) { const int ncc = ndir ? 3 - nci : nci; const size_t nrow = brow + tls + ncc * 64;
                    c_issue<true>(R, p, nrow, h, tid);
                    const float* gr = p.gates + (nrow + lane) * 16; gi_raw = gr[ndir * 4 + h]; gf_raw = gr[8 + ndir * 4 + h]; }
            }
            __syncthreads();
            { bf16x8 aq[2]; ld_frags<64>(aq, L.Qc, 72, mb2 * 16, lane);
#pragma unroll
              for (int n = 0; n < 2; ++n) { f32x4 a = (f32x4){0.f, 0.f, 0.f, 0.f}; const int nb16 = nh * 2 + n;
                mma_fa<64>(a, aq, L.Kc, 72, nb16 * 16, lane);
                const int ps = nb16 * 16 + c16, pt0 = mb2 * 16 + 4 * q4; const float cbs = L.sc[64 + ps];
#pragma unroll
                for (int i = 0; i < 4; ++i) { const int pt = pt0 + i; const bool keep = dir ? (ps >= pt) : (ps <= pt);
                    const float wv = keep ? a[i] * __expf(L.sc[pt] + cbs) : 0.f;
                    L.Pw[pt * 72 + ps] = f2bf(wv); } } }
            __syncthreads();
            if (w < 4) { f32x4 n2 = (f32x4){0.f, 0.f, 0.f, 0.f};
                mma_nt<64>(n2, L.Qc, 72, w * 16, L.St, 72, 128, lane);
                const f32x4 g = *(const LAS f32x4*)(L.sc + 128 + w * 16 + 4 * q4);
                n2 = n2 * g;
                { bf16x8 ap[2]; ld_frags<64>(ap, L.Pw, 72, w * 16, lane); const bf16x8 on = ones_col0(lane);
                  n2 = __builtin_amdgcn_mfma_f32_16x16x32_bf16(ap[0], on, n2, 0, 0, 0); n2 = __builtin_amdgcn_mfma_f32_16x16x32_bf16(ap[1], on, n2, 0, 0, 0); }
                if (c16 == 0) *(LAS f32x4*)(L.sc + 512 + w * 16 + 4 * q4) = n2; }
            __syncthreads();
            bf16x8 bv[2], bs[2];
            bv[0] = tr_frag(L.Vr, w, 0, lane); bv[1] = tr_frag(L.Vr, w, 1, lane); ld_frags<64>(bs, L.St, 72, w * 16, lane);
#pragma unroll
            for (int m = 0; m < 4; ++m) { f32x4 T = (f32x4){0.f, 0.f, 0.f, 0.f};
                mma_fb<64>(T, L.Qc, 72, m * 16, bs, lane);
                const f32x4 g = *(const LAS f32x4*)(L.sc + 128 + m * 16 + 4 * q4);
                T = T * g; mma_fb<64>(T, L.Pw, 72, m * 16, bv, lane);
                const f32x4 dn = *(const LAS f32x4*)(L.sc + 512 + m * 16 + 4 * q4), mr = *(const LAS f32x4*)(L.sc + 448 + m * 16 + 4 * q4);
#pragma unroll
                for (int i = 0; i < 4; ++i) T[i] *= __builtin_amdgcn_rcpf(fmaxf(fabsf(dn[i]), __expf(-mr[i])));
                if (cc == 0) H[0][m] += T; else if (cc == 1) H[1][m] += T; else if (cc == 2) H[2][m] += T; else H[3][m] += T; }
#pragma unroll
            for (int j = 0; j < 4; ++j) { S[j] = S[j] * dcy; S[j] = __builtin_amdgcn_mfma_f32_16x16x32_bf16(tr_frag(L.Kw, j, 0, lane), bv[0], S[j], 0, 0, 0); S[j] = __builtin_amdgcn_mfma_f32_16x16x32_bf16(tr_frag(L.Kw, j, 1, lane), bv[1], S[j], 0, 0, 0);
                *(LAS u32x2*)(L.St + (w * 16 + c16) * 72 + j * 16 + 4 * q4) = (u32x2){pk2(S[j][0], S[j][1]), pk2(S[j][2], S[j][3])}; }
            if (w < 4) { S[4] = S[4] * dcy; { const bf16x8 on = ones_col0(lane); S[4] = __builtin_amdgcn_mfma_f32_16x16x32_bf16(tr_frag(L.Kw, w, 0, lane), on, S[4], 0, 0, 0); S[4] = __builtin_amdgcn_mfma_f32_16x16x32_bf16(tr_frag(L.Kw, w, 1, lane), on, S[4], 0, 0, 0); }
                *(LAS u32x2*)(L.St + (128 + c16) * 72 + w * 16 + 4 * q4) = (u32x2){pk2(S[4][0], S[4][1]), pk2(S[4][2], S[4][3])}; }
            __syncthreads();
        }
    }
    {
        const int t2 = otid(); const int ch = t2 & 15, r0 = t2 >> 4;
        LAS float* Ht = (LAS float*)lds;
        const size_t rowb = brow + tls;
        u32x4 og[8], zr[8];
#pragma unroll
        for (int it = 0; it < 8; ++it) og[it] = *(const u32x4*)UP(p, (unsigned)(rowb + r0 + 32 * it) * NU + UC_O + h * 128 + ch * 8);
#pragma unroll
        for (int it = 0; it < 8; ++it) zr[it] = *(const u32x4*)UP(p, (unsigned)(rowb + r0 + 32 * it) * NU + UC_Z + h * 128 + ch * 8);
        acc_to_lds(Ht, H, w, t2 & 63);
        __syncthreads();
        const f32x4 g0 = *(const f32x4*)(p.mlstm_g + h * 128 + ch * 8), g1 = *(const f32x4*)(p.mlstm_g + h * 128 + ch * 8 + 4);
        const float gg[8] = {g0[0], g0[1], g0[2], g0[3], g1[0], g1[1], g1[2], g1[3]};
#pragma unroll
        for (int it = 0; it < 8; ++it) { const int r = r0 + 32 * it;
            const f32x4 h0 = *(const LAS f32x4*)(Ht + r * HT_LD + ch * 8), h1 = *(const LAS f32x4*)(Ht + r * HT_LD + ch * 8 + 4);
            float v[8] = {h0[0], h0[1], h0[2], h0[3], h1[0], h1[1], h1[2], h1[3]};
            float of[8], zf[8], y[8]; unpack8(of, og[it]); unpack8(zf, zr[it]);
            float sm = 0.f;
#pragma unroll
            for (int e = 0; e < 8; ++e) { v[e] *= sigm(of[e]); sm += v[e]; }
            const float mu = dpp_sum16(sm) * (1.0f / 128.f);
            float sq = 0.f;
#pragma unroll
            for (int e = 0; e < 8; ++e) { v[e] -= mu; sq = fmaf(v[e], v[e], sq); }
            const float rs = frsqrt(dpp_sum16(sq) * (1.0f / 128.f) + EPS);
#pragma unroll
            for (int e = 0; e < 8; ++e) y[e] = v[e] * rs * gg[e] * silu(zf[e]);
            if (!dry) *(u32x4*)UP(p, (unsigned)(rowb + r) * NU + UC_V + h * 128 + ch * 8) = (u32x4){pk2(y[0], y[1]), pk2(y[2], y[3]), pk2(y[4], y[5]), pk2(y[6], y[7])}; }
        __syncthreads();
    }
}

__device__ __forceinline__ void pre_load(const MP& p, LAS unsigned char* lds, int blk) {
    const int tid = otid();
    LAS bf16_t* raw = (LAS bf16_t*)lds;
    const int tl0 = (blk * 64) & (SEQ - 1); const size_t brow = (size_t)(blk * 64 - tl0);
    u32x4 rv[9], vv[2];
#pragma unroll
    for (int it = 0; it < 9; ++it) { const int c = tid + it * 512; const int r = c >> 6, ch = c & 63; const int tl = tl0 - 2 + r;
        rv[it] = (u32x4){0u, 0u, 0u, 0u};
        const bf16_t* src = UP(p, (unsigned)(brow + tl) * NU + UC_Q + ch * 8);
        if (r < 2) src = p.halo + ((size_t)(blk - 1) * 4 + 2 + r) * 512 + ch * 8;
        if (r >= 66) src = p.halo + ((size_t)(blk + 1) * 4 + (r - 66)) * 512 + ch * 8;
        if (c < 68 * 64 && tl >= 0 && tl < SEQ) rv[it] = *(const u32x4*)src; }
#pragma unroll
    for (int it = 0; it < 2; ++it) { const int c = tid + it * 512; const int kvh = c >> 9, t = (c >> 3) & 63, ch = c & 7;
        vv[it] = *(const u32x4*)UP(p, (unsigned)(blk * 64 + t) * NU + UB_V + kvh * 64 + ch * 8); }
    __builtin_amdgcn_sched_barrier(0);
#pragma unroll
    for (int it = 0; it < 9; ++it) { const int c = tid + it * 512; if (c >= 68 * 64) break; const int r = c >> 6, ch = c & 63;
        *(LAS u32x4*)(raw + r * 520 + ch * 8) = rv[it]; }
    LAS bf16_t* vt = raw + 68 * 520;
#pragma unroll
    for (int it = 0; it < 2; ++it) { const int c = tid + it * 512; const int kvh = c >> 9, t = (c >> 3) & 63, ch = c & 7;
        *(LAS u32x4*)(vt + (kvh * 64 + t) * 72 + ch * 8) = vv[it]; }
}
__device__ __forceinline__ void pre_write(const MP& p, LAS unsigned char* lds, int blk) {
    const int tid = otid();
    LAS bf16_t* raw = (LAS bf16_t*)lds;
    const size_t row0 = (size_t)blk * 64;
    u32x4 ra[2], rb[2]; f32x4 rc0[2], rc1[2], rs0[2], rs1[2];
#pragma unroll
    for (int it = 0; it < 2; ++it) { const int c = tid + it * 512; const int cc = c < 640 ? c : 639; const int r = cc / 10, hh = cc % 10;
        const bf16_t* ptr = UP(p, (unsigned)(row0 + r) * NU + (hh < 8 ? UB_Q + hh * 64 : UB_K + (hh - 8) * 64));
        ra[it] = *(const u32x4*)ptr; rb[it] = *(const u32x4*)(ptr + 8);
        rc0[it] = *(const f32x4*)(p.cs + (row0 + r) * 8); rc1[it] = *(const f32x4*)(p.cs + (row0 + r) * 8 + 4); rs0[it] = *(const f32x4*)(p.sn + (row0 + r) * 8); rs1[it] = *(const f32x4*)(p.sn + (row0 + r) * 8 + 4); }
    __builtin_amdgcn_sched_barrier(0);
    __syncthreads();
    {
        const int ch = tid & 63;
        f32x4 w0[5], w1[5];
#pragma unroll
        for (int j = 0; j < 5; ++j) { w0[j] = *(const f32x4*)(p.conv_w + j * 512 + ch * 8); w1[j] = *(const f32x4*)(p.conv_w + j * 512 + ch * 8 + 4); }
        const float sc = (ch < 32) ? 0.125f : 1.0f;
        const int r0 = (tid >> 6) * 8;
        float win[5][8];
#pragma unroll
        for (int j = 0; j < 4; ++j) { const u32x4 x = *(const LAS u32x4*)(raw + (r0 + j) * 520 + ch * 8);
            win[j][0] = bf2f(x.x & 0xffffu); win[j][1] = bf2f(x.x >> 16); win[j][2] = bf2f(x.y & 0xffffu); win[j][3] = bf2f(x.y >> 16);
            win[j][4] = bf2f(x.z & 0xffffu); win[j][5] = bf2f(x.z >> 16); win[j][6] = bf2f(x.w & 0xffffu); win[j][7] = bf2f(x.w >> 16); }
#pragma unroll
        for (int it = 0; it < 8; ++it) { const int r = r0 + it;
            { const u32x4 x = *(const LAS u32x4*)(raw + (r + 4) * 520 + ch * 8); float (&wn)[8] = win[(it + 4) % 5];
              wn[0] = bf2f(x.x & 0xffffu); wn[1] = bf2f(x.x >> 16); wn[2] = bf2f(x.y & 0xffffu); wn[3] = bf2f(x.y >> 16);
              wn[4] = bf2f(x.z & 0xffffu); wn[5] = bf2f(x.z >> 16); wn[6] = bf2f(x.w & 0xffffu); wn[7] = bf2f(x.w >> 16); }
            float acc[8];
#pragma unroll
            for (int e = 0; e < 8; ++e) acc[e] = 0.f;
#pragma unroll
            for (int j = 0; j < 5; ++j) { const float (&xr)[8] = win[(it + j) % 5];
                acc[0] = fmaf(xr[0], w0[j][0], acc[0]); acc[1] = fmaf(xr[1], w0[j][1], acc[1]); acc[2] = fmaf(xr[2], w0[j][2], acc[2]); acc[3] = fmaf(xr[3], w0[j][3], acc[3]);
                acc[4] = fmaf(xr[4], w1[j][0], acc[4]); acc[5] = fmaf(xr[5], w1[j][1], acc[5]); acc[6] = fmaf(xr[6], w1[j][2], acc[6]); acc[7] = fmaf(xr[7], w1[j][3], acc[7]); }
#pragma unroll
            for (int e = 0; e < 8; ++e) acc[e] = silu(acc[e]) * sc;
            *(u32x4*)UP(p, (unsigned)(row0 + r) * NU + UC_Q + ch * 8) = (u32x4){pk2(acc[0], acc[1]), pk2(acc[2], acc[3]), pk2(acc[4], acc[5]), pk2(acc[6], acc[7])}; }
    }
    { LAS bf16_t* vt = raw + 68 * 520;
#pragma unroll 1
      for (int it = 0; it < 2; ++it) { const int c = tid + it * 512; const int kvh = c >> 9, d = (c >> 3) & 63, ch = c & 7;
          const LAS bf16_t* src = vt + (kvh * 64 + ch * 8) * 72 + d;
          const u32x4 o = (u32x4){(unsigned)src[0] | ((unsigned)src[72] << 16), (unsigned)src[2 * 72] | ((unsigned)src[3 * 72] << 16), (unsigned)src[4 * 72] | ((unsigned)src[5 * 72] << 16), (unsigned)src[6 * 72] | ((unsigned)src[7 * 72] << 16)};
          *(u32x4*)UP(p, (unsigned)(row0 + d) * NU + UB_V + kvh * 64 + ch * 8) = o; } }
#pragma unroll
    for (int it = 0; it < 2; ++it) { const int c = tid + it * 512; if (c >= 64 * 10) break; const int r = c / 10, hh = c % 10;
        bf16_t* ptr = UP(p, (unsigned)(row0 + r) * NU + (hh < 8 ? UB_Q + hh * 64 : UB_K + (hh - 8) * 64));
        const u32x4 a = ra[it], bb = rb[it];
        const f32x4 c0 = rc0[it], c1 = rc1[it], s0 = rs0[it], s1 = rs1[it];
        const float cs[8] = {c0[0], c0[1], c0[2], c0[3], c1[0], c1[1], c1[2], c1[3]}, sn[8] = {s0[0], s0[1], s0[2], s0[3], s1[0], s1[1], s1[2], s1[3]};
        const float x1[8] = {bf2f(a.x & 0xffffu), bf2f(a.x >> 16), bf2f(a.y & 0xffffu), bf2f(a.y >> 16), bf2f(a.z & 0xffffu), bf2f(a.z >> 16), bf2f(a.w & 0xffffu), bf2f(a.w >> 16)};
        const float x2[8] = {bf2f(bb.x & 0xffffu), bf2f(bb.x >> 16), bf2f(bb.y & 0xffffu), bf2f(bb.y >> 16), bf2f(bb.z & 0xffffu), bf2f(bb.z >> 16), bf2f(bb.w & 0xffffu), bf2f(bb.w >> 16)};
        float r1[8], r2[8];
#pragma unroll
        for (int e = 0; e < 8; ++e) { r1[e] = x1[e] * cs[e] - x2[e] * sn[e]; r2[e] = x2[e] * cs[e] + x1[e] * sn[e]; }
        *(u32x4*)ptr = (u32x4){pk2(r1[0], r1[1]), pk2(r1[2], r1[3]), pk2(r1[4], r1[5]), pk2(r1[6], r1[7])};
        *(u32x4*)(ptr + 8) = (u32x4){pk2(r2[0], r2[1]), pk2(r2[2], r2[3]), pk2(r2[4], r2[5]), pk2(r2[6], r2[7])}; }
    __syncthreads();
}
}
#ifndef PROBE
#define PROBE 0
#endif
#ifndef PROBE_GAIN
#define PROBE_GAIN 1
#endif
#ifndef PROBE_A
#define PROBE_A 1
#endif
#ifndef PROBE_B
#define PROBE_B 2
#endif
#define PROBE_SPLIT (PROBE == 1 || PROBE == 2)
#include <hip/hip_cooperative_groups.h>
namespace cg = cooperative_groups;
namespace fr {
using namespace mk;
constexpr int M = 16384, DM = 1024, DIN = 6928, NB = 4;
constexpr size_t MiB = 1u << 20;
constexpr int LDS_BYTES = 147456;
#ifndef MK_MULTI
#define MK_MULTI 0
#endif
constexpr int NPHASE = 12;
constexpr size_t WS_CTL = 0, CTL_ZERO_BYTES = 256 * 1024;
constexpr size_t WS_BAR = 16 * 1024;
constexpr size_t WS_SS = 64 * 1024;
constexpr size_t WS_LB = 256 * 1024;
constexpr size_t WS_DA = WS_LB + 4096;
constexpr size_t WS_CS = WS_DA + 2 * 16 * 16 * 128 * 4;
constexpr size_t WS_U = 1 * MiB;
constexpr size_t WS_R2 = 217 * MiB;
constexpr size_t WS_WTIN = WS_R2;
constexpr size_t WS_SA = WS_R2;
constexpr size_t WS_HALO = WS_R2 + 14 * MiB;
constexpr size_t WS_SC = WS_R2 + 16 * MiB;
constexpr size_t WS_WTOUT = WS_R2 + 25 * MiB;
constexpr size_t WS_KV = WS_R2 + 33 * MiB;
constexpr size_t WS_GATES = WS_R2 + 37 * MiB;
constexpr size_t WS_CSN = WS_R2 + 38 * MiB;
static_assert(WS_CSN + 1 * MiB == 256 * MiB, "ws map");
static_assert(WS_U + (size_t)M * NU * 2 == WS_R2, "u fills [1, 217) MiB");
constexpr size_t DO_XB = 0;
constexpr size_t DO_LO = 32 * MiB;
constexpr size_t DO_WTKV = 32 * MiB;
constexpr size_t DO_MEMN = 36 * MiB;

#define XB_TMO      128
#define XB_XCNT(j)  (256  + 64 * (j))
#define XB_XSUB(j)  (1280 + 64 * (j))
#define XB_XGEN(j)  (2304 + 64 * (j))
#define XB_TOP      3328
#define XB_TOPGEN   3392
#define XCD_BAR_WORDS 3456
#define XB_SPIN_CAP (1u << 18)

__device__ __forceinline__ unsigned xb_ld(unsigned* p)              { return __hip_atomic_load(p, __ATOMIC_RELAXED, __HIP_MEMORY_SCOPE_AGENT); }
__device__ __forceinline__ unsigned xb_add(unsigned* p, unsigned v) { return __hip_atomic_fetch_add(p, v, __ATOMIC_RELAXED, __HIP_MEMORY_SCOPE_AGENT); }
__device__ __forceinline__ unsigned xb_xcc_id() { return (unsigned)__builtin_amdgcn_s_getreg((3 << 11) | 20) & 0xFu; }
#define XB_SPIN(cond, bar) do { unsigned _sp = 0; while (cond) { __builtin_amdgcn_s_sleep(1); \
    if ((++_sp & 255u) == 0u) { if (xb_ld(&(bar)[XB_TMO])) break; if (_sp > XB_SPIN_CAP) { atomicAdd(&(bar)[XB_TMO], 1u); break; } } } } while (0)

struct XcdBarrier {
    unsigned* bar; unsigned x;
    volatile LAS unsigned* st;
};

__device__ __forceinline__ XcdBarrier xcd_barrier_post(unsigned* bar, volatile LAS unsigned* st) {
    XcdBarrier b; b.bar = bar; b.x = xb_xcc_id(); b.st = st;
    if (pg8::tid_now() == 0) (void)xb_add(&bar[XB_XCNT(b.x)], 1u);
    return b;
}
__device__ __forceinline__ void xcd_barrier_complete(unsigned* bar, unsigned x, unsigned& nloc, unsigned& nx) {
    const unsigned G = gridDim.x * gridDim.y * gridDim.z;
    unsigned sum, cnt, mine, sp = 0u;
    for (;;) {
        sum = 0u; cnt = 0u; mine = 0u;
#pragma unroll 1
        for (unsigned j = 0; j < 16; ++j) { const unsigned c = xb_ld(&bar[XB_XCNT(j)]); sum += c; cnt += (c > 0u) ? 1u : 0u; mine = (j == x) ? c : mine; }
        if (sum == G) break;
        __builtin_amdgcn_s_sleep(1);
        if ((++sp & 255u) == 0u) { if (xb_ld(&bar[XB_TMO])) break; if (sp > XB_SPIN_CAP) { atomicAdd(&bar[XB_TMO], 1u); break; } }
    }
    nloc = mine > 0u ? mine : 1u; nx = cnt > 0u ? cnt : 1u;
}

__device__ __forceinline__ void xcd_barrier(const XcdBarrier& b) {
    asm volatile("s_waitcnt vmcnt(0)" ::: "memory");
    __syncthreads();
    if (pg8::tid_now() == 0) {
        unsigned* bar = b.bar; unsigned bx = b.x; asm volatile("" : "+s"(bx));
        __builtin_amdgcn_s_waitcnt(0);
        unsigned nloc = b.st[0], nx = b.st[1];
        if (nloc == 0u) { xcd_barrier_complete(bar, bx, nloc, nx); b.st[0] = nloc; b.st[1] = nx; }
        const unsigned old = xb_add(&bar[XB_XSUB(bx)], 1u);
        const unsigned gen = old / nloc;
        if (old + 1u == (gen + 1u) * nloc) {
            __builtin_amdgcn_fence(__ATOMIC_RELEASE, "agent");
            asm volatile("s_waitcnt vmcnt(0)" ::: "memory");
            const unsigned og = xb_add(&bar[XB_TOP], 1u);
            const unsigned tg = og / nx;
            if (og + 1u == (tg + 1u) * nx) xb_add(&bar[XB_TOPGEN], 1u);
            else XB_SPIN(xb_ld(&bar[XB_TOPGEN]) == tg, bar);
            __builtin_amdgcn_fence(__ATOMIC_ACQUIRE, "agent");
            xb_add(&bar[XB_XGEN(bx)], 1u);
            asm volatile("s_waitcnt vmcnt(0)" ::: "memory");
        } else {
            XB_SPIN(xb_ld(&bar[XB_XGEN(bx)]) == gen, bar);
            __builtin_amdgcn_fence(__ATOMIC_ACQUIRE, "agent");
            asm volatile("s_waitcnt vmcnt(0)" ::: "memory");
        }
    }
    __syncthreads();
}


struct KP {
    const float* x; const float* mem; const int* pos; const float* norm_g; const float* w_in; const float* lb_logits; const float* hgrn_g; const float* sink;
    const float* conv_w; const float* gate_b; const float* mlstm_g; const float* mem_g; const float* w_kv; const float* w_out; const float* final_g;
    float* out; unsigned char* ws;
};

__device__ const double INVF[8] = {1.0, 0.19392274474868576, 0.03760603093086393, 0.007292664737217109, 0.001414213562373095, 0.0002742481756762073, 5.318295896944988e-05, 1.031338537721246e-05};

struct EpiFinal {
    static constexpr bool PERM = true, AFTER_DRAIN = true;
    const bf16_t* hi; const bf16_t* lo; float* ssn; const float* fg; float* out; XcdBarrier bar; const unsigned long long* tsp;
    __device__ __forceinline__ void ldhalf(u32x4& rh, u32x4& rl, int row0, int col0, int st) const {
        const size_t e = (size_t)(row0 + (st >> 3) * 128 + ((st >> 1) & 3) * 16) * 1024 + col0 + (st & 1) * 128; rh = *(const u32x4*)(hi + e); rl = *(const u32x4*)(lo + e);
    }
    __device__ __forceinline__ void fused(pg8::f32x4 (&acc)[2][2][4][2], const pg8::Unit& u, int wr, int wc, int fr, int fq, PG8_LAS unsigned char*, int, int) const {
        asm volatile("" : "+v"(fr), "+v"(fq));
        using pg8::f32x4;
        const int row0 = u.pm * 256 + wr * 64 + fr; const int col0 = u.pn * 256 + wc * 32 + 8 * fq;
        u32x4 rh, rl;
        ldhalf(rh, rl, row0, col0, 0);
        float part = 0.f;
#pragma unroll
        for (int st = 0; st < 16; ++st) { const int ai = st >> 3, m = (st >> 1) & 3, bj = st & 1; const int r = row0 + ai * 128 + m * 16;
            u32x4 nh, nl;
            if (st < 15) ldhalf(nh, nl, row0, col0, st + 1);
            __builtin_amdgcn_sched_barrier(0);
            {   const u32x4 h = rh, l = rl;
                const f32x4 xa = (f32x4){bf2f(h.x & 0xffffu) + bf2f(l.x & 0xffffu), bf2f(h.x >> 16) + bf2f(l.x >> 16), bf2f(h.y & 0xffffu) + bf2f(l.y & 0xffffu), bf2f(h.y >> 16) + bf2f(l.y >> 16)};
                const f32x4 xb = (f32x4){bf2f(h.z & 0xffffu) + bf2f(l.z & 0xffffu), bf2f(h.z >> 16) + bf2f(l.z >> 16), bf2f(h.w & 0xffffu) + bf2f(l.w & 0xffffu), bf2f(h.w >> 16) + bf2f(l.w >> 16)};
                const f32x4 va = xa + acc[ai][bj][m][0], vb = xb + acc[ai][bj][m][1]; acc[ai][bj][m][0] = va; acc[ai][bj][m][1] = vb;
                part += ((va[0] * va[0] + va[1] * va[1]) + (va[2] * va[2] + va[3] * va[3])) + ((vb[0] * vb[0] + vb[1] * vb[1]) + (vb[2] * vb[2] + vb[3] * vb[3])); }
            if (bj == 1) { part += __shfl_xor(part, 16); part += __shfl_xor(part, 32);
                if (fq == 0) atomicAdd(ssn + r, part);
                part = 0.f; }
            if (st < 15) { rh = nh; rl = nl; }
        }
        xcd_barrier(bar);
        float osc = 1.0f;
#ifdef CHECK_TID
        if (__hip_atomic_load((const unsigned*)tsp + 256, __ATOMIC_RELAXED, __HIP_MEMORY_SCOPE_AGENT) != 0u) osc = __builtin_nanf("");
#endif
#if PROBE == 3
        { const unsigned long long tA = __hip_atomic_load(tsp + PROBE_A, __ATOMIC_RELAXED, __HIP_MEMORY_SCOPE_AGENT), tB = __hip_atomic_load(tsp + PROBE_B, __ATOMIC_RELAXED, __HIP_MEMORY_SCOPE_AGENT);
          osc = 1.0f + sqrtf((float)(tB - tA) * 0.01f * 2e-7f * (float)PROBE_GAIN); }
#endif
        float sv[8];
#pragma unroll
        for (int am = 0; am < 8; ++am) sv[am] = __hip_atomic_load(ssn + row0 + (am >> 2) * 128 + (am & 3) * 16, __ATOMIC_RELAXED, __HIP_MEMORY_SCOPE_AGENT);
        f32x4 ga[2], gb[2];
#pragma unroll
        for (int bj = 0; bj < 2; ++bj) { ga[bj] = *(const f32x4*)(fg + col0 + bj * 128); gb[bj] = *(const f32x4*)(fg + col0 + bj * 128 + 4); }
        __builtin_amdgcn_sched_barrier(0);
#pragma unroll
        for (int am = 0; am < 8; ++am) { const int ai = am >> 2, m = am & 3; const int r = row0 + ai * 128 + m * 16;
            const float rs = osc / sqrtf(sv[am] * (1.0f / 1024.f) + 1e-6f);
#pragma unroll
            for (int bj = 0; bj < 2; ++bj) { const int c = col0 + bj * 128;
                *(f32x4*)(out + (size_t)r * 1024 + c) = acc[ai][bj][m][0] * rs * ga[bj]; *(f32x4*)(out + (size_t)r * 1024 + c + 4) = acc[ai][bj][m][1] * rs * gb[bj]; } }
    }
};
__device__ __forceinline__ float wave_sum(float v) {
#pragma unroll
    for (int o = 1; o < 64; o <<= 1) v += __shfl_xor(v, o);
    return v;
}
__device__ __forceinline__ int new_col_to_old(int c) {
    if (c < 512) return 0 + c;
    if (c < 1024) return 2560 + (c - 512);
    if (c < 1536) return 4352 + (c - 1024);
    if (c < 2048) return 5904 + (c - 1536);
    if (c < 2560) return 512 + (c - 2048);
    if (c < 3072) return 1024 + (c - 2560);
    if (c < 3584) return 1536 + (c - 3072);
    if (c < 4096) return 2048 + (c - 3584);
    if (c < 4224) return 3072 + (c - 4096);
    if (c < 4352) return 3200 + (c - 4224);
    if (c < 4864) return 3328 + (c - 4352);
    if (c < 5120) return 3840 + (c - 4864);
    if (c < 5376) return 4096 + (c - 5120);
    if (c < 5888) return 4864 + (c - 5376);
    if (c < 6400) return 5376 + (c - 5888);
    return 6416 + (c - 6400);
}
__device__ __forceinline__ void transpose_item(const float* W, int K, int N, bf16_t* WT, int k0, int src_col0, int dst_row0, const float* kscale, LAS float* scr, int lane) {
    float wv[32];
    const int c = lane & 7;
    f32x4 ks0 = (f32x4){1.f, 1.f, 1.f, 1.f}, ks1 = ks0;
    if (kscale) { ks0 = *(const f32x4*)(kscale + k0 + 8 * c); ks1 = *(const f32x4*)(kscale + k0 + 8 * c + 4); }
#pragma unroll
    for (int i = 0; i < 32; ++i) { const int kk = 2 * i + (lane >> 5); wv[i] = __builtin_nontemporal_load(W + (size_t)(k0 + kk) * N + src_col0 + (lane & 31)); }
    __builtin_amdgcn_sched_barrier(0);
#pragma unroll
    for (int i = 0; i < 32; ++i) { const int kk = 2 * i + (lane >> 5); scr[kk * 33 + (lane & 31)] = wv[i]; }
    asm volatile("s_waitcnt lgkmcnt(0)" ::: "memory");
#pragma unroll
    for (int j = 0; j < 4; ++j) { const int n = (lane >> 3) + 8 * j; const LAS float* s = scr + (8 * c) * 33 + n;
        u32x4 o; o.x = pk2(s[0 * 33] * ks0[0], s[1 * 33] * ks0[1]); o.y = pk2(s[2 * 33] * ks0[2], s[3 * 33] * ks0[3]); o.z = pk2(s[4 * 33] * ks1[0], s[5 * 33] * ks1[1]); o.w = pk2(s[6 * 33] * ks1[2], s[7 * 33] * ks1[3]);
        *(u32x4*)(WT + (size_t)(dst_row0 + n) * K + k0 + 8 * c) = o; }
    asm volatile("s_waitcnt lgkmcnt(0)" ::: "memory");
}
__device__ __forceinline__ void convert_wtin(const KP& a, int l, LAS unsigned char* lds, int gw, int ngw, int wave, int lane) {
    LAS float* scr = (LAS float*)(lds + wave * 8448);
    bf16_t* WT = (bf16_t*)(a.ws + WS_WTIN);
    for (int it = gw; it < 16 * 216; it += ngw) { const int kb = it / 216, nbk = it % 216;
        transpose_item(a.w_in + (size_t)l * DM * DIN, DM, DIN, WT, kb * 64, new_col_to_old(nbk * 32), nbk * 32, a.norm_g + l * DM, scr, lane); }
}
__device__ __forceinline__ void gates_block(const KP& a, int l, LAS unsigned char* lds, const bf16_t* xb, const float* ss, int blk) {
    const int tid = otid(), lane = tid & 63, w = __builtin_amdgcn_readfirstlane(tid >> 6);
    float* gates = (float*)(a.ws + WS_GATES);
    LAS bf16_t* A2 = (LAS bf16_t*)lds; LAS bf16_t* B2 = A2 + 64 * 520;
    f32x4 acc = (f32x4){0.f, 0.f, 0.f, 0.f};
    for (int kh = 0; kh < 2; ++kh) {
        u32x4 av[8]; float wv[16], gv[16];
#pragma unroll
        for (int it = 0; it < 8; ++it) { const int c = tid + it * 512; const int r = c >> 6, ch = c & 63;
            av[it] = *(const u32x4*)(xb + (size_t)(blk * 64 + r) * DM + kh * 512 + ch * 8); }
#pragma unroll
        for (int it = 0; it < 16; ++it) { const int c = tid + it * 512; const int j = c & 15, k = c >> 4; const int kg = kh * 512 + k;
            wv[it] = a.w_in[((size_t)l * DM + kg) * DIN + 5888 + j]; gv[it] = a.norm_g[l * DM + kg]; }
        __builtin_amdgcn_sched_barrier(0);
#pragma unroll
        for (int it = 0; it < 8; ++it) { const int c = tid + it * 512; const int r = c >> 6, ch = c & 63; *(LAS u32x4*)(A2 + r * 520 + ch * 8) = av[it]; }
#pragma unroll
        for (int it = 0; it < 16; ++it) { const int c = tid + it * 512; const int j = c & 15, k = c >> 4; B2[j * 520 + k] = f2bf(wv[it] * gv[it]); }
        __syncthreads();
        if (w < 4) mma_nt<512>(acc, A2, 520, w * 16, B2, 520, 0, lane);
        __syncthreads();
    }
    if (w < 4) {
        float sv4[4];
#pragma unroll
        for (int i = 0; i < 4; ++i) { const int r = blk * 64 + w * 16 + 4 * (lane >> 4) + i; sv4[i] = ss[r]; }
        __builtin_amdgcn_sched_barrier(0);
#pragma unroll
        for (int i = 0; i < 4; ++i) { const int r = blk * 64 + w * 16 + 4 * (lane >> 4) + i; const float rs = 1.0f / sqrtf(sv4[i] * (1.0f / 1024.f) + 1e-6f);
            gates[(size_t)r * 16 + (lane & 15)] = acc[i] * rs; }
    }
}

__device__ __forceinline__ void prologue(const KP& a, LAS unsigned char* lds) {
    const int tid = otid(), lane = tid & 63, wave = __builtin_amdgcn_readfirstlane(tid >> 6);
    const int G = gridDim.x, gw = blockIdx.x * 8 + wave, ngw = G * 8;
    LAS float* scr = (LAS float*)(lds + wave * 8448);
    float* ss0 = (float*)(a.ws + WS_SS);
    bf16_t* xb = (bf16_t*)((unsigned char*)a.out + DO_XB);
    for (int blk = blockIdx.x; blk < M / 64; blk += G) {
#pragma unroll 4
        for (int rr = wave; rr < 64; rr += 8) { const int r = blk * 64 + rr;
            const f32x4* xr = (const f32x4*)(a.x + (size_t)r * DM) + 2 * lane;
            f32x4 v[4]; float s = 0.f;
#pragma unroll
            for (int j = 0; j < 4; ++j) { v[j] = __builtin_nontemporal_load(xr + 128 * (j >> 1) + (j & 1)); s += (v[j][0] * v[j][0] + v[j][1] * v[j][1]) + (v[j][2] * v[j][2] + v[j][3] * v[j][3]); }
            s = wave_sum(s);
            if (lane == 0) ss0[r] = s;
            u32x4* o16 = (u32x4*)(xb + (size_t)r * DM) + lane;
#pragma unroll
            for (int j = 0; j < 2; ++j) o16[64 * j] = (u32x4){pk2(v[2 * j][0], v[2 * j][1]), pk2(v[2 * j][2], v[2 * j][3]), pk2(v[2 * j + 1][0], v[2 * j + 1][1]), pk2(v[2 * j + 1][2], v[2 * j + 1][3])};
        }
    }
    convert_wtin(a, 0, lds, gw, ngw, wave, lane);
    for (int it = gw; it < 2 * 32 * 32; it += ngw) { const int l = it >> 10, r = it & 1023, kb = r >> 5, nbk = r & 31;
        transpose_item(a.w_out + (size_t)l * 2048 * DM, 2048, DM, (bf16_t*)(a.ws + WS_WTOUT) + (size_t)l * DM * 2048, kb * 64, nbk * 32, nbk * 32, nullptr, scr, lane); }
    for (int it = gw; it < 2 * 16 * 32; it += ngw) { const int l = it >> 9, r = it & 511, kb = r >> 5, nbk = r & 31;
        transpose_item(a.w_kv + (size_t)l * DM * 1024, DM, 1024, (bf16_t*)((unsigned char*)a.out + DO_WTKV) + (size_t)l * 1024 * DM, kb * 64, nbk * 32, nbk * 32, nullptr, scr, lane); }
    for (int it = gw; it < 2 * 1024; it += ngw) { const int l = it >> 10, r = it & 1023;
        const f32x4* xr = (const f32x4*)(a.mem + (size_t)r * DM) + lane; const f32x4* gr = (const f32x4*)(a.mem_g + l * DM) + lane;
        f32x4 v[4]; float s = 0.f;
#pragma unroll
        for (int j = 0; j < 4; ++j) { v[j] = xr[64 * j]; s += (v[j][0] * v[j][0] + v[j][1] * v[j][1]) + (v[j][2] * v[j][2] + v[j][3] * v[j][3]); }
        const float rs = 1.0f / sqrtf(wave_sum(s) * (1.0f / 1024.f) + 1e-6f);
        u32x2* o8 = (u32x2*)((bf16_t*)((unsigned char*)a.out + DO_MEMN) + ((size_t)l * 1024 + r) * DM) + lane;
#pragma unroll
        for (int j = 0; j < 4; ++j) { const f32x4 g = gr[64 * j]; o8[64 * j] = (u32x2){pk2(v[j][0] * rs * g[0], v[j][1] * rs * g[1]), pk2(v[j][2] * rs * g[2], v[j][3] * rs * g[3])}; }
    }
    {
        float* cs = (float*)(a.ws + WS_CSN); float* sn = cs + (size_t)M * 8;
        for (int i = blockIdx.x * 512 + tid; i < M * 8; i += G * 512) { const int t = i >> 3, j = i & 7;
            const double inv = INVF[j];
            const double ang = (double)a.pos[t] * inv;
            const double kq = rint(ang * 0.15915494309189535);
            const float r = (float)fma(-kq, 1.2246467991473532e-16 * 2.0, fma(-kq, 6.283185307179586, ang));
            cs[i] = cosf(r); sn[i] = sinf(r); }
        if (blockIdx.x == 0) { float* lb = (float*)(a.ws + WS_LB);
            const float l0 = a.lb_logits[tid], l1 = a.lb_logits[512 + tid]; const float m = fmaxf(l0, l1); const float e0 = __expf(l0 - m), e1 = __expf(l1 - m);
            lb[tid] = 0.f; lb[512 + tid] = e1 / (e0 + e1); }
    }
    __syncthreads();
}

__device__ __forceinline__ MP make_mp(const KP& a, int l) {
    MP p;
    p.u = (bf16_t*)(a.ws + WS_U); p.halo = (const bf16_t*)(a.ws + WS_HALO); p.gates = (const float*)(a.ws + WS_GATES); p.kv = (const bf16_t*)(a.ws + WS_KV) + (size_t)l * 1024 * 1024;
    p.cs = (const float*)(a.ws + WS_CSN); p.sn = p.cs + (size_t)M * 8; p.lb = (const float*)(a.ws + WS_LB) + l * 512;
    p.hgrn_g = a.hgrn_g + l * 512; p.sink = a.sink + l * 8; p.conv_w = a.conv_w + (size_t)l * 5 * 512; p.gate_b = a.gate_b + l * 16; p.mlstm_g = a.mlstm_g + l * 512;
    p.SA = (bf16_t*)(a.ws + WS_SA); p.DA = (float*)(a.ws + WS_DA); p.SC = (bf16_t*)(a.ws + WS_SC); p.CS = (float*)(a.ws + WS_CS); p.nb = NB;
    return p;
}

#ifndef REP_STEP
#define REP_STEP 0
#endif
#ifndef REP_N
#define REP_N 3
#endif
#ifndef STEP_MASK
#define STEP_MASK 0xffff
#endif
#define ST_ON(i) ((STEP_MASK >> (i)) & 1)
#ifndef PROBE
#define PROBE 0
#endif
#ifndef PROBE_GAIN
#define PROBE_GAIN 1
#endif
#ifndef PROBE_A
#define PROBE_A 1
#endif
#ifndef PROBE_B
#define PROBE_B 2
#endif
constexpr size_t WS_TS = 32 * 1024;

__device__ __forceinline__ int opq(int v) { asm volatile("" : "+s"(v)); return v; }
__device__ __forceinline__ void step_gates(const KP& a, int l, LAS unsigned char* lds) {
    const int G = gridDim.x;
    const bf16_t* xb = (const bf16_t*)((unsigned char*)a.out + DO_XB);
    const float* ss = (const float*)(a.ws + WS_SS) + (size_t)l * M;
    for (int blk = blockIdx.x; blk < M / 64; blk += G) gates_block(a, l, lds, xb, ss, blk);
    __syncthreads();
}
#ifndef G1_WGM
#define G1_WGM 6
#endif
#ifndef G2_WGM
#define G2_WGM 8
#endif
__device__ __forceinline__ void step_g1(const KP& a, int l, LAS unsigned char* lds) {
    const int G = gridDim.x;
    const bf16_t* xb = (const bf16_t*)((unsigned char*)a.out + DO_XB);
    const float* ss = (const float*)(a.ws + WS_SS) + (size_t)l * M;
    {
        pg8::Gemm g{xb, (const bf16_t*)(a.ws + WS_WTIN), M, NU, DM, DM};
        pg8::StaticOrder S; S.init(M, NU, G, (int)blockIdx.x, G1_WGM);
        pg8::EpiIn E{(bf16_t*)(a.ws + WS_U), NU, ss, (bf16_t*)(a.ws + WS_HALO)};
        pg8::gemm_phase<pg8::EpiIn, pg8::StaticOrder, true, true>((PG8_LAS unsigned char*)lds, g, S, E);
    }
    if (l == 0) {
        __syncthreads();
        pg8::Gemm g{(const bf16_t*)((unsigned char*)a.out + DO_MEMN), (const bf16_t*)((unsigned char*)a.out + DO_WTKV), 2048, 2048, DM, DM};
        pg8::KvOrder S{(int)blockIdx.x, G - 64 > 0 ? G - 64 : 0};
        pg8::EpiKv E{(bf16_t*)(a.ws + WS_KV)};
        pg8::gemm_phase<pg8::EpiKv, pg8::KvOrder, false, true>((PG8_LAS unsigned char*)lds, g, S, E);
    }
}
__device__ __forceinline__ void step_g2(const KP& a, int l, LAS unsigned char* lds, const XcdBarrier& xb, int dry = 0) {
    const int G = gridDim.x;
    pg8::Gemm g{(const bf16_t*)(a.ws + WS_U), (const bf16_t*)(a.ws + WS_WTOUT) + (size_t)l * DM * 2048, M, DM, 2048, NU};
    pg8::StaticOrder S; S.init(M, DM, G, (int)blockIdx.x, G2_WGM);
    bf16_t* hi = (bf16_t*)((unsigned char*)a.out + DO_XB); bf16_t* lo = (bf16_t*)((unsigned char*)a.out + DO_LO);
    float* ssn = (float*)(a.ws + WS_SS) + (size_t)(l + 1) * M;
    if (l == 0) { pg8::EpiOut<0> E{a.x, hi, lo, nullptr, 0, 0, ssn, dry}; pg8::gemm_phase<pg8::EpiOut<0>, pg8::StaticOrder, true, true>((PG8_LAS unsigned char*)lds, g, S, E); }
    else {
#if PROBE_SPLIT || (REP_STEP != 0)
        pg8::EpiOut<1> E{nullptr, hi, lo, (float*)(a.ws + WS_U), NU / 2, 1024, ssn, dry}; pg8::gemm_phase<pg8::EpiOut<1>, pg8::StaticOrder, true, true>((PG8_LAS unsigned char*)lds, g, S, E);
#else
        EpiFinal E{hi, lo, ssn, a.final_g, a.out, xb, (const unsigned long long*)(a.ws + WS_TS)}; pg8::gemm_phase<EpiFinal, pg8::StaticOrder, false, true>((PG8_LAS unsigned char*)lds, g, S, E);
#endif
    }
}
__device__ __forceinline__ void step_final(const KP& a, float oscale = 1.0f) {
    const int tid = otid(), lane = tid & 63, wave = __builtin_amdgcn_readfirstlane(tid >> 6);
    const int gw = blockIdx.x * 8 + wave, ngw = gridDim.x * 8;
    const float* ss2 = (const float*)(a.ws + WS_SS) + (size_t)2 * M;
    const float* x2 = (const float*)(a.ws + WS_U);
    for (int r = gw; r < M; r += ngw) {
        const float rs = 1.0f / sqrtf(ss2[r] * (1.0f / 1024.f) + 1e-6f);
        const f32x4* xr = (const f32x4*)(x2 + (size_t)r * (NU / 2) + 1024) + lane; const f32x4* gr = (const f32x4*)a.final_g + lane;
        f32x4* orow = (f32x4*)(a.out + (size_t)r * DM) + lane;
#pragma unroll
        for (int j = 0; j < 4; ++j) { const f32x4 v = xr[64 * j], g = gr[64 * j]; orow[64 * j] = v * (rs * oscale) * g; }
    }
}

typedef const __attribute__((address_space(4))) KP* KPC;
__device__ __forceinline__ KP kargs() { KPC p = (KPC)__builtin_amdgcn_kernarg_segment_ptr(); asm volatile("" : "+s"(p)); KP r; __builtin_memcpy(&r, p, sizeof(KP)); return r; }
#define KA kargs()
#define MPK make_mp(kargs(), l)
__global__ void __launch_bounds__(512, 2) mega_fwd(KP a_unused) {
    extern __shared__ __attribute__((aligned(16))) unsigned char lds_raw[];
    LAS unsigned char* lds = (LAS unsigned char*)lds_raw;
    cg::grid_group grid = cg::this_grid();
    volatile LAS unsigned* xst = (volatile LAS unsigned*)(lds + LDS_BYTES - 16);
    pg8::tid_table_init();
    if (threadIdx.x < 4) xst[threadIdx.x] = 0u;
    __syncthreads();
#ifdef CHECK_TID
    if (pg8::tid_now() != (int)threadIdx.x) ((unsigned*)(KA.ws + WS_TS))[256] = 1u;
#endif
    XcdBarrier xbar = xcd_barrier_post((unsigned*)(KA.ws + WS_BAR), xst);
    const int G = gridDim.x;
    const int vcu = (G % 8 == 0) ? (int)(blockIdx.x % 8) * (G / 8) + (int)(blockIdx.x / 8) : (int)blockIdx.x;
#if PROBE
    unsigned long long* ts = (unsigned long long*)(KA.ws + WS_TS); int nst = 0;
#define STAMP() do { if (blockIdx.x == 0 && threadIdx.x == 0) ts[nst] = __builtin_amdgcn_s_memrealtime(); ++nst; } while (0)
#if PROBE == 3
#define PSEAM() do {} while (0)
#else
#define PSEAM() do { xcd_barrier(xbar); STAMP(); } while (0)
#endif
    STAMP();
#else
#define STAMP() do {} while (0)
#define PSEAM() do {} while (0)
#endif
#define SEAM() do { xcd_barrier(xbar); STAMP(); } while (0)
    if (REP_STEP == 1) { for (int r = 0, rn = opq(REP_N - 1); r < rn; ++r) prologue(KA, lds); }
    if (ST_ON(0)) prologue(KA, lds);
    if (KA.ws == nullptr) grid.sync();
    xcd_barrier(xbar); STAMP();
    if (REP_STEP == 13) { for (int r = 0, rn = opq(20); r < rn; ++r) xcd_barrier(xbar); }
    if (REP_STEP == 14) { for (int r = 0, rn = opq(4); r < rn; ++r) grid.sync(); }
    auto layer_body = [&](const int l) __attribute__((always_inline)) {
        if (REP_STEP == 2 && l == 0) { for (int r = 0, rn = opq(REP_N - 1); r < rn; ++r) step_gates(KA, l, lds); }
        if (ST_ON(1)) step_gates(KA, l, lds); PSEAM();
        if (REP_STEP == 3 && l == 0) { for (int r = 0, rn = opq(REP_N - 1); r < rn; ++r) step_g1(KA, l, lds); }
        if (ST_ON(2)) step_g1(KA, l, lds); SEAM();
        {
            if (ST_ON(3)) for (int blk = blockIdx.x; blk < M / 64; blk += G) { pre_load(MPK, lds, blk); pre_write(MPK, lds, blk); __syncthreads(); }
            xcd_barrier(xbar);
#if PROBE
            if (blockIdx.x == 0 && threadIdx.x == 0) ts[50 + l] = __builtin_amdgcn_s_memrealtime();
#endif
            const int nB = NB * 128, nA = NB * 128, nC = NB * 128, nD = NB * 64;
#if PROBE_SPLIT
            for (int it = blockIdx.x; it < nB; it += G) b_item(MPK, lds, it);
            PSEAM();
            for (int it = blockIdx.x; it < nA; it += G) { mk::ARaw RA; a_pass1(MPK, lds, it, RA, false, -1); }
            PSEAM();
            for (int it = blockIdx.x; it < nC; it += G) { mk::C1Pre PX; c_pass1(MPK, lds, it, PX, false, -1); }
            PSEAM();
            for (int it = blockIdx.x; it < nD; it += G) d_item(MPK, lds, it);
#else
            if (l == 0 && REP_STEP >= 4 && REP_STEP <= 7) { for (int r = 0, rn = opq(REP_N - 1); r < rn; ++r) { const bool dry = opq(1) != 0;
                if (REP_STEP == 4) for (int it = blockIdx.x; it < nB; it += G) b_item(MPK, lds, it, dry);
                if (REP_STEP == 5) for (int it = blockIdx.x; it < nA; it += G) { mk::ARaw RA; a_pass1(MPK, lds, it, RA, false, -1); }
                if (REP_STEP == 6) for (int it = blockIdx.x; it < nC; it += G) { mk::C1Pre PX; c_pass1(MPK, lds, it, PX, false, -1); }
                if (REP_STEP == 7) for (int it = blockIdx.x; it < nD; it += G) d_item(MPK, lds, it, dry); } }
            {
                const int lo1 = nB, lo2 = nB + nA, lo3 = nB + nA + nC, hi3 = lo3 + nD;
                const int s1 = vcu + ((lo1 - vcu + G - 1) / G) * G, s2 = vcu + ((lo2 - vcu + G - 1) / G) * G, s3 = vcu + ((lo3 - vcu + G - 1) / G) * G;
                if (ST_ON(4)) for (int it = vcu; it < lo1; it += G) b_item(MPK, lds, it);
                if (ST_ON(5)) { mk::ARaw RA; bool have = false;
                    for (int it = s1; it < lo2; it += G) { const int nx = it + G < lo2 ? it + G - lo1 : -1; a_pass1(MPK, lds, it - lo1, RA, have, nx); have = nx >= 0; } }
                if (ST_ON(6)) { mk::C1Pre PC1; bool haveC = false;
                    for (int it = s2; it < lo3; it += G) { const int nx = it + G < lo3 ? it + G - lo2 : -1; c_pass1(MPK, lds, it - lo2, PC1, haveC, nx); haveC = nx >= 0; } }
                if (ST_ON(7)) for (int it = s3; it < hi3; it += G) d_item(MPK, lds, it - lo3);
            }
#endif
            SEAM();
            {
                const int nAu = NB * 8 * 4096, nCu = NB * 8 * 2304;
                if (l == 0 && REP_STEP == 8) { for (int r = 0, rn = opq(REP_N - 1); r < rn; ++r) { const bool dry = opq(1) != 0;
                    for (int uu = blockIdx.x * 512 + otid(); uu < nAu + nCu; uu += G * 512) { if (uu < nAu) a_scan_unit(MPK, uu, dry); else c_scan_unit(MPK, uu - nAu, dry); } } }
                if (G * 512 == nAu) {
                    const int uu = blockIdx.x * 512 + otid();
                    mk::CScan X;
                    if (uu < nCu) c_scan_load(X, MPK, uu);
                    __builtin_amdgcn_sched_barrier(0);
                    a_scan_unit(MPK, uu);
                    if (uu < nCu) c_scan_run(X, MPK, uu);
                } else
                for (int uu = blockIdx.x * 512 + otid(); uu < nAu + nCu; uu += G * 512) { if (uu < nAu) a_scan_unit(MPK, uu); else c_scan_unit(MPK, uu - nAu); }
            }
            SEAM();
#if PROBE_SPLIT
            for (int it = blockIdx.x; it < NB * 64; it += G) { mk::C3Pre PC; a_pass3(MPK, lds, it, PC, -1); }
            PSEAM();
            for (int it = blockIdx.x; it < NB * 64; it += G) { mk::C3Pre PC; c_pass3(MPK, lds, it, PC, false); }
#else
            if (l == 0 && (REP_STEP == 9 || REP_STEP == 10)) { for (int r = 0, rn = opq(REP_N - 1); r < rn; ++r) { const bool dry = opq(1) != 0;
                if (REP_STEP == 9) for (int it = blockIdx.x; it < NB * 64; it += G) { mk::C3Pre PC; a_pass3(MPK, lds, it, PC, -1, dry); }
                if (REP_STEP == 10) for (int it = blockIdx.x; it < NB * 64; it += G) { mk::C3Pre PC; c_pass3(MPK, lds, it, PC, false, dry); } } }
            {
                const int nA3 = NB * 64, sC = (int)blockIdx.x + ((nA3 - (int)blockIdx.x + G - 1) / G) * G;
                mk::C3Pre PC; bool have = false;
                if (ST_ON(9)) { int it = blockIdx.x;
                    for (; it + G < nA3; it += G) { mk::C3Pre PD; a_pass3(MPK, lds, it, PD, -1); }
                    if (it < nA3) { const int nc = (sC < 2 * nA3 && ST_ON(10)) ? sC - nA3 : -1; a_pass3(MPK, lds, it, PC, nc); have = nc >= 0; } }
                if (ST_ON(10)) for (int it = sC; it < 2 * nA3; it += G) { c_pass3(MPK, lds, it - nA3, PC, have); have = false; }
            }
#endif
            SEAM();
        }
        if (l == 0) { const int tid = otid(); convert_wtin(KA, 1, lds, blockIdx.x * 8 + (tid >> 6), G * 8, __builtin_amdgcn_readfirstlane(tid >> 6), tid & 63); __syncthreads(); PSEAM(); }
        if (REP_STEP == 12 && l == 0) { for (int r = 0, rn = opq(REP_N - 1); r < rn; ++r) { step_g2(KA, l, lds, xbar, opq(1)); } }
#if PROBE_SPLIT || (REP_STEP != 0)
        step_g2(KA, l, lds, xbar); SEAM();
#else
        step_g2(KA, l, lds, xbar); if (l == 0) SEAM();
#endif
    };
    layer_body(0);
    layer_body(1);
#if PROBE == 2
    {
        xcd_barrier(xbar);
        const unsigned long long* tsx = (PROBE_A >= 100) ? (const unsigned long long*)((const float*)(KA.ws + WS_CS) + 4096) - 100 : ts;
        const float d = (float)(tsx[PROBE_B] - tsx[PROBE_A]) * 0.01f;
        step_final(KA, 1.0f + sqrtf(d * 2e-7f * (float)PROBE_GAIN));
    }
#elif PROBE == 1
    {
        const float dA = (float)(ts[PROBE_A] - ts[PROBE_A - 1]) * 0.01f, dB = (float)(ts[PROBE_B] - ts[PROBE_B - 1]) * 0.01f;
        const float c = sqrtf(dA * 0.1f);
        for (size_t i = (size_t)blockIdx.x * 512 + threadIdx.x; i < (size_t)M * DM; i += (size_t)G * 512) KA.out[i] = (i == 0) ? (20.f + dB) : c;
    }
#elif (REP_STEP != 0)
    step_final(KA);
#endif
}
}

extern "C" void kernel_launch(void* const* d_in, const int* in_sizes, int n_in,
                              void* d_out, int out_size, void* d_ws, size_t ws_size,
                              hipStream_t stream) {
    using namespace fr;
    static int grid_blocks = 0;
    if (!grid_blocks) {
        int dev = 0, cus = 0, per_cu = 0;
        (void)hipGetDevice(&dev);
        (void)hipDeviceGetAttribute(&cus, hipDeviceAttributeMultiprocessorCount, dev);
        (void)hipFuncSetAttribute((const void*)mega_fwd, hipFuncAttributeMaxDynamicSharedMemorySize, LDS_BYTES);
        (void)hipOccupancyMaxActiveBlocksPerMultiprocessor(&per_cu, (const void*)mega_fwd, 512, LDS_BYTES);
        if (per_cu < 1) per_cu = 1;
        grid_blocks = cus * (per_cu > 1 ? 1 : per_cu);
    }
    KP a{};
    a.x = (const float*)d_in[0]; a.mem = (const float*)d_in[1]; a.pos = (const int*)d_in[2]; a.norm_g = (const float*)d_in[3]; a.w_in = (const float*)d_in[4];
    a.lb_logits = (const float*)d_in[5]; a.hgrn_g = (const float*)d_in[6]; a.sink = (const float*)d_in[7]; a.conv_w = (const float*)d_in[8]; a.gate_b = (const float*)d_in[9];
    a.mlstm_g = (const float*)d_in[10]; a.mem_g = (const float*)d_in[11]; a.w_kv = (const float*)d_in[12]; a.w_out = (const float*)d_in[13]; a.final_g = (const float*)d_in[14];
    a.out = (float*)d_out; a.ws = (unsigned char*)d_ws;
    (void)hipMemsetAsync((char*)d_ws + WS_CTL, 0, CTL_ZERO_BYTES, stream);
    void* args[] = {&a};
    (void)hipLaunchCooperativeKernel((const void*)mega_fwd, dim3(grid_blocks), dim3(512), args, LDS_BYTES, stream);
}
```
